# Optimizing an MI355X kernel written in HIP

```python
import math
import jax
import jax.numpy as jnp
from jax import lax
import numpy as np


D_MODEL = 1024
BATCH = 32
SEQ = 2048
DEPTH = 4

GRID_W = 64
CTX_LEN = 256
EPS = 1e-6
F32 = jnp.float32
HEAD_DIM = 64
ATT_WIDTH = D_MODEL // 2
ATT_HEADS = ATT_WIDTH // HEAD_DIM
ATT_KV_HEADS = ATT_HEADS // 4
ATT_GROUP = ATT_HEADS // ATT_KV_HEADS
WINDOW = 128
ATT_BLOCK = 128
ROPE_THETA = 10000.0
ROPE_AXIS_DIM = HEAD_DIM // 2
SSD_WIDTH = D_MODEL // 4
SSD_HEAD_DIM = 64
SSD_HEADS = SSD_WIDTH // SSD_HEAD_DIM
SSD_STATE = 64
SSD_GROUPS = 2
SSD_CONV = 3
SSD_CHUNK = 128
HYENA_WIDTH = D_MODEL // 4
HYENA_GROUPS = 4
HYENA_ORDER = 2
HYENA_CONV = 3
HYENA_POS_DIM = 33
HYENA_FILTER_HIDDEN = 64
HYENA_FAST_DECAY = 0.3
HYENA_SLOW_DECAY = 1.5
HYENA_DECAY_TARGET = 1e-2
MIX_WIDTH = ATT_WIDTH + SSD_WIDTH + HYENA_WIDTH
Q_COLS = ATT_HEADS * HEAD_DIM
KV_COLS = ATT_KV_HEADS * HEAD_DIM
SSD_XBC_COLS = SSD_WIDTH + 2 * SSD_GROUPS * SSD_STATE
SSD_DT_COLS = 2 * SSD_HEADS
HY_COLS = (HYENA_ORDER + 1) * HYENA_WIDTH
PROJ_WIDTH = Q_COLS + 2 * KV_COLS + SSD_WIDTH + SSD_XBC_COLS + SSD_DT_COLS + HY_COLS
FFN_DIM = 256 * ((8 * D_MODEL // 3 + 255) // 256)
N_EXPERTS = 8
MOE_TOP_K = 2
EXPERT_DIM = FFN_DIM

kernel_name = 'hybrid_swa_ssd_hyena_moe_dit'


def _rms(x):
    xf = x.astype(F32)
    return (xf * lax.rsqrt(jnp.mean(xf * xf, axis=-1, keepdims=True) + EPS)).astype(x.dtype)


def rms_norm(x, g):
    return _rms(x) * g


def group_rms_norm(x, g, groups):
    shp = x.shape
    return _rms(x.reshape(shp[:-1] + (groups, shp[-1] // groups))).reshape(shp) * g


def short_conv(u, w, b):
    k = w.shape[0]
    y = lax.conv_general_dilated(u, w[:, None, :], window_strides=(1,), padding=[(k // 2, k // 2)],
                                 dimension_numbers=('NWC', 'WIO', 'NWC'), feature_group_count=u.shape[-1])
    return y + b


def swiglu(t, wg, wu, wd):
    return (jax.nn.silu(t @ wg) * (t @ wu)) @ wd


def moe_swiglu(h, router, wg, wu, wd):
    shp = h.shape
    t = h.reshape(-1, shp[-1])
    logits = (t @ router).astype(F32)
    top_v, top_i = lax.top_k(logits, MOE_TOP_K)
    top_w = jax.nn.softmax(top_v, axis=-1)
    combine = jnp.sum(jax.nn.one_hot(top_i, N_EXPERTS, dtype=F32) * top_w[..., None], axis=1).astype(h.dtype)
    out = jnp.zeros_like(t)
    for e in range(N_EXPERTS):
        out = out + combine[:, e:e + 1] * swiglu(t, wg[e], wu[e], wd[e])
    return out.reshape(shp)


def channel_mixer(h, layer, ffn_w_gate, ffn_w_up, ffn_w_down, moe_router, moe_w_gate, moe_w_up, moe_w_down):
    j = layer // 2
    if layer % 2 == 0:
        return swiglu(h, ffn_w_gate[j], ffn_w_up[j], ffn_w_down[j])
    return moe_swiglu(h, moe_router[j], moe_w_gate[j], moe_w_up[j], moe_w_down[j])


def axial_rope_tables(seq_len):
    rows = seq_len // GRID_W
    row = jnp.repeat(jnp.arange(rows, dtype=F32), GRID_W)
    col = jnp.tile(jnp.arange(GRID_W, dtype=F32), rows)
    inv = ROPE_THETA ** (-jnp.arange(0, ROPE_AXIS_DIM, 2, dtype=F32) / ROPE_AXIS_DIM)
    ang = jnp.stack([row[:, None] * inv, col[:, None] * inv], axis=1)
    return jnp.cos(ang), jnp.sin(ang)


def apply_axial_rope(x, cos, sin):
    xr = x.reshape(x.shape[:-1] + (2, 2, ROPE_AXIS_DIM // 2))
    x1, x2 = xr[..., 0, :], xr[..., 1, :]
    cs = cos[None, :, None].astype(x.dtype)
    sn = sin[None, :, None].astype(x.dtype)
    return jnp.stack([x1 * cs - x2 * sn, x1 * sn + x2 * cs], axis=-2).reshape(x.shape)


def _heads(t, n):
    return t.reshape(t.shape[:-1] + (n, HEAD_DIM))


def latent_window_attention(q, k, v, k_ctx, v_ctx, sink):
    b, seq_len = q.shape[:2]
    band = ATT_BLOCK + 2 * WINDOW
    pad = ((0, 0), (WINDOW, WINDOW), (0, 0), (0, 0))
    kp = jnp.pad(k, pad)
    vp = jnp.pad(v, pad)
    rel = jnp.arange(band)[None, :] - WINDOW - jnp.arange(ATT_BLOCK)[:, None]

    def one_block(i):
        start = i * ATT_BLOCK
        qb = lax.dynamic_slice_in_dim(q, start, ATT_BLOCK, axis=1)
        kb = lax.dynamic_slice_in_dim(kp, start, band, axis=1)
        vb = lax.dynamic_slice_in_dim(vp, start, band, axis=1)
        kpos = start - WINDOW + jnp.arange(band)
        valid = (jnp.abs(rel) <= WINDOW) & ((kpos >= 0) & (kpos < seq_len))[None, :]
        s_loc = jnp.where(valid, jnp.einsum('bqhgd,bkhd->bhgqk', qb, kb).astype(F32), -jnp.inf)
        s_ctx = jnp.einsum('bqhgd,bkhd->bhgqk', qb, k_ctx).astype(F32)
        s_snk = jnp.broadcast_to(sink[None, :, :, None, None], s_ctx.shape[:-1] + (1,))
        p = jax.nn.softmax(jnp.concatenate([s_loc, s_ctx, s_snk], axis=-1), axis=-1).astype(v.dtype)
        return (jnp.einsum('bhgqk,bkhd->bqhgd', p[..., :band], vb)
                + jnp.einsum('bhgqk,bkhd->bqhgd', p[..., band:-1], v_ctx))

    out = lax.map(one_block, jnp.arange(seq_len // ATT_BLOCK))
    return jnp.moveaxis(out, 0, 1).reshape(b, seq_len, ATT_WIDTH)


def context_attention(q, k, v, sink):
    b, ctx_len = q.shape[:2]
    s = jnp.einsum('bqhgd,bkhd->bhgqk', q, k).astype(F32)
    s_snk = jnp.broadcast_to(sink[None, :, :, None, None], s.shape[:-1] + (1,))
    p = jax.nn.softmax(jnp.concatenate([s, s_snk], axis=-1), axis=-1).astype(v.dtype)
    return jnp.einsum('bhgqk,bkhd->bqhgd', p[..., :-1], v).reshape(b, ctx_len, ATT_WIDTH)


def ssd_prep(xbc, dt_raw, lp):
    xbc = jax.nn.silu(short_conv(xbc, lp['ssd_conv_w'], lp['ssd_conv_b']))
    xs, bm, cm = jnp.split(xbc, [SSD_WIDTH, SSD_WIDTH + SSD_GROUPS * SSD_STATE], axis=-1)
    b, seq_len = xs.shape[:2]
    rep = SSD_HEADS // SSD_GROUPS
    bh = jnp.repeat(bm.reshape(b, seq_len, SSD_GROUPS, SSD_STATE), rep, axis=2)
    ch = jnp.repeat(cm.reshape(b, seq_len, SSD_GROUPS, SSD_STATE), rep, axis=2)
    dt = jax.nn.softplus(dt_raw.astype(F32).reshape(b, seq_len, 2, SSD_HEADS) + lp['ssd_dt_bias'].astype(F32))
    return xs.reshape(b, seq_len, SSD_HEADS, SSD_HEAD_DIM), bh, ch, dt


def ssd_chunked(xh, dt, a, bh, ch, h0, want_y):
    b, seq_len, nh, hp = xh.shape
    nc = seq_len // SSD_CHUNK
    shp = (b, nc, SSD_CHUNK)
    xdt = (xh.astype(F32) * dt[..., None]).reshape(shp + (nh, hp))
    bc = bh.astype(F32).reshape(shp + (nh, SSD_STATE))
    la = jnp.cumsum((dt * a).reshape(shp + (nh,)), axis=2)
    w_end = jnp.exp(la[:, :, -1:] - la)
    states = jnp.einsum('bcshn,bcshp->bchpn', bc, xdt * w_end[..., None])

    def step(h, inp):
        s, dec = inp
        return h * dec[:, :, None, None] + s, h

    h_last, h_start = lax.scan(step, h0, (jnp.moveaxis(states, 1, 0), jnp.moveaxis(jnp.exp(la[:, :, -1]), 1, 0)))
    if not want_y:
        return None, h_last
    cc = ch.astype(F32).reshape(shp + (nh, SSD_STATE))
    seg = la[:, :, :, None] - la[:, :, None, :]
    lower = jnp.tril(jnp.ones((SSD_CHUNK, SSD_CHUNK), bool))[None, None, :, :, None]
    decay = jnp.exp(jnp.where(lower, seg, -jnp.inf))
    scores = jnp.einsum('bclhn,bcshn->bclsh', cc, bc)
    y_diag = jnp.einsum('bclsh,bcshp->bclhp', scores * decay, xdt)
    y_off = jnp.einsum('bclhn,bchpn->bclhp', cc, jnp.moveaxis(h_start, 0, 1)) * jnp.exp(la)[..., None]
    return (y_diag + y_off).reshape(b, seq_len, nh, hp), h_last


def _flip(t, rev):
    return jnp.flip(t, axis=1) if rev else t


def ssd_bidirectional(lat, ctx, a_log, d_skip, want_ctx):
    a = -jnp.exp(a_log.astype(F32))
    xl, bl, cl, dl = lat
    xc, bc, cc, dc = ctx
    h0 = jnp.zeros((xl.shape[0], SSD_HEADS, SSD_HEAD_DIM, SSD_STATE), F32)
    dsk = d_skip.astype(F32)[:, None]
    y_lat = xl.astype(F32) * dsk
    y_ctx = xc.astype(F32) * dsk if want_ctx else None
    for direction in range(2):
        rev = direction == 1
        yc, hc = ssd_chunked(_flip(xc, rev), _flip(dc[:, :, direction], rev), a[direction],
                             _flip(bc, rev), _flip(cc, rev), h0, want_ctx)
        yl, _ = ssd_chunked(_flip(xl, rev), _flip(dl[:, :, direction], rev), a[direction],
                            _flip(bl, rev), _flip(cl, rev), hc, True)
        y_lat = y_lat + _flip(yl, rev)
        if want_ctx:
            y_ctx = y_ctx + _flip(yc, rev)
    return y_lat, y_ctx


def hyena_filters(seq_len, lp):
    t = jnp.linspace(0.0, 1.0, seq_len, dtype=F32)[:, None]
    w = (2.0 * math.pi / seq_len) * jnp.arange(seq_len, dtype=F32)[:, None]
    bands = (HYENA_POS_DIM - 1) // 2
    freqs = jnp.linspace(1e-4, bands - 1, bands, dtype=F32)[None, :]
    z = jnp.concatenate([t, jnp.cos(freqs * w), -jnp.sin(freqs * w)], axis=-1)
    h = jnp.sin(lp['hy_f1'].astype(F32) * (z @ lp['hy_w1'].astype(F32) + lp['hy_b1'].astype(F32)))
    h = jnp.sin(lp['hy_f2'].astype(F32) * (h @ lp['hy_w2'].astype(F32) + lp['hy_b2'].astype(F32)))
    h = (h @ lp['hy_w3'].astype(F32)).reshape(seq_len, 2, HYENA_ORDER, HYENA_WIDTH)
    deltas = jnp.abs(jnp.linspace(math.log(HYENA_DECAY_TARGET) / HYENA_SLOW_DECAY,
                                  math.log(HYENA_DECAY_TARGET) / HYENA_FAST_DECAY, HYENA_WIDTH, dtype=F32))
    h = h * jnp.exp(-t * deltas)[:, None, None, :]
    k2 = jnp.concatenate([h[:, 0], jnp.zeros((1, HYENA_ORDER, HYENA_WIDTH), F32),
                          jnp.flip(h[1:, 1], axis=0)], axis=0)
    return jnp.fft.rfft(k2, axis=0)


def long_conv(u, kf, bias):
    seq_len = u.shape[1]
    uf = u.astype(F32)
    y = jnp.fft.irfft(jnp.fft.rfft(uf, n=2 * seq_len, axis=1) * kf[None], n=2 * seq_len, axis=1)[:, :seq_len]
    return (y + uf * bias.astype(F32)).astype(u.dtype)


def hyena_operator(u, lp):
    kf = hyena_filters(u.shape[1], lp)
    u = short_conv(u, lp['hy_conv_w'], lp['hy_conv_b'])
    v, x1, x2 = jnp.split(u, 3, axis=-1)
    z = x1 * long_conv(v, kf[:, 0], lp['hy_bias'][0])
    return x2 * long_conv(z, kf[:, 1], lp['hy_bias'][1])


def split_proj(p):
    widths = (Q_COLS, KV_COLS, KV_COLS, SSD_WIDTH, SSD_XBC_COLS, SSD_DT_COLS)
    cuts = []
    total = 0
    for wdt in widths:
        total += wdt
        cuts.append(total)
    return jnp.split(p, cuts, axis=-1)


def merge_groups(att, ssd_y, z, hy, lp):
    ssd_out = rms_norm(ssd_y.reshape(z.shape).astype(z.dtype) * jax.nn.silu(z), lp['ssd_norm'])
    y = jnp.concatenate([rms_norm(att, lp['att_out_norm']), ssd_out,
                         group_rms_norm(hy, lp['hy_out_norm'], HYENA_GROUPS)], axis=-1)
    return y @ lp['w_out']


def hybrid_mixer(hx, hc, rope_cos, rope_sin, lp, ctx_out):
    b, seq_len = hx.shape[:2]
    ctx_len = hc.shape[1]
    q_x, k_x, v_x, z_x, xbc_x, dt_x, hy_x = split_proj(hx @ lp['w_in'])
    q_c, k_c, v_c, z_c, xbc_c, dt_c, hy_c = split_proj(hc @ lp['w_in'])
    scale = HEAD_DIM ** -0.5
    sink = lp['att_sinks'].astype(F32).reshape(ATT_KV_HEADS, ATT_GROUP)
    q_l = apply_axial_rope(rms_norm(_heads(q_x, ATT_HEADS), lp['q_norm']), rope_cos, rope_sin) * scale
    k_l = apply_axial_rope(rms_norm(_heads(k_x, ATT_KV_HEADS), lp['k_norm']), rope_cos, rope_sin)
    k_cx = rms_norm(_heads(k_c, ATT_KV_HEADS), lp['k_norm'])
    v_cx = _heads(v_c, ATT_KV_HEADS)
    att_l = latent_window_attention(q_l.reshape(b, seq_len, ATT_KV_HEADS, ATT_GROUP, HEAD_DIM), k_l,
                                    _heads(v_x, ATT_KV_HEADS), k_cx, v_cx, sink)
    ssd_l, ssd_c = ssd_bidirectional(ssd_prep(xbc_x, dt_x, lp), ssd_prep(xbc_c, dt_c, lp),
                                     lp['ssd_a_log'], lp['ssd_d'], ctx_out)
    y_l = merge_groups(att_l, ssd_l, z_x, hyena_operator(hy_x, lp), lp)
    if not ctx_out:
        return y_l, None
    q_cx = rms_norm(_heads(q_c, ATT_HEADS), lp['q_norm']) * scale
    att_c = context_attention(q_cx.reshape(b, ctx_len, ATT_KV_HEADS, ATT_GROUP, HEAD_DIM), k_cx, v_cx, sink)
    y_c = merge_groups(att_c, ssd_c, z_c, hyena_operator(hy_c, lp), lp)
    return y_l, y_c


def setup_inputs(seed: int = 0) -> dict:
    key = jax.random.key(seed)
    ks = iter(jax.random.split(key, 48))

    def nrm(shape, scale):
        return jax.random.normal(next(ks), shape, F32) * scale

    def gain(shape):
        return 1.0 + 0.05 * jax.random.normal(next(ks), shape, F32)

    n_dense = (DEPTH + 1) // 2
    n_moe = DEPTH // 2
    dt0 = jnp.exp(jax.random.uniform(next(ks), (DEPTH, 2, SSD_HEADS), F32) * (math.log(0.1) - math.log(1e-3)) + math.log(1e-3))
    return {
        'x': nrm((BATCH, SEQ, D_MODEL), 1.0),
        'c': nrm((BATCH, D_MODEL), 1.0),
        'ctx': nrm((BATCH, CTX_LEN, D_MODEL), 1.0),
        'c_ctx': nrm((D_MODEL,), 1.0),
        'w_ada': nrm((DEPTH, D_MODEL, 6 * D_MODEL), 0.5 * D_MODEL ** -0.5),
        'b_ada': nrm((DEPTH, 6 * D_MODEL), 0.02),
        'norm1': gain((DEPTH, D_MODEL)),
        'norm2': gain((DEPTH, D_MODEL)),
        'w_in': nrm((DEPTH, D_MODEL, PROJ_WIDTH), D_MODEL ** -0.5),
        'w_out': nrm((DEPTH, MIX_WIDTH, D_MODEL), MIX_WIDTH ** -0.5),
        'q_norm': gain((DEPTH, HEAD_DIM)),
        'k_norm': gain((DEPTH, HEAD_DIM)),
        'att_sinks': nrm((DEPTH, ATT_HEADS), 0.5),
        'att_out_norm': gain((DEPTH, ATT_WIDTH)),
        'ssd_conv_w': nrm((DEPTH, SSD_CONV, SSD_XBC_COLS), SSD_CONV ** -0.5),
        'ssd_conv_b': nrm((DEPTH, SSD_XBC_COLS), 0.02),
        'ssd_dt_bias': dt0 + jnp.log(-jnp.expm1(-dt0)),
        'ssd_a_log': jnp.log(jax.random.uniform(next(ks), (DEPTH, 2, SSD_HEADS), F32, 1.0, 16.0)),
        'ssd_d': gain((DEPTH, SSD_HEADS)),
        'ssd_norm': gain((DEPTH, SSD_WIDTH)),
        'hy_conv_w': nrm((DEPTH, HYENA_CONV, HY_COLS), HYENA_CONV ** -0.5),
        'hy_conv_b': nrm((DEPTH, HY_COLS), 0.02),
        'hy_w1': nrm((DEPTH, HYENA_POS_DIM, HYENA_FILTER_HIDDEN), HYENA_POS_DIM ** -0.5),
        'hy_b1': nrm((DEPTH, HYENA_FILTER_HIDDEN), 0.1),
        'hy_f1': gain((DEPTH, HYENA_FILTER_HIDDEN)),
        'hy_w2': nrm((DEPTH, HYENA_FILTER_HIDDEN, HYENA_FILTER_HIDDEN), HYENA_FILTER_HIDDEN ** -0.5),
        'hy_b2': nrm((DEPTH, HYENA_FILTER_HIDDEN), 0.1),
        'hy_f2': gain((DEPTH, HYENA_FILTER_HIDDEN)),
        'hy_w3': nrm((DEPTH, HYENA_FILTER_HIDDEN, 2 * HYENA_ORDER * HYENA_WIDTH), 0.02),
        'hy_bias': nrm((DEPTH, HYENA_ORDER, HYENA_WIDTH), 0.1),
        'hy_out_norm': gain((DEPTH, HYENA_WIDTH)),
        'ffn_w_gate': nrm((n_dense, D_MODEL, FFN_DIM), D_MODEL ** -0.5),
        'ffn_w_up': nrm((n_dense, D_MODEL, FFN_DIM), D_MODEL ** -0.5),
        'ffn_w_down': nrm((n_dense, FFN_DIM, D_MODEL), FFN_DIM ** -0.5),
        'moe_router': nrm((n_moe, D_MODEL, N_EXPERTS), D_MODEL ** -0.5),
        'moe_w_gate': nrm((n_moe, N_EXPERTS, D_MODEL, EXPERT_DIM), D_MODEL ** -0.5),
        'moe_w_up': nrm((n_moe, N_EXPERTS, D_MODEL, EXPERT_DIM), D_MODEL ** -0.5),
        'moe_w_down': nrm((n_moe, N_EXPERTS, EXPERT_DIM, D_MODEL), EXPERT_DIM ** -0.5),
    }


def reference(x, c, ctx, c_ctx, w_ada, b_ada, norm1, norm2, w_in, w_out, q_norm, k_norm, att_sinks,
              att_out_norm, ssd_conv_w, ssd_conv_b, ssd_dt_bias, ssd_a_log, ssd_d, ssd_norm, hy_conv_w,
              hy_conv_b, hy_w1, hy_b1, hy_f1, hy_w2, hy_b2, hy_f2, hy_w3, hy_bias, hy_out_norm, ffn_w_gate,
              ffn_w_up, ffn_w_down, moe_router, moe_w_gate, moe_w_up, moe_w_down):
    seq_len = x.shape[1]
    rope_cos, rope_sin = axial_rope_tables(seq_len)
    silu_c = jax.nn.silu(c)
    silu_cc = jax.nn.silu(c_ctx)
    xc = ctx
    for i in range(DEPTH):
        last = i == DEPTH - 1
        lp = {
            'w_in': w_in[i], 'w_out': w_out[i], 'q_norm': q_norm[i], 'k_norm': k_norm[i],
            'att_sinks': att_sinks[i], 'att_out_norm': att_out_norm[i],
            'ssd_conv_w': ssd_conv_w[i], 'ssd_conv_b': ssd_conv_b[i], 'ssd_dt_bias': ssd_dt_bias[i],
            'ssd_a_log': ssd_a_log[i], 'ssd_d': ssd_d[i], 'ssd_norm': ssd_norm[i],
            'hy_conv_w': hy_conv_w[i], 'hy_conv_b': hy_conv_b[i], 'hy_w1': hy_w1[i], 'hy_b1': hy_b1[i],
            'hy_f1': hy_f1[i], 'hy_w2': hy_w2[i], 'hy_b2': hy_b2[i], 'hy_f2': hy_f2[i], 'hy_w3': hy_w3[i],
            'hy_bias': hy_bias[i], 'hy_out_norm': hy_out_norm[i],
        }
        mod = (silu_c @ w_ada[i] + b_ada[i]).reshape(c.shape[0], 6, 1, D_MODEL)
        modc = (silu_cc @ w_ada[i] + b_ada[i]).reshape(6, D_MODEL)
        hx = rms_norm(x, norm1[i]) * (1 + mod[:, 1]) + mod[:, 0]
        hc = rms_norm(xc, norm1[i]) * (1 + modc[1]) + modc[0]
        mix_x, mix_c = hybrid_mixer(hx, hc, rope_cos, rope_sin, lp, not last)
        x = x + mod[:, 2] * mix_x
        x = x + mod[:, 5] * channel_mixer(rms_norm(x, norm2[i]) * (1 + mod[:, 4]) + mod[:, 3], i,
                                          ffn_w_gate, ffn_w_up, ffn_w_down, moe_router, moe_w_gate, moe_w_up, moe_w_down)
        if not last:
            xc = xc + modc[2] * mix_c
            xc = xc + modc[5] * channel_mixer(rms_norm(xc, norm2[i]) * (1 + modc[4]) + modc[3], i,
                                              ffn_w_gate, ffn_w_up, ffn_w_down, moe_router, moe_w_gate, moe_w_up, moe_w_down)
    return x
```

```cpp
#include <hip/hip_runtime.h>
#include <cstdio>
#include <cstdint>
namespace pg8 {
#define PG8_LAS __attribute__((address_space(3)))
typedef unsigned short bf16_t;
typedef short bf16x8 __attribute__((ext_vector_type(8)));
typedef float f32x4 __attribute__((ext_vector_type(4)));
typedef unsigned u32x4 __attribute__((ext_vector_type(4)));
constexpr int BM = 256, BK = 64, HALF = 128, HTB = HALF * BK * 2  , STAGE_BYTES = 8 * HTB, NXCD = 8, WGM = 8;

__host__ __device__ __forceinline__ int lds_byte(int r, int c) { const int st = (r >> 4) * 2 + (c >> 5), rr = r & 15, cc = c & 31, ob = rr * 64 + cc * 2; return st * 1024 + (ob ^ (((ob >> 9) & 1) << 5)); }
__host__ __device__ __forceinline__ void stage_rc(int b, int& R, int& C) { const int st = b / 1024, sb = b % 1024, swz = sb ^ (((sb >> 9) & 1) << 5); R = (st >> 1) * 16 + swz / 64; C = (st & 1) * 32 + (swz % 64) / 2; }
__host__ __device__ __forceinline__ int perm32(int rho) { const int n = rho >> 4, i = rho & 15; return 8 * (i >> 2) + 4 * n + (i & 3); }

struct Unit { int pm, pn; };
struct Gemm { const bf16_t* A; const bf16_t* Bt; int M, N, K; };

struct StaticOrder {
    int nM, nN, nwg, G, c;
    __host__ __device__ void init(int M, int N, int G_, int c_) { nM = M / BM; nN = N / BM; nwg = nM * nN; G = G_; c = c_; }
    __host__ __device__ bool next(int i, Unit& u) const {
        const long L = (long)i * G + c; if (L >= nwg) return false;
        int wgid = (int)L; { const int q = nwg / NXCD, r = nwg % NXCD, xcd = wgid % NXCD, off = wgid / NXCD; wgid = (xcd < r ? xcd * (q + 1) : r * (q + 1) + (xcd - r) * q) + off; }
        const int nig = WGM * nN, gid = wgid / nig, fm = gid * WGM, gsz = (nM - fm) < WGM ? (nM - fm) : WGM;
        u.pm = fm + ((wgid % nig) % gsz); u.pn = (wgid % nig) / gsz; return true;
    }
    __device__ __forceinline__ void a_ready(const Unit&) const {}
    __device__ __forceinline__ void done(const Unit&) const {}
};


__device__ __forceinline__ unsigned cvt_pk_bf16(float lo, float hi) { unsigned r; asm volatile("v_cvt_pk_bf16_f32 %0, %1, %2" : "=v"(r) : "v"(lo), "v"(hi)); return r; }
__device__ __forceinline__ float silu_f(float v) { return v * __builtin_amdgcn_rcpf(1.0f + __expf(-v)); }

struct EpiStore {
    static constexpr bool PERM = true, AFTER_DRAIN = false;
    bf16_t* O; int ldc;
    __device__ __forceinline__ void operator()(const f32x4 (&acc)[2][2][4][2], const Unit& u, int wr, int wc, int fr, int fq) const {
        const int row0 = u.pm * BM + wr * 64 + fr; const int col0 = u.pn * BM + wc * 32 + 8 * fq;
#pragma unroll
        for (int ai = 0; ai < 2; ++ai)
#pragma unroll
            for (int m = 0; m < 4; ++m) { bf16_t* rowp = O + (size_t)(row0 + ai * HALF + m * 16) * ldc + col0;
#pragma unroll
                for (int bj = 0; bj < 2; ++bj) { const f32x4 v0 = acc[ai][bj][m][0], v1 = acc[ai][bj][m][1];
                    u32x4 w; w.x = cvt_pk_bf16(v0[0], v0[1]); w.y = cvt_pk_bf16(v0[2], v0[3]); w.z = cvt_pk_bf16(v1[0], v1[1]); w.w = cvt_pk_bf16(v1[2], v1[3]);
                    *(u32x4*)(rowp + bj * HALF) = w; } }
    }
};
struct EpiSwiglu {
    static constexpr bool PERM = true, AFTER_DRAIN = false;
    bf16_t* H; int ldh;
    __device__ __forceinline__ void operator()(const f32x4 (&acc)[2][2][4][2], const Unit& u, int wr, int wc, int fr, int fq) const {
        const int row0 = u.pm * BM + wr * 64 + fr; const int hid0 = u.pn * 128 + wc * 32 + 8 * fq;
#pragma unroll
        for (int ai = 0; ai < 2; ++ai)
#pragma unroll
            for (int m = 0; m < 4; ++m) { bf16_t* rowp = H + (size_t)(row0 + ai * HALF + m * 16) * ldh + hid0;
                float h[8];
#pragma unroll
                for (int bj = 0; bj < 2; ++bj)
#pragma unroll
                    for (int e = 0; e < 4; ++e) h[4 * bj + e] = silu_f(acc[ai][bj][m][0][e]) * acc[ai][bj][m][1][e];
                u32x4 w; w.x = cvt_pk_bf16(h[0], h[1]); w.y = cvt_pk_bf16(h[2], h[3]); w.z = cvt_pk_bf16(h[4], h[5]); w.w = cvt_pk_bf16(h[6], h[7]);
                *(u32x4*)rowp = w; }
    }
};
struct EpiResid {
    static constexpr bool PERM = false, AFTER_DRAIN = false;
    float* xlat; float* xctx; const float* gate;
    const float* cw; int cw_stride;
    __device__ __forceinline__ void operator()(const f32x4 (&acc)[2][2][4][2], const Unit& u, int wr, int wc, int fr, int fq) const {
        const int row0 = u.pm * BM + wr * 64 + fr, col0 = u.pn * BM + wc * 32 + 4 * fq;
#pragma unroll
        for (int ai = 0; ai < 2; ++ai)
#pragma unroll
            for (int m = 0; m < 4; ++m) { const int row = row0 + ai * HALF + m * 16;
                float* xr; int mr;
                if (row < 65536) { xr = xlat + (size_t)row * 1024; mr = row >> 11; } else { xr = xctx + (size_t)(row - 65536) * 1024; mr = 32; }
                const float s = cw ? cw[(size_t)row * cw_stride] : 1.0f;
                if (s != 0.0f) {
                    const float* g = gate + (size_t)mr * 6144;
#pragma unroll
                    for (int bj = 0; bj < 2; ++bj)
#pragma unroll
                        for (int n = 0; n < 2; ++n) { const int c = col0 + bj * HALF + n * 16;
                            const f32x4 gv = *(const f32x4*)(g + c); f32x4 xv = *(const f32x4*)(xr + c);
                            xv = xv + gv * s * acc[ai][bj][m][n]; *(f32x4*)(xr + c) = xv; } } }
    }
};
template <class Epi, class Sched, bool ALIGN_EPI = false, bool SP2 = false>
__device__ __forceinline__ void gemm_phase(PG8_LAS unsigned char* lds, const Gemm g, const Sched& S, const Epi& E, const int tid) {
    const int wid = __builtin_amdgcn_readfirstlane(tid >> 6), lane = tid & 63, wr = wid >> 2, wc = wid & 3, fr = lane & 15, fq = lane >> 4;
    const int K = g.K, nt = K / BK;
    unsigned voffA[2], voffB[2];
#pragma unroll
    for (int i = 0; i < 2; ++i) { int R, C; stage_rc(tid * 16 + i * 8192, R, C); const int Rb = Epi::PERM ? ((R & ~31) + perm32(R & 31)) : R;
        voffA[i] = (unsigned)(R * K + C) * 2u; voffB[i] = (unsigned)(Rb * K + C) * 2u; }
    const size_t kstep = (size_t)(BK * 2);
    const size_t hstep = (size_t)HALF * K * 2;
    const size_t tstep = 2 * hstep;
    const unsigned ldsw = (unsigned)wid * 1024u;
    const int aoff = lds_byte(wr * 64 + fr, fq * 8), boff = lds_byte(wc * 32 + fr, fq * 8);
#define PG8_SA(b, h) (((b) * 2 + (h)) * HTB)
#define PG8_SB(b, h) ((4 + (b) * 2 + (h)) * HTB)
#define PG8_STAGE(bufoff, gbase, voff) do { _Pragma("unroll") for (int _i = 0; _i < 2; ++_i) \
        __builtin_amdgcn_global_load_lds((const unsigned*)((const char*)(gbase) + (voff)[_i]), (PG8_LAS unsigned*)(lds + (bufoff) + ldsw + _i * 8192), 16, 0, 0); } while (0)
#define PG8_LDA(dst, b, h) do { _Pragma("unroll") for (int m = 0; m < 4; ++m) _Pragma("unroll") for (int k = 0; k < 2; ++k) dst[m][k] = *(const PG8_LAS bf16x8*)(lds + PG8_SA(b, h) + aoff + m * 2048 + k * 1024); } while (0)
#define PG8_LDB(dst, b, h) do { _Pragma("unroll") for (int n = 0; n < 2; ++n) _Pragma("unroll") for (int k = 0; k < 2; ++k) dst[n][k] = *(const PG8_LAS bf16x8*)(lds + PG8_SB(b, h) + boff + n * 2048 + k * 1024); } while (0)
#define PG8_MMA(ai, bj, At, Bt) do { __builtin_amdgcn_s_setprio(1); _Pragma("unroll") for (int m = 0; m < 4; ++m) _Pragma("unroll") for (int n = 0; n < 2; ++n) _Pragma("unroll") for (int k = 0; k < 2; ++k) \
        acc[ai][bj][m][n] = __builtin_amdgcn_mfma_f32_16x16x32_bf16(Bt[n][k], At[m][k], acc[ai][bj][m][n], 0, 0, 0); __builtin_amdgcn_s_setprio(0); } while (0)
#define PG8_WAIT_V(n) asm volatile("s_waitcnt vmcnt(" #n ")" ::: "memory")
#define PG8_WAIT_L(n) asm volatile("s_waitcnt lgkmcnt(" #n ")" ::: "memory")
#define PG8_BAR __builtin_amdgcn_s_barrier()
#define PG8_SCHED __builtin_amdgcn_sched_barrier(0)
    Unit cur, nxt; int ui = 0;
    if (!S.next(0, cur)) return;
    f32x4 acc[2][2][4][2];
#pragma unroll
    for (int a = 0; a < 2; ++a)
#pragma unroll
        for (int b = 0; b < 2; ++b)
#pragma unroll
            for (int m = 0; m < 4; ++m)
#pragma unroll
                for (int n = 0; n < 2; ++n) acc[a][b][m][n] = (f32x4){0.f, 0.f, 0.f, 0.f};
    bf16x8 At[4][2], B0[2][2], B1[2][2];
    const char* cA = (const char*)g.A + (size_t)cur.pm * tstep; const char* cB = (const char*)g.Bt + (size_t)cur.pn * tstep;
    S.a_ready(cur);
    if constexpr (SP2) {
        PG8_STAGE(PG8_SB(0, 0), cB, voffB); PG8_STAGE(PG8_SB(0, 1), cB + hstep, voffB); PG8_STAGE(PG8_SA(0, 0), cA, voffA); PG8_STAGE(PG8_SA(0, 1), cA + hstep, voffA);
        if (wr == 1) PG8_BAR;
        PG8_WAIT_V(2); PG8_BAR;
        PG8_STAGE(PG8_SB(1, 0), cB + kstep, voffB); PG8_STAGE(PG8_SA(1, 0), cA + kstep, voffA); PG8_STAGE(PG8_SB(1, 1), cB + hstep + kstep, voffB);
        PG8_WAIT_V(6); PG8_BAR;
    } else {
        PG8_STAGE(PG8_SB(0, 0), cB, voffB); PG8_STAGE(PG8_SA(0, 0), cA, voffA); PG8_STAGE(PG8_SB(0, 1), cB + hstep, voffB); PG8_STAGE(PG8_SA(0, 1), cA + hstep, voffA);
        if (wr == 1) PG8_BAR;
        PG8_WAIT_V(4); PG8_BAR;
        PG8_STAGE(PG8_SB(1, 0), cB + kstep, voffB); PG8_STAGE(PG8_SA(1, 0), cA + kstep, voffA); PG8_STAGE(PG8_SB(1, 1), cB + hstep + kstep, voffB);
        PG8_WAIT_V(6); PG8_BAR;
    }
    for (;;) {
        const bool has_next = S.next(ui + 1, nxt);
        const char* nA = has_next ? (const char*)g.A + (size_t)nxt.pm * tstep : cA; const char* nB = has_next ? (const char*)g.Bt + (size_t)nxt.pn * tstep : cB;
        for (int t = 0; t < nt; t += 2) {
            const bool last = (t == nt - 2);
            const char* a1 = cA + (size_t)(t + 1) * kstep;
            const char* a2 = last ? nA : cA + (size_t)(t + 2) * kstep; const char* b2 = last ? nB : cB + (size_t)(t + 2) * kstep;
            const char* a3 = a2 + kstep; const char* b3 = b2 + kstep;
            if (last && has_next) S.a_ready(nxt);
            if constexpr (SP2) {
            PG8_LDB(B0, 0, 0); PG8_LDB(B1, 0, 1); PG8_SCHED; PG8_LDA(At, 0, 0); PG8_STAGE(PG8_SA(1, 1), a1 + hstep, voffA);
            PG8_WAIT_V(8); PG8_WAIT_L(0); PG8_BAR; PG8_MMA(0, 0, At, B0); PG8_MMA(0, 1, At, B1); PG8_BAR; PG8_SCHED;
            PG8_LDA(At, 0, 1); PG8_STAGE(PG8_SB(0, 0), b2, voffB); PG8_STAGE(PG8_SB(0, 1), b2 + hstep, voffB); PG8_STAGE(PG8_SA(0, 0), a2, voffA);
            PG8_WAIT_V(8); PG8_WAIT_L(0); PG8_BAR; PG8_MMA(1, 0, At, B0); PG8_MMA(1, 1, At, B1); PG8_BAR; PG8_SCHED;
            PG8_LDB(B0, 1, 0); PG8_LDB(B1, 1, 1); PG8_SCHED; PG8_LDA(At, 1, 0); PG8_STAGE(PG8_SA(0, 1), a2 + hstep, voffA);
            PG8_WAIT_V(8); PG8_WAIT_L(0); PG8_BAR; PG8_MMA(0, 0, At, B0); PG8_MMA(0, 1, At, B1); PG8_BAR; PG8_SCHED;
            PG8_LDA(At, 1, 1); PG8_STAGE(PG8_SB(1, 0), b3, voffB); PG8_STAGE(PG8_SB(1, 1), b3 + hstep, voffB); PG8_STAGE(PG8_SA(1, 0), a3, voffA);
            PG8_WAIT_V(8); PG8_WAIT_L(0); PG8_BAR; PG8_MMA(1, 0, At, B0); PG8_MMA(1, 1, At, B1); PG8_BAR; PG8_SCHED;
            } else {
            PG8_LDB(B0, 0, 0); PG8_SCHED; PG8_LDA(At, 0, 0); PG8_STAGE(PG8_SA(1, 1), a1 + hstep, voffA);
            PG8_WAIT_L(8); PG8_BAR; PG8_WAIT_L(0); PG8_MMA(0, 0, At, B0); PG8_BAR; PG8_SCHED;
            PG8_LDB(B1, 0, 1); PG8_STAGE(PG8_SB(0, 0), b2, voffB);
            PG8_BAR; PG8_WAIT_L(0); PG8_MMA(0, 1, At, B1); PG8_BAR;
            PG8_LDA(At, 0, 1); PG8_STAGE(PG8_SA(0, 0), a2, voffA);
            PG8_BAR; PG8_WAIT_L(0); PG8_MMA(1, 0, At, B0); PG8_BAR; PG8_SCHED;
            PG8_STAGE(PG8_SB(0, 1), b2 + hstep, voffB);
            PG8_WAIT_V(6); PG8_BAR; PG8_MMA(1, 1, At, B1); PG8_BAR;
            PG8_LDB(B0, 1, 0); PG8_SCHED; PG8_LDA(At, 1, 0); PG8_STAGE(PG8_SA(0, 1), a2 + hstep, voffA);
            PG8_WAIT_L(8); PG8_BAR; PG8_WAIT_L(0); PG8_MMA(0, 0, At, B0); PG8_BAR; PG8_SCHED;
            PG8_LDB(B1, 1, 1); PG8_STAGE(PG8_SB(1, 0), b3, voffB);
            PG8_BAR; PG8_WAIT_L(0); PG8_MMA(0, 1, At, B1); PG8_BAR;
            PG8_LDA(At, 1, 1); PG8_STAGE(PG8_SA(1, 0), a3, voffA);
            PG8_BAR; PG8_WAIT_L(0); PG8_MMA(1, 0, At, B0); PG8_BAR; PG8_SCHED;
            PG8_STAGE(PG8_SB(1, 1), b3 + hstep, voffB);
            PG8_WAIT_V(6); PG8_BAR; PG8_MMA(1, 1, At, B1); PG8_BAR;
            }
        }
        if constexpr (ALIGN_EPI) { if (wr == 0) PG8_BAR; }
        if constexpr (!Epi::AFTER_DRAIN) { E(acc, cur, wr, wc, fr, fq); S.done(cur); }
        if (!has_next) break;
#pragma unroll
        for (int a = 0; a < 2; ++a)
#pragma unroll
            for (int b = 0; b < 2; ++b)
#pragma unroll
                for (int m = 0; m < 4; ++m)
#pragma unroll
                    for (int n = 0; n < 2; ++n) acc[a][b][m][n] = (f32x4){0.f, 0.f, 0.f, 0.f};
        cur = nxt; cA = nA; cB = nB; ++ui;
        if constexpr (ALIGN_EPI) { if (wr == 1) PG8_BAR; }
    }
    PG8_WAIT_V(0);
    if constexpr (!ALIGN_EPI) { if (wr == 0) PG8_BAR; }
    PG8_BAR;
    if constexpr (Epi::AFTER_DRAIN) { E.fused(acc, cur, wr, wc, fr, fq, lds, wid, lane); S.done(cur); }
#undef PG8_SA
#undef PG8_SB
#undef PG8_STAGE
#undef PG8_LDA
#undef PG8_LDB
#undef PG8_MMA
#undef PG8_WAIT_V
#undef PG8_WAIT_L
#undef PG8_BAR
#undef PG8_SCHED
}
}

#ifndef PG8_SP2
#define PG8_SP2 true
#endif
#ifndef PG8_ALIGN
#define PG8_ALIGN true
#endif

constexpr int D = 1024, NB = 32, SEQ = 2048, CTXL = 256, DEPTH = 4;
constexpr int TLAT = NB * SEQ, TCTX = NB * CTXL, TT = TLAT + TCTX;
constexpr int PROJ_W = 2312, PW = 2304;
constexpr int FF = 2816, NEXP = 8;
constexpr float EPS = 1e-6f;
constexpr int PC_Q = 0, PC_K = 512, PC_V = 640, PC_Z = 768, PC_XBC = 1024, PC_HY = 1536;

constexpr size_t MiB = 1u << 20;
constexpr size_t WS_CTL = 0, CTL_ZERO_BYTES = 1 * MiB;
constexpr size_t WS_SILUC = 1 * MiB;
constexpr size_t WS_MOD = 2 * MiB;
constexpr size_t WS_DT = 6 * MiB;
constexpr size_t WS_COMB = 9 * MiB;
constexpr size_t WS_FILT = 12 * MiB;
constexpr size_t WS_FILTC = 20 * MiB;
constexpr size_t WS_WIN = 22 * MiB;
constexpr size_t WS_WOUT = 27 * MiB;
constexpr size_t WS_F1 = 29 * MiB;
constexpr size_t WS_F2 = 117 * MiB;
constexpr size_t WS_XC = 161 * MiB;
constexpr size_t WS_A = 193 * MiB;
constexpr size_t WS_PROJ = 337 * MiB;
constexpr size_t WS_HID = 337 * MiB;
constexpr size_t WS_ATT = 661 * MiB;
constexpr size_t WS_SSDY = 733 * MiB;
constexpr size_t WS_HYOT = 805 * MiB;
constexpr size_t WS_UT = 841 * MiB;
constexpr size_t WS_ZT = 949 * MiB;
constexpr size_t WS_END = 985 * MiB;
static_assert(WS_HID + (size_t)TT * FF * 2 <= WS_SSDY, "hidden overlay");
constexpr int CW_BAR = 4096;

constexpr int NWAVES = 8, NTHR = 512;
constexpr int LDS_BYTES = 155648;
constexpr int MISC_OFF = 151 * 1024;

#define GAS __attribute__((address_space(1)))
#define LAS __attribute__((address_space(3)))
typedef unsigned short bf16;
typedef unsigned v4u __attribute__((ext_vector_type(4)));
typedef unsigned v2u __attribute__((ext_vector_type(2)));
typedef float f32x4 __attribute__((ext_vector_type(4)));
#define LDS_WAIT() asm volatile("s_waitcnt lgkmcnt(0)" ::: "memory")
__device__ __forceinline__ unsigned f2bf(float f) { unsigned u = __builtin_bit_cast(unsigned, f); return (u + 0x7fffu + ((u >> 16) & 1u)) >> 16; }
__device__ __forceinline__ unsigned pk2(float lo, float hi) { return f2bf(lo) | (f2bf(hi) << 16); }
__device__ __forceinline__ float bf2f(unsigned short b) { return __builtin_bit_cast(float, ((unsigned)b) << 16); }
__device__ __forceinline__ float bflo(unsigned w) { return __builtin_bit_cast(float, w << 16); }
__device__ __forceinline__ float bfhi(unsigned w) { return __builtin_bit_cast(float, w & 0xffff0000u); }
__device__ __forceinline__ float wave_sum(float v) {
#pragma unroll
    for (int o = 1; o < 64; o <<= 1) v += __shfl_xor(v, o);
    return v;
}
__device__ __forceinline__ float silu(float v) { return v / (1.0f + __expf(-v)); }

#define XB_TMO      128
#define XB_XCNT(j)  (256  + 64 * (j))
#define XB_XSUB(j)  (1280 + 64 * (j))
#define XB_XGEN(j)  (2304 + 64 * (j))
#define XB_TOP      3328
#define XB_TOPGEN   3392
#define XCD_BAR_WORDS 3456
#define XB_SPIN_CAP (1u << 20)
__device__ __forceinline__ unsigned xb_ld(unsigned* p)              { return __hip_atomic_load(p, __ATOMIC_RELAXED, __HIP_MEMORY_SCOPE_AGENT); }
__device__ __forceinline__ unsigned xb_add(unsigned* p, unsigned v) { return __hip_atomic_fetch_add(p, v, __ATOMIC_RELAXED, __HIP_MEMORY_SCOPE_AGENT); }
__device__ __forceinline__ unsigned xb_xcc_id() { return (unsigned)__builtin_amdgcn_s_getreg((3 << 11) | 20) & 0xFu; }
#define XB_SPIN(cond, bar) do { unsigned _sp = 0; while (cond) { __builtin_amdgcn_s_sleep(1); \
    if ((++_sp & 255u) == 0u) { if (xb_ld(&(bar)[XB_TMO])) break; if (_sp > XB_SPIN_CAP) { atomicAdd(&(bar)[XB_TMO], 1u); break; } } } } while (0)
struct XcdBarrier { unsigned* bar; unsigned x; volatile LAS unsigned* st; };
__device__ __forceinline__ XcdBarrier xcd_barrier_post(unsigned* bar, volatile LAS unsigned* st) {
    XcdBarrier b; b.bar = bar; b.x = xb_xcc_id(); b.st = st;
    if (threadIdx.x == 0) (void)xb_add(&bar[XB_XCNT(b.x)], 1u);
    return b;
}
__device__ __forceinline__ void xcd_barrier_complete(unsigned* bar, unsigned x, unsigned& nloc, unsigned& nx) {
    const unsigned G = gridDim.x * gridDim.y * gridDim.z;
    unsigned sum, cnt, mine, sp = 0u;
    for (;;) {
        sum = 0u; cnt = 0u; mine = 0u;
#pragma unroll
        for (unsigned j = 0; j < 16; ++j) { const unsigned c = xb_ld(&bar[XB_XCNT(j)]); sum += c; cnt += (c > 0u) ? 1u : 0u; mine = (j == x) ? c : mine; }
        if (sum == G) break;
        __builtin_amdgcn_s_sleep(1);
        if ((++sp & 255u) == 0u) { if (xb_ld(&bar[XB_TMO])) break; if (sp > XB_SPIN_CAP) { atomicAdd(&bar[XB_TMO], 1u); break; } }
    }
    nloc = mine > 0u ? mine : 1u; nx = cnt > 0u ? cnt : 1u;
}
__device__ __forceinline__ void xcd_barrier(const XcdBarrier& b) {
    asm volatile("s_waitcnt vmcnt(0)" ::: "memory");
    __syncthreads();
    if (threadIdx.x == 0) {
        unsigned* bar = b.bar;
        __builtin_amdgcn_s_waitcnt(0);
        unsigned nloc = b.st[0], nx = b.st[1];
        if (nloc == 0u) { xcd_barrier_complete(bar, b.x, nloc, nx); b.st[0] = nloc; b.st[1] = nx; }
        const unsigned old = xb_add(&bar[XB_XSUB(b.x)], 1u);
        const unsigned gen = old / nloc;
        if (old + 1u == (gen + 1u) * nloc) {
            __builtin_amdgcn_fence(__ATOMIC_RELEASE, "agent");
            asm volatile("s_waitcnt vmcnt(0)" ::: "memory");
            const unsigned og = xb_add(&bar[XB_TOP], 1u);
            const unsigned tg = og / nx;
            if (og + 1u == (tg + 1u) * nx) xb_add(&bar[XB_TOPGEN], 1u);
            else XB_SPIN(xb_ld(&bar[XB_TOPGEN]) == tg, bar);
            __builtin_amdgcn_fence(__ATOMIC_ACQUIRE, "agent");
            xb_add(&bar[XB_XGEN(b.x)], 1u);
            asm volatile("s_waitcnt vmcnt(0)" ::: "memory");
        } else {
            XB_SPIN(xb_ld(&bar[XB_XGEN(b.x)]) == gen, bar);
            __builtin_amdgcn_fence(__ATOMIC_ACQUIRE, "agent");
            asm volatile("s_waitcnt vmcnt(0)" ::: "memory");
        }
    }
    __syncthreads();
}

struct Args { const float* in[38]; float* out; unsigned char* ws; int ph_lo, ph_hi, pad0, pad1; };
enum { I_X = 0, I_C, I_CTX, I_CCTX, I_WADA, I_BADA, I_NORM1, I_NORM2, I_WIN, I_WOUT, I_QNORM, I_KNORM, I_SINKS, I_ATTON, I_SCW, I_SCB, I_SDTB, I_SALOG, I_SD, I_SNORM,
       I_HCW, I_HCB, I_HW1, I_HB1, I_HF1, I_HW2, I_HB2, I_HF2, I_HW3, I_HBIAS, I_HON, I_FG, I_FU, I_FD, I_MR, I_MG, I_MU, I_MD };

struct Ctx {
    const float* const* in; float* out; unsigned char* ws; LAS unsigned char* lds;
    int tid, lane, wave, bid, G;
};
#define WSP(type, off) ((type*)(C.ws + (off)))

__device__ __forceinline__ void phase_siluc(const Ctx& C) {
    float* sc = WSP(float, WS_SILUC);
    for (int i = C.bid * NTHR + C.tid; i < 33 * 1024; i += C.G * NTHR) {
        const int r = i >> 10, k = i & 1023; const float v = (r < 32) ? C.in[I_C][r * 1024 + k] : C.in[I_CCTX][k];
        sc[i] = silu(v);
    }
}

template <class SRC>
__device__ __forceinline__ void conv_item(const SRC& S, int K, int ld, bf16* WT, LAS float* scr, int item, int nblk, int lane) {
    const int kb = item / nblk, nb = item % nblk, k0 = 64 * kb, r0 = 32 * nb;
    const float* sp; int col; S(r0 + (lane & 31), sp, col);
#pragma unroll 8
    for (int i = 0; i < 32; ++i) { const int kk = 2 * i + (lane >> 5); scr[kk * 33 + (lane & 31)] = sp[(size_t)(k0 + kk) * ld + col]; }
    LDS_WAIT(); asm volatile("" ::: "memory");
    const int c = lane & 7;
#pragma unroll
    for (int j = 0; j < 4; ++j) { const int n = (lane >> 3) + 8 * j; const LAS float* s = scr + (8 * c) * 33 + n;
        v4u o; o.x = pk2(s[0 * 33], s[1 * 33]); o.y = pk2(s[2 * 33], s[3 * 33]); o.z = pk2(s[4 * 33], s[5 * 33]); o.w = pk2(s[6 * 33], s[7 * 33]);
        *(v4u*)(WT + (size_t)(r0 + n) * K + k0 + 8 * c) = o; }
    LDS_WAIT(); asm volatile("" ::: "memory");
}
struct SrcWin { const float* w; __device__ __forceinline__ void operator()(int rho, const float*& p, int& col) const { p = w; col = rho < 1536 ? rho : rho + 8; } };
struct SrcPlain { const float* w; __device__ __forceinline__ void operator()(int rho, const float*& p, int& col) const { p = w; col = rho; } };
struct SrcGU { const float* g; const float* u; __device__ __forceinline__ void operator()(int rho, const float*& p, int& col) const {
    const int pn = rho >> 8, r = rho & 255, bj = r >> 7, wc = (r >> 5) & 3, fq = (r >> 3) & 3, n = (r >> 2) & 1, e = r & 3;
    p = (const float*)((const char*)g + (long)n * ((const char*)u - (const char*)g)); col = 128 * pn + 32 * wc + 8 * fq + 4 * bj + e; } };

__device__ __forceinline__ void hy_filter_item(const Ctx& C, int layer, int item) {
    const bool lat = item < 64; const int L = lat ? 2048 : 256; const int pos0 = 32 * (lat ? item : item - 64);
    LAS float* z = (LAS float*)C.lds;
    LAS float* h1 = z + 32 * 33;
    LAS float* h2 = h1 + 32 * 64;
    const float* w1 = C.in[I_HW1] + (size_t)layer * 33 * 64; const float* b1 = C.in[I_HB1] + layer * 64; const float* f1 = C.in[I_HF1] + layer * 64;
    const float* w2 = C.in[I_HW2] + (size_t)layer * 64 * 64; const float* b2 = C.in[I_HB2] + layer * 64; const float* f2 = C.in[I_HF2] + layer * 64;
    const float* w3 = C.in[I_HW3] + (size_t)layer * 64 * 1024; const float* hb = C.in[I_HBIAS] + (size_t)layer * 512;
    __syncthreads();
    for (int t = C.tid; t < 32 * 33; t += NTHR) { const int p = t / 33, j = t % 33; const int i = pos0 + p;
        const float tt = (float)i / (float)(L - 1); const float wv = (6.283185307179586f / (float)L) * (float)i;
        float v;
        if (j == 0) v = tt;
        else { const int jj = (j - 1) & 15; const float fr = 1e-4f + (float)jj * ((15.0f - 1e-4f) / 15.0f); const float a = fr * wv; v = (j <= 16) ? cosf(a) : -sinf(a); }
        z[p * 33 + j] = v; }
    __syncthreads();
    for (int t = C.tid; t < 32 * 64; t += NTHR) { const int p = t >> 6, k = t & 63; float s = b1[k];
        for (int j = 0; j < 33; ++j) s += z[p * 33 + j] * w1[j * 64 + k];
        h1[p * 64 + k] = sinf(f1[k] * s); }
    __syncthreads();
    for (int t = C.tid; t < 32 * 64; t += NTHR) { const int p = t >> 6, k = t & 63; float s = b2[k];
        for (int j = 0; j < 64; ++j) s += h1[p * 64 + j] * w2[j * 64 + k];
        h2[p * 64 + k] = sinf(f2[k] * s); }
    __syncthreads();
    const float dmin = -3.0701134573253946f, dmax = -15.350567286626973f;
    float* FL = lat ? WSP(float, WS_FILT) : WSP(float, WS_FILTC); const int FS = lat ? 4096 : 512;
    for (int o = C.tid; o < 1024; o += NTHR) {
        float acc[32];
#pragma unroll
        for (int p = 0; p < 32; ++p) acc[p] = 0.f;
        for (int j = 0; j < 64; ++j) { const float w = w3[j * 1024 + o];
#pragma unroll
            for (int p = 0; p < 32; ++p) acc[p] += h2[p * 64 + j] * w; }
        const int dir = o >> 9, order = (o >> 8) & 1, c = o & 255;
        const float delta = fabsf(dmin + (float)c * ((dmax - dmin) / 255.0f));
        float* fo = FL + ((size_t)order * 256 + c) * FS;
#pragma unroll
        for (int p = 0; p < 32; ++p) { const int lag = pos0 + p; const float tt = (float)lag / (float)(L - 1);
            float v = acc[p] * expf(-tt * delta);
            if (dir == 0) { if (lag == 0) v += hb[order * 256 + c]; fo[(L - 1) - lag] = v; }
            else if (lag >= 1) fo[(L - 1) + lag] = v; }
    }
    __syncthreads();
}

__device__ __forceinline__ void phase_pre(const Ctx& C, int layer) {
    LAS float* scr = (LAS float*)(C.lds + C.wave * 8448);
    const int gw = C.bid * NWAVES + C.wave, NGW = C.G * NWAVES;
    const bool moe = layer & 1; const int j2 = layer >> 1;
    {
        const SrcWin s_in{C.in[I_WIN] + (size_t)layer * D * PROJ_W};
        const SrcPlain s_out{C.in[I_WOUT] + (size_t)layer * D * D};
        constexpr int I_IN = 16 * (PW / 32), I_OUT = 16 * 32, I_F1 = 16 * (2 * FF / 32), I_F2 = (FF / 64) * 32;
        const int ne = moe ? NEXP : 1;
        const int nitems = I_IN + I_OUT + ne * (I_F1 + I_F2);
        for (int it = gw; it < nitems; it += NGW) {
            int r = it;
            if (r < I_IN) { conv_item(s_in, D, PROJ_W, WSP(bf16, WS_WIN), scr, r, PW / 32, C.lane); continue; } r -= I_IN;
            if (r < I_OUT) { conv_item(s_out, D, D, WSP(bf16, WS_WOUT), scr, r, 32, C.lane); continue; } r -= I_OUT;
            const int e = r / (I_F1 + I_F2); r -= e * (I_F1 + I_F2);
            const float *wg, *wu, *wd;
            if (moe) { const size_t o = ((size_t)j2 * NEXP + e) * (size_t)D * FF; wg = C.in[I_MG] + o; wu = C.in[I_MU] + o; wd = C.in[I_MD] + o; }
            else { const size_t o = (size_t)j2 * D * FF; wg = C.in[I_FG] + o; wu = C.in[I_FU] + o; wd = C.in[I_FD] + o; }
            if (r < I_F1) { const SrcGU s{wg, wu}; conv_item(s, D, FF, WSP(bf16, WS_F1) + (size_t)e * 2 * FF * D, scr, r, 2 * FF / 32, C.lane); }
            else { const SrcPlain s{wd}; conv_item(s, FF, D, WSP(bf16, WS_F2) + (size_t)e * D * FF, scr, r - I_F1, 32, C.lane); }
        }
    }
    __syncthreads();
    {
        const float* sc = WSP(float, WS_SILUC); const float* wa = C.in[I_WADA] + (size_t)layer * D * 6144; const float* ba = C.in[I_BADA] + (size_t)layer * 6144;
        float* mod = WSP(float, WS_MOD) + (size_t)layer * 33 * 6144;
        LAS float* part = (LAS float*)C.lds;
        for (int grp = C.bid; grp < 96; grp += C.G) {
            const int n = grp * 64 + C.lane; float acc[33];
#pragma unroll
            for (int r = 0; r < 33; ++r) acc[r] = 0.f;
            const int k0 = C.wave * 128;
            for (int k = k0; k < k0 + 128; ++k) { const float w = wa[(size_t)k * 6144 + n];
#pragma unroll
                for (int r = 0; r < 33; ++r) acc[r] += sc[r * 1024 + k] * w; }
            __syncthreads();
#pragma unroll
            for (int r = 0; r < 33; ++r) part[(C.wave * 33 + r) * 64 + C.lane] = acc[r];
            __syncthreads();
            for (int o = C.tid; o < 33 * 64; o += NTHR) { const int r = o >> 6, l = o & 63; float s = ba[grp * 64 + l];
#pragma unroll
                for (int w = 0; w < 8; ++w) s += part[(w * 33 + r) * 64 + l];
                mod[(size_t)r * 6144 + grp * 64 + l] = s; }
        }
    }
    __syncthreads();
    for (int it = C.bid; it < 72; it += C.G) hy_filter_item(C, layer, it);
    __syncthreads();
}

__device__ __forceinline__ void phase_norm(const Ctx& C, int layer, int which) {
    LAS float* wx = (LAS float*)C.lds;
    const bool moe = layer & 1; const bool need_extra = (which == 0) || moe;
    __syncthreads();
    if (need_extra) {
        for (int i = C.tid; i < 1024 * 8; i += NTHR) { const int k = i >> 3, j = i & 7;
            wx[i] = (which == 0) ? C.in[I_WIN][(size_t)layer * D * PROJ_W + (size_t)k * PROJ_W + 1536 + j] : C.in[I_MR][(size_t)(layer >> 1) * D * 8 + i]; }
    }
    __syncthreads();
    const float* gn = (which == 0 ? C.in[I_NORM1] : C.in[I_NORM2]) + layer * D;
    const float* mod = WSP(float, WS_MOD) + (size_t)layer * 33 * 6144;
    const int i_sh = which == 0 ? 0 : 3, i_sc = which == 0 ? 1 : 4;
    bf16* O = WSP(bf16, WS_A);
    const int gw = C.bid * NWAVES + C.wave, NGW = C.G * NWAVES;
    const int nrows = (which == 1 && layer == DEPTH - 1) ? TLAT : TT;
    for (int m = gw; m < nrows; m += NGW) {
        const bool lat = m < TLAT; const int mr = lat ? (m >> 11) : 32;
        const float* xin; float* xcopy = nullptr;
        if (which == 0 && layer == 0) { xin = lat ? C.in[I_X] + (size_t)m * D : C.in[I_CTX] + (size_t)(m - TLAT) * D; xcopy = lat ? C.out + (size_t)m * D : WSP(float, WS_XC) + (size_t)(m - TLAT) * D; }
        else xin = lat ? C.out + (size_t)m * D : WSP(float, WS_XC) + (size_t)(m - TLAT) * D;
        const f32x4* xr = (const f32x4*)xin + C.lane;
        f32x4 v[4]; float ss = 0.f;
#pragma unroll
        for (int j = 0; j < 4; ++j) { v[j] = xr[64 * j]; ss += (v[j].x * v[j].x + v[j].y * v[j].y) + (v[j].z * v[j].z + v[j].w * v[j].w); }
        if (xcopy) {
#pragma unroll
            for (int j = 0; j < 4; ++j) ((f32x4*)xcopy + C.lane)[64 * j] = v[j]; }
        const float rstd = rsqrtf(wave_sum(ss) * (1.0f / D) + EPS);
        const float* msh = mod + (size_t)mr * 6144 + i_sh * 1024; const float* msc = mod + (size_t)mr * 6144 + i_sc * 1024;
        float ex[8];
#pragma unroll
        for (int j = 0; j < 8; ++j) ex[j] = 0.f;
        unsigned long long* o8 = (unsigned long long*)(O + (size_t)m * D) + C.lane;
#pragma unroll
        for (int j = 0; j < 4; ++j) {
            const int k = 4 * C.lane + 256 * j;
            const f32x4 g = *(const f32x4*)(gn + k), sh = *(const f32x4*)(msh + k), sc = *(const f32x4*)(msc + k);
            f32x4 h = v[j] * rstd * g * (1.0f + sc) + sh;
            o8[64 * j] = (unsigned long long)pk2(h.x, h.y) | ((unsigned long long)pk2(h.z, h.w) << 32);
            if (need_extra) {
#pragma unroll
                for (int e = 0; e < 4; ++e) { const f32x4 w0 = *(const LAS f32x4*)(wx + (k + e) * 8), w1 = *(const LAS f32x4*)(wx + (k + e) * 8 + 4);
                    ex[0] += h[e] * w0.x; ex[1] += h[e] * w0.y; ex[2] += h[e] * w0.z; ex[3] += h[e] * w0.w; ex[4] += h[e] * w1.x; ex[5] += h[e] * w1.y; ex[6] += h[e] * w1.z; ex[7] += h[e] * w1.w; }
            }
        }
        if (need_extra) {
#pragma unroll
            for (int j = 0; j < 8; ++j) ex[j] = wave_sum(ex[j]);
            if (which == 0) { if (C.lane == 0) { float* d = WSP(float, WS_DT) + (size_t)m * 8; *(f32x4*)d = (f32x4){ex[0], ex[1], ex[2], ex[3]}; *(f32x4*)(d + 4) = (f32x4){ex[4], ex[5], ex[6], ex[7]}; } }
            else if (C.lane == 0) {
                int i0 = 0; float v0 = ex[0];
#pragma unroll
                for (int j = 1; j < 8; ++j) if (ex[j] > v0) { v0 = ex[j]; i0 = j; }
                int i1 = -1; float v1 = -3.0e38f;
#pragma unroll
                for (int j = 0; j < 8; ++j) if (j != i0 && ex[j] > v1) { v1 = ex[j]; i1 = j; }
                const float e1 = __expf(v1 - v0); const float w0 = 1.0f / (1.0f + e1), w1 = e1 / (1.0f + e1);
                float cb[8];
#pragma unroll
                for (int j = 0; j < 8; ++j) cb[j] = (j == i0) ? w0 : ((j == i1) ? w1 : 0.f);
                float* d = WSP(float, WS_COMB) + (size_t)m * 8; *(f32x4*)d = (f32x4){cb[0], cb[1], cb[2], cb[3]}; *(f32x4*)(d + 4) = (f32x4){cb[4], cb[5], cb[6], cb[7]};
            }
        }
    }
    __syncthreads();
}

__device__ __forceinline__ void phase_prep(const Ctx& C, int layer) {
    bf16* P = WSP(bf16, WS_PROJ);
    const float* qn = C.in[I_QNORM] + layer * 64; const float* kn = C.in[I_KNORM] + layer * 64;
    const long nit = (long)TT * 10;
    for (long it = (long)C.bid * NTHR + C.tid; it < nit; it += (long)C.G * NTHR) {
        const int m = (int)(it / 10), s = (int)(it % 10);
        const bool isq = s < 8; const int col = isq ? PC_Q + 64 * s : PC_K + 64 * (s - 8);
        v4u* p = (v4u*)(P + (size_t)m * PW + col);
        float v[64]; float ss = 0.f;
#pragma unroll
        for (int j = 0; j < 8; ++j) { const v4u w = p[j];
            v[8 * j + 0] = bflo(w.x); v[8 * j + 1] = bfhi(w.x); v[8 * j + 2] = bflo(w.y); v[8 * j + 3] = bfhi(w.y); v[8 * j + 4] = bflo(w.z); v[8 * j + 5] = bfhi(w.z); v[8 * j + 6] = bflo(w.w); v[8 * j + 7] = bfhi(w.w); }
#pragma unroll
        for (int d = 0; d < 64; ++d) ss += v[d] * v[d];
        const float rstd = rsqrtf(ss * (1.0f / 64.0f) + EPS);
        const float* g = isq ? qn : kn;
#pragma unroll
        for (int d = 0; d < 64; ++d) v[d] = v[d] * rstd * g[d];
        if (m < TLAT) {
            const int t = m & 2047; const float pr = (float)(t >> 6), pc = (float)(t & 63);
#pragma unroll
            for (int a = 0; a < 2; ++a)
#pragma unroll
                for (int f = 0; f < 16; ++f) {
                    const float inv = expf(-(float)(2 * f) * (9.210340371976184f / 32.0f));
                    const float ang = (a == 0 ? pr : pc) * inv; float sn, cs; sincosf(ang, &sn, &cs);
                    const float x1 = v[32 * a + f], x2 = v[32 * a + 16 + f];
                    v[32 * a + f] = x1 * cs - x2 * sn; v[32 * a + 16 + f] = x1 * sn + x2 * cs; }
        }
        const float scl = isq ? 0.125f : 1.0f;
#pragma unroll
        for (int j = 0; j < 8; ++j) { v4u w; w.x = pk2(v[8 * j] * scl, v[8 * j + 1] * scl); w.y = pk2(v[8 * j + 2] * scl, v[8 * j + 3] * scl); w.z = pk2(v[8 * j + 4] * scl, v[8 * j + 5] * scl); w.w = pk2(v[8 * j + 6] * scl, v[8 * j + 7] * scl); p[j] = w; }
    }
    const float* cw = C.in[I_HCW] + (size_t)layer * 3 * 768; const float* cb = C.in[I_HCB] + (size_t)layer * 768;
    bf16* UT = WSP(bf16, WS_UT);
    const long nit2 = (long)TT * 96;
    for (long it = (long)C.bid * NTHR + C.tid; it < nit2; it += (long)C.G * NTHR) {
        const int m = (int)(it / 96), c8 = (int)(it % 96);
        const int t = m < TLAT ? (m & 2047) : ((m - TLAT) & 255); const int L = m < TLAT ? 2048 : 256;
        const v4u zero = (v4u){0u, 0u, 0u, 0u};
        const v4u a0 = t > 0 ? *(const v4u*)(P + (size_t)(m - 1) * PW + PC_HY + 8 * c8) : zero;
        const v4u a1 = *(const v4u*)(P + (size_t)m * PW + PC_HY + 8 * c8);
        const v4u a2 = t < L - 1 ? *(const v4u*)(P + (size_t)(m + 1) * PW + PC_HY + 8 * c8) : zero;
        const unsigned w0[4] = {a0.x, a0.y, a0.z, a0.w}, w1[4] = {a1.x, a1.y, a1.z, a1.w}, w2[4] = {a2.x, a2.y, a2.z, a2.w};
#pragma unroll
        for (int e = 0; e < 8; ++e) { const int ch = 8 * c8 + e;
            const float x0 = (e & 1) ? bfhi(w0[e >> 1]) : bflo(w0[e >> 1]), x1 = (e & 1) ? bfhi(w1[e >> 1]) : bflo(w1[e >> 1]), x2 = (e & 1) ? bfhi(w2[e >> 1]) : bflo(w2[e >> 1]);
            const float y = cw[ch] * x0 + cw[768 + ch] * x1 + cw[1536 + ch] * x2 + cb[ch];
            UT[(size_t)ch * TT + m] = (bf16)f2bf(y); }
    }
}

__device__ __forceinline__ void att_key(const bf16* P, int krow, int kcol, int vcol, const float (&q)[64], float& mx, float& l, float (&acc)[64]) {
    const v4u* kp = (const v4u*)(P + (size_t)krow * PW + kcol);
    float s = 0.f;
#pragma unroll
    for (int j = 0; j < 8; ++j) { const v4u w = kp[j];
        s += q[8 * j] * bflo(w.x) + q[8 * j + 1] * bfhi(w.x) + q[8 * j + 2] * bflo(w.y) + q[8 * j + 3] * bfhi(w.y) + q[8 * j + 4] * bflo(w.z) + q[8 * j + 5] * bfhi(w.z) + q[8 * j + 6] * bflo(w.w) + q[8 * j + 7] * bfhi(w.w); }
    if (s > mx) { const float cr = __expf(mx - s); l *= cr;
#pragma unroll
        for (int d = 0; d < 64; ++d) acc[d] *= cr;
        mx = s; }
    const float p = __expf(s - mx); l += p;
    const v4u* vp = (const v4u*)(P + (size_t)krow * PW + vcol);
#pragma unroll
    for (int j = 0; j < 8; ++j) { const v4u w = vp[j];
        acc[8 * j] += p * bflo(w.x); acc[8 * j + 1] += p * bfhi(w.x); acc[8 * j + 2] += p * bflo(w.y); acc[8 * j + 3] += p * bfhi(w.y); acc[8 * j + 4] += p * bflo(w.z); acc[8 * j + 5] += p * bfhi(w.z); acc[8 * j + 6] += p * bflo(w.w); acc[8 * j + 7] += p * bfhi(w.w); }
}
__device__ __forceinline__ void phase_att_naive(const Ctx& C, int layer) {
    const bf16* P = WSP(bf16, WS_PROJ); bf16* AO = WSP(bf16, WS_ATT);
    const float* sinks = C.in[I_SINKS] + layer * 8;
    const bool last = layer == DEPTH - 1;
    const long nit = (long)(last ? TLAT : TT) * 8;
    for (long it = (long)C.bid * NTHR + C.tid; it < nit; it += (long)C.G * NTHR) {
        const int m = (int)(it >> 3), hd = (int)(it & 7), kvh = hd >> 2;
        float q[64], acc[64];
        { const v4u* qp = (const v4u*)(P + (size_t)m * PW + PC_Q + 64 * hd);
#pragma unroll
          for (int j = 0; j < 8; ++j) { const v4u w = qp[j];
            q[8 * j] = bflo(w.x); q[8 * j + 1] = bfhi(w.x); q[8 * j + 2] = bflo(w.y); q[8 * j + 3] = bfhi(w.y); q[8 * j + 4] = bflo(w.z); q[8 * j + 5] = bfhi(w.z); q[8 * j + 6] = bflo(w.w); q[8 * j + 7] = bfhi(w.w); } }
#pragma unroll
        for (int d = 0; d < 64; ++d) acc[d] = 0.f;
        float mx = -3.0e38f, l = 0.f;
        const int kcol = PC_K + 64 * kvh, vcol = PC_V + 64 * kvh;
        int b;
        if (m < TLAT) { b = m >> 11; const int t = m & 2047; const int j0 = t - 128 < 0 ? 0 : t - 128, j1 = t + 128 > 2047 ? 2047 : t + 128;
            for (int j = j0; j <= j1; ++j) att_key(P, b * 2048 + j, kcol, vcol, q, mx, l, acc); }
        else b = (m - TLAT) >> 8;
        for (int j = 0; j < 256; ++j) att_key(P, TLAT + b * 256 + j, kcol, vcol, q, mx, l, acc);
        const float sk = sinks[hd];
        if (sk > mx) { const float cr = __expf(mx - sk); l *= cr;
#pragma unroll
            for (int d = 0; d < 64; ++d) acc[d] *= cr;
            mx = sk; }
        l += __expf(sk - mx);
        const float il = 1.0f / l;
        v4u* op = (v4u*)(AO + (size_t)m * 512 + 64 * hd);
#pragma unroll
        for (int j = 0; j < 8; ++j) { v4u w; w.x = pk2(acc[8 * j] * il, acc[8 * j + 1] * il); w.y = pk2(acc[8 * j + 2] * il, acc[8 * j + 3] * il); w.z = pk2(acc[8 * j + 4] * il, acc[8 * j + 5] * il); w.w = pk2(acc[8 * j + 6] * il, acc[8 * j + 7] * il); op[j] = w; }
    }
}

__device__ __forceinline__ float conv3_at(const bf16* P, int m, int t, int L, int col, const float* cw, const float* cb) {
    const float x1 = bf2f(P[(size_t)m * PW + col]);
    const float x0 = t > 0 ? bf2f(P[(size_t)(m - 1) * PW + col]) : 0.f;
    const float x2 = t < L - 1 ? bf2f(P[(size_t)(m + 1) * PW + col]) : 0.f;
    const int cc = col - PC_XBC;
    return cw[cc] * x0 + cw[512 + cc] * x1 + cw[1024 + cc] * x2 + cb[cc];
}
__device__ __forceinline__ void phase_ssd_naive(const Ctx& C, int layer) {
    const int gw = C.bid * NWAVES + C.wave, NGW = C.G * NWAVES;
    const bf16* P = WSP(bf16, WS_PROJ); const float* DTR = WSP(float, WS_DT); bf16* Y = WSP(bf16, WS_SSDY);
    const float* cw = C.in[I_SCW] + (size_t)layer * 3 * 512; const float* cb = C.in[I_SCB] + (size_t)layer * 512;
    for (int u = gw; u < NB * 4 * 2; u += NGW) {
        const int b = u >> 3, h = (u >> 1) & 3, dir = u & 1, g = h >> 1, p = C.lane;
        const float a = -expf(C.in[I_SALOG][layer * 8 + dir * 4 + h]); const float dtb = C.in[I_SDTB][layer * 8 + dir * 4 + h]; const float dsk = C.in[I_SD][layer * 4 + h];
        float hs[64];
#pragma unroll
        for (int n = 0; n < 64; ++n) hs[n] = 0.f;
        for (int seg = 0; seg < 2; ++seg) {
            const int L = seg == 0 ? CTXL : SEQ; const int base = seg == 0 ? TLAT + b * CTXL : b * SEQ;
            for (int st = 0; st < L; ++st) {
                const int t = dir ? (L - 1 - st) : st; const int m = base + t;
                const float xs = silu(conv3_at(P, m, t, L, PC_XBC + 64 * h + p, cw, cb));
                const float Bv = silu(conv3_at(P, m, t, L, PC_XBC + 256 + 64 * g + p, cw, cb));
                const float Cv = silu(conv3_at(P, m, t, L, PC_XBC + 384 + 64 * g + p, cw, cb));
                const float dr = DTR[(size_t)m * 8 + dir * 4 + h] + dtb;
                const float dt = dr > 20.f ? dr : log1pf(expf(dr));
                const float dec = expf(dt * a); const float dx = dt * xs;
                float y = 0.f;
#pragma unroll
                for (int n = 0; n < 64; ++n) { const float bn = __builtin_bit_cast(float, __builtin_amdgcn_readlane(__builtin_bit_cast(int, Bv), n)); const float cn = __builtin_bit_cast(float, __builtin_amdgcn_readlane(__builtin_bit_cast(int, Cv), n));
                    hs[n] = hs[n] * dec + dx * bn; y += cn * hs[n]; }
                if (dir == 0) y += xs * dsk;
                Y[((size_t)dir * TT + m) * 256 + 64 * h + p] = (bf16)f2bf(y);
            }
        }
    }
}

__device__ __forceinline__ void phase_hy_naive(const Ctx& C, int layer, int stage) {
    const int gw = C.bid * NWAVES + C.wave, NGW = C.G * NWAVES;
    const bf16* UT = WSP(bf16, WS_UT); bf16* ZT = WSP(bf16, WS_ZT); bf16* HO = WSP(bf16, WS_HYOT);
    const bool last = layer == DEPTH - 1;
    const int nlat = 256 * NB * (SEQ / 64), nctx = last ? 0 : 256 * NB * (CTXL / 64);
    for (int it = gw; it < nlat + nctx; it += NGW) {
        int c, b, tb, L, base; const float* F;
        if (it < nlat) { c = it / (NB * 32); const int r = it % (NB * 32); b = r / 32; tb = r % 32; L = SEQ; base = b * SEQ; F = WSP(float, WS_FILT) + ((size_t)stage * 256 + c) * 4096; }
        else { const int i2 = it - nlat; c = i2 / (NB * 4); const int r = i2 % (NB * 4); b = r / 4; tb = r % 4; L = CTXL; base = TLAT + b * CTXL; F = WSP(float, WS_FILTC) + ((size_t)stage * 256 + c) * 512; }
        const int t = tb * 64 + C.lane;
        const bf16* u = (stage == 0 ? UT + (size_t)c * TT : ZT + (size_t)c * TT) + base;
        const float* f = F + (L - 1) - t;
        float acc = 0.f;
        for (int s = 0; s < L; s += 8) { const v4u w = *(const v4u*)(u + s);
            acc += f[s] * bflo(w.x) + f[s + 1] * bfhi(w.x) + f[s + 2] * bflo(w.y) + f[s + 3] * bfhi(w.y) + f[s + 4] * bflo(w.z) + f[s + 5] * bfhi(w.z) + f[s + 6] * bflo(w.w) + f[s + 7] * bfhi(w.w); }
        const float mul = bf2f(UT[((size_t)(stage + 1) * 256 + c) * TT + base + t]);
        (stage == 0 ? ZT : HO)[(size_t)c * TT + base + t] = (bf16)f2bf(acc * mul);
    }
}

__device__ __forceinline__ void phase_merge(const Ctx& C, int layer) {
    const int gw = C.bid * NWAVES + C.wave, NGW = C.G * NWAVES;
    const bf16* AO = WSP(bf16, WS_ATT); const bf16* SY = WSP(bf16, WS_SSDY); const bf16* HO = WSP(bf16, WS_HYOT); const bf16* P = WSP(bf16, WS_PROJ);
    bf16* Y = WSP(bf16, WS_A);
    const float* g_att = C.in[I_ATTON] + layer * 512; const float* g_ssd = C.in[I_SNORM] + layer * 256; const float* g_hy = C.in[I_HON] + layer * 256;
    const int nrows = (layer == DEPTH - 1) ? TLAT : TT;
    for (int m = gw; m < nrows; m += NGW) {
        { const v4u w = *((const v4u*)(AO + (size_t)m * 512) + C.lane);
          float v[8] = {bflo(w.x), bfhi(w.x), bflo(w.y), bfhi(w.y), bflo(w.z), bfhi(w.z), bflo(w.w), bfhi(w.w)}; float ss = 0.f;
#pragma unroll
          for (int e = 0; e < 8; ++e) ss += v[e] * v[e];
          const float rstd = rsqrtf(wave_sum(ss) * (1.0f / 512.0f) + EPS);
          const float* g = g_att + 8 * C.lane;
          v4u o; o.x = pk2(v[0] * rstd * g[0], v[1] * rstd * g[1]); o.y = pk2(v[2] * rstd * g[2], v[3] * rstd * g[3]); o.z = pk2(v[4] * rstd * g[4], v[5] * rstd * g[5]); o.w = pk2(v[6] * rstd * g[6], v[7] * rstd * g[7]);
          *((v4u*)(Y + (size_t)m * D) + C.lane) = o; }
        { const v2u w0 = *((const v2u*)(SY + (size_t)m * 256) + C.lane), w1 = *((const v2u*)(SY + ((size_t)TT + m) * 256) + C.lane), wz = *((const v2u*)(P + (size_t)m * PW + PC_Z) + C.lane);
          float v[4] = {bflo(w0.x) + bflo(w1.x), bfhi(w0.x) + bfhi(w1.x), bflo(w0.y) + bflo(w1.y), bfhi(w0.y) + bfhi(w1.y)};
          const float z[4] = {bflo(wz.x), bfhi(wz.x), bflo(wz.y), bfhi(wz.y)}; float ss = 0.f;
#pragma unroll
          for (int e = 0; e < 4; ++e) { v[e] *= silu(z[e]); ss += v[e] * v[e]; }
          const float rstd = rsqrtf(wave_sum(ss) * (1.0f / 256.0f) + EPS);
          const float* g = g_ssd + 4 * C.lane;
          v2u o; o.x = pk2(v[0] * rstd * g[0], v[1] * rstd * g[1]); o.y = pk2(v[2] * rstd * g[2], v[3] * rstd * g[3]);
          *((v2u*)(Y + (size_t)m * D + 512) + C.lane) = o; }
        { float v[4]; float ss = 0.f;
#pragma unroll
          for (int e = 0; e < 4; ++e) { v[e] = bf2f(HO[(size_t)(4 * C.lane + e) * TT + m]); ss += v[e] * v[e]; }
          ss += __shfl_xor(ss, 1); ss += __shfl_xor(ss, 2); ss += __shfl_xor(ss, 4); ss += __shfl_xor(ss, 8);
          const float rstd = rsqrtf(ss * (1.0f / 64.0f) + EPS);
          const float* g = g_hy + 4 * C.lane;
          v2u o; o.x = pk2(v[0] * rstd * g[0], v[1] * rstd * g[1]); o.y = pk2(v[2] * rstd * g[2], v[3] * rstd * g[3]);
          *((v2u*)(Y + (size_t)m * D + 768) + C.lane) = o; }
    }
}

constexpr int NPL = 25;
constexpr int NPHASES = 1 + DEPTH * NPL;
__global__ void __launch_bounds__(NTHR, 2) mega_fwd(Args args) {
    extern __shared__ __attribute__((aligned(16))) unsigned char lds_raw[];
    Ctx C0; C0.in = args.in; C0.out = args.out; C0.ws = args.ws; C0.lds = (LAS unsigned char*)lds_raw;
    C0.tid = threadIdx.x; C0.lane = C0.tid & 63; C0.wave = __builtin_amdgcn_readfirstlane(C0.tid >> 6); C0.bid = blockIdx.x; C0.G = gridDim.x;
    const Ctx& C = C0;
    volatile LAS unsigned* MISC = (volatile LAS unsigned*)(C.lds + MISC_OFF);
    if (C.tid < 64) MISC[C.tid] = 0u;
    __syncthreads();
    const int lo = args.ph_lo, hi = args.ph_hi;
    const bool multi = (hi - lo) > 1;
    XcdBarrier bar; bar.bar = (unsigned*)(C.ws + WS_CTL) + CW_BAR; bar.x = 0; bar.st = MISC + 8;
    if (multi) bar = xcd_barrier_post((unsigned*)(C.ws + WS_CTL) + CW_BAR, MISC + 8);
    int ph = 0;
#ifndef PHMASK
#define PHMASK 0xffffffffu
#endif
#define PHM(i) ((PHMASK >> (i)) & 1u)
#define PH_BEGIN if (ph >= lo && ph < hi) { Ctx C = C0; { unsigned long long _b = (unsigned long long)C0.out, _c = (unsigned long long)C0.ws; int _t = C0.tid; \
        asm volatile("" : "+s"(_b), "+s"(_c), "+v"(_t)); C.out = (float*)_b; C.ws = (unsigned char*)_c; C.tid = _t; C.lane = _t & 63; C.wave = __builtin_amdgcn_readfirstlane(_t >> 6); }
#define PH_END } if (ph >= lo && ph + 1 < hi) xcd_barrier(bar); ++ph;

    PH_BEGIN if (PHM(0)) phase_siluc(C); PH_END
    for (int layer = 0; layer < DEPTH; ++layer) {
        const bool last = layer == DEPTH - 1; const bool moe = layer & 1;
        PH_BEGIN if (PHM(1)) phase_pre(C, layer); PH_END
        PH_BEGIN if (PHM(2)) phase_norm(C, layer, 0); PH_END
        PH_BEGIN if (PHM(3)) { pg8::Gemm g{WSP(bf16, WS_A), WSP(bf16, WS_WIN), TT, PW, D}; pg8::StaticOrder S; S.init(TT, PW, C.G, C.bid);
                   pg8::EpiStore E{WSP(bf16, WS_PROJ), PW};
                   pg8::gemm_phase<pg8::EpiStore, pg8::StaticOrder, PG8_ALIGN, PG8_SP2>(C.lds, g, S, E, C.tid); } PH_END
        PH_BEGIN if (PHM(4)) phase_prep(C, layer); PH_END
        PH_BEGIN if (PHM(5)) phase_att_naive(C, layer); if (PHM(6)) phase_ssd_naive(C, layer); if (PHM(7)) phase_hy_naive(C, layer, 0); PH_END
        PH_BEGIN if (PHM(8)) phase_hy_naive(C, layer, 1); PH_END
        PH_BEGIN if (PHM(9)) phase_merge(C, layer); PH_END
        PH_BEGIN if (PHM(10)) { const int M = last ? TLAT : TT; pg8::Gemm g{WSP(bf16, WS_A), WSP(bf16, WS_WOUT), M, D, D}; pg8::StaticOrder S; S.init(M, D, C.G, C.bid);
                   pg8::EpiResid E{C.out, WSP(float, WS_XC), WSP(float, WS_MOD) + (size_t)layer * 33 * 6144 + 2 * 1024, nullptr, 0};
                   pg8::gemm_phase<pg8::EpiResid, pg8::StaticOrder, PG8_ALIGN, PG8_SP2>(C.lds, g, S, E, C.tid); } PH_END
        PH_BEGIN if (PHM(11)) phase_norm(C, layer, 1); PH_END
        for (int e = 0; e < NEXP; ++e) {
            const bool act = moe || e == 0; const int M = last ? TLAT : TT;
            PH_BEGIN if (PHM(12) && act) { pg8::Gemm g{WSP(bf16, WS_A), WSP(bf16, WS_F1) + (size_t)e * 2 * FF * D, M, 2 * FF, D}; pg8::StaticOrder S; S.init(M, 2 * FF, C.G, C.bid);
                   pg8::EpiSwiglu E{WSP(bf16, WS_HID), FF};
                   pg8::gemm_phase<pg8::EpiSwiglu, pg8::StaticOrder, PG8_ALIGN, PG8_SP2>(C.lds, g, S, E, C.tid); } PH_END
            PH_BEGIN if (PHM(13) && act) { pg8::Gemm g{WSP(bf16, WS_HID), WSP(bf16, WS_F2) + (size_t)e * D * FF, M, D, FF}; pg8::StaticOrder S; S.init(M, D, C.G, C.bid);
                   pg8::EpiResid E{C.out, WSP(float, WS_XC), WSP(float, WS_MOD) + (size_t)layer * 33 * 6144 + 5 * 1024, moe ? WSP(float, WS_COMB) + e : nullptr, 8};
                   pg8::gemm_phase<pg8::EpiResid, pg8::StaticOrder, PG8_ALIGN, PG8_SP2>(C.lds, g, S, E, C.tid); } PH_END
        }
    }
#undef PH_BEGIN
#undef PH_END
}

#ifndef MK_ONE_LAUNCH
#define MK_ONE_LAUNCH 0
#endif
extern "C" void kernel_launch(void* const* d_in, const int* in_sizes, int n_in, void* d_out, int out_size, void* d_ws, size_t ws_size, hipStream_t stream) {
    static int grid = 0;
    if (grid == 0) {
        if (n_in != 38 || out_size != TLAT * D || ws_size < WS_END) { fprintf(stderr, "kernel_launch: unexpected shapes (n_in %d, out %d, ws %zu)\n", n_in, out_size, ws_size); grid = -1; return; }
        int dev = 0, cus = 0, per_cu = 0;
        if (hipGetDevice(&dev) != hipSuccess || hipDeviceGetAttribute(&cus, hipDeviceAttributeMultiprocessorCount, dev) != hipSuccess) { grid = -1; return; }
        if (hipFuncSetAttribute((const void*)mega_fwd, hipFuncAttributeMaxDynamicSharedMemorySize, LDS_BYTES) != hipSuccess) { fprintf(stderr, "kernel_launch: hipFuncSetAttribute failed\n"); grid = -1; return; }
        if (hipOccupancyMaxActiveBlocksPerMultiprocessor(&per_cu, (const void*)mega_fwd, NTHR, LDS_BYTES) != hipSuccess || per_cu < 1) { fprintf(stderr, "kernel_launch: occupancy query says %d\n", per_cu); (void)hipGetLastError(); grid = -1; return; }
        grid = cus;
    }
    if (grid < 0) return;
    (void)hipMemsetAsync((char*)d_ws + WS_CTL, 0, CTL_ZERO_BYTES, stream);
    Args a{};
    for (int i = 0; i < 38; ++i) a.in[i] = (const float*)d_in[i];
    a.out = (float*)d_out; a.ws = (unsigned char*)d_ws;
#if MK_ONE_LAUNCH
    a.ph_lo = 0; a.ph_hi = NPHASES;
    hipLaunchKernelGGL(mega_fwd, dim3(grid), dim3(NTHR), LDS_BYTES, stream, a);
#else
    for (int ph = 0; ph < NPHASES; ++ph) {
        const int r = ph == 0 ? -1 : (ph - 1) % NPL, layer = ph == 0 ? 0 : (ph - 1) / NPL;
        if (r >= 9 && !(layer & 1) && r >= 11) continue;
        a.ph_lo = ph; a.ph_hi = ph + 1;
        hipLaunchKernelGGL(mega_fwd, dim3(grid), dim3(NTHR), LDS_BYTES, stream, a);
    }
#endif
}
```

```cpp
#include <hip/hip_runtime.h>
#include <cstdio>
#include <cstdint>
namespace pg8 {
#define PG8_LAS __attribute__((address_space(3)))
typedef unsigned short bf16_t;
typedef short bf16x8 __attribute__((ext_vector_type(8)));
typedef float f32x4 __attribute__((ext_vector_type(4)));
typedef unsigned u32x4 __attribute__((ext_vector_type(4)));
constexpr int BM = 256, BK = 64, HALF = 128, HTB = HALF * BK * 2  , STAGE_BYTES = 8 * HTB, NXCD = 8, WGM = 8;

__host__ __device__ __forceinline__ int lds_byte(int r, int c) { const int st = (r >> 4) * 2 + (c >> 5), rr = r & 15, cc = c & 31, ob = rr * 64 + cc * 2; return st * 1024 + (ob ^ (((ob >> 9) & 1) << 5)); }
__host__ __device__ __forceinline__ void stage_rc(int b, int& R, int& C) { const int st = b / 1024, sb = b % 1024, swz = sb ^ (((sb >> 9) & 1) << 5); R = (st >> 1) * 16 + swz / 64; C = (st & 1) * 32 + (swz % 64) / 2; }
__host__ __device__ __forceinline__ int perm32(int rho) { const int n = rho >> 4, i = rho & 15; return 8 * (i >> 2) + 4 * n + (i & 3); }

struct Unit { int pm, pn; };
struct Gemm { const bf16_t* A; const bf16_t* Bt; int M, N, K; };

struct StaticOrder {
    int nM, nN, nwg, G, c;
    __host__ __device__ void init(int M, int N, int G_, int c_) { nM = M / BM; nN = N / BM; nwg = nM * nN; G = G_; c = c_; }
    __host__ __device__ bool next(int i, Unit& u) const {
        const long L = (long)i * G + c; if (L >= nwg) return false;
        int wgid = (int)L; { const int q = nwg / NXCD, r = nwg % NXCD, xcd = wgid % NXCD, off = wgid / NXCD; wgid = (xcd < r ? xcd * (q + 1) : r * (q + 1) + (xcd - r) * q) + off; }
        const int nig = WGM * nN, gid = wgid / nig, fm = gid * WGM, gsz = (nM - fm) < WGM ? (nM - fm) : WGM;
        u.pm = fm + ((wgid % nig) % gsz); u.pn = (wgid % nig) / gsz; return true;
    }
    __device__ __forceinline__ void a_ready(const Unit&) const {}
    __device__ __forceinline__ void done(const Unit&) const {}
};


__device__ __forceinline__ unsigned cvt_pk_bf16(float lo, float hi) { unsigned r; asm volatile("v_cvt_pk_bf16_f32 %0, %1, %2" : "=v"(r) : "v"(lo), "v"(hi)); return r; }
__device__ __forceinline__ float silu_f(float v) { return v * __builtin_amdgcn_rcpf(1.0f + __expf(-v)); }

struct EpiStore {
    static constexpr bool PERM = true, AFTER_DRAIN = false;
    bf16_t* O; int ldc;
    __device__ __forceinline__ void operator()(const f32x4 (&acc)[2][2][4][2], const Unit& u, int wr, int wc, int fr, int fq) const {
        const int row0 = u.pm * BM + wr * 64 + fr; const int col0 = u.pn * BM + wc * 32 + 8 * fq;
#pragma unroll
        for (int ai = 0; ai < 2; ++ai)
#pragma unroll
            for (int m = 0; m < 4; ++m) { bf16_t* rowp = O + (size_t)(row0 + ai * HALF + m * 16) * ldc + col0;
#pragma unroll
                for (int bj = 0; bj < 2; ++bj) { const f32x4 v0 = acc[ai][bj][m][0], v1 = acc[ai][bj][m][1];
                    u32x4 w; w.x = cvt_pk_bf16(v0[0], v0[1]); w.y = cvt_pk_bf16(v0[2], v0[3]); w.z = cvt_pk_bf16(v1[0], v1[1]); w.w = cvt_pk_bf16(v1[2], v1[3]);
                    *(u32x4*)(rowp + bj * HALF) = w; } }
    }
};
struct EpiSwiglu {
    static constexpr bool PERM = true, AFTER_DRAIN = false;
    bf16_t* H; int ldh;
    __device__ __forceinline__ void operator()(const f32x4 (&acc)[2][2][4][2], const Unit& u, int wr, int wc, int fr, int fq) const {
        const int row0 = u.pm * BM + wr * 64 + fr; const int hid0 = u.pn * 128 + wc * 32 + 8 * fq;
#pragma unroll
        for (int ai = 0; ai < 2; ++ai)
#pragma unroll
            for (int m = 0; m < 4; ++m) { bf16_t* rowp = H + (size_t)(row0 + ai * HALF + m * 16) * ldh + hid0;
                float h[8];
#pragma unroll
                for (int bj = 0; bj < 2; ++bj)
#pragma unroll
                    for (int e = 0; e < 4; ++e) h[4 * bj + e] = silu_f(acc[ai][bj][m][0][e]) * acc[ai][bj][m][1][e];
                u32x4 w; w.x = cvt_pk_bf16(h[0], h[1]); w.y = cvt_pk_bf16(h[2], h[3]); w.z = cvt_pk_bf16(h[4], h[5]); w.w = cvt_pk_bf16(h[6], h[7]);
                *(u32x4*)rowp = w; }
    }
};
struct EpiResid {
    static constexpr bool PERM = false, AFTER_DRAIN = false;
    float* xlat; float* xctx; const float* gate;
    const float* cw; int cw_stride;
    __device__ __forceinline__ void operator()(const f32x4 (&acc)[2][2][4][2], const Unit& u, int wr, int wc, int fr, int fq) const {
        const int row0 = u.pm * BM + wr * 64 + fr, col0 = u.pn * BM + wc * 32 + 4 * fq;
#pragma unroll
        for (int ai = 0; ai < 2; ++ai)
#pragma unroll
            for (int m = 0; m < 4; ++m) { const int row = row0 + ai * HALF + m * 16;
                float* xr; int mr;
                if (row < 65536) { xr = xlat + (size_t)row * 1024; mr = row >> 11; } else { xr = xctx + (size_t)(row - 65536) * 1024; mr = 32; }
                const float s = cw ? cw[(size_t)row * cw_stride] : 1.0f;
                if (s != 0.0f) {
                    const float* g = gate + (size_t)mr * 6144;
#pragma unroll
                    for (int bj = 0; bj < 2; ++bj)
#pragma unroll
                        for (int n = 0; n < 2; ++n) { const int c = col0 + bj * HALF + n * 16;
                            const f32x4 gv = *(const f32x4*)(g + c); f32x4 xv = *(const f32x4*)(xr + c);
                            xv = xv + gv * s * acc[ai][bj][m][n]; *(f32x4*)(xr + c) = xv; } } }
    }
};
template <class Epi, class Sched, bool ALIGN_EPI = false, bool SP2 = false>
__device__ __forceinline__ void gemm_phase(PG8_LAS unsigned char* lds, const Gemm g, const Sched& S, const Epi& E, const int tid) {
    const int wid = __builtin_amdgcn_readfirstlane(tid >> 6), lane = tid & 63, wr = wid >> 2, wc = wid & 3, fr = lane & 15, fq = lane >> 4;
    const int K = g.K, nt = K / BK;
    unsigned voffA[2], voffB[2];
#pragma unroll
    for (int i = 0; i < 2; ++i) { int R, C; stage_rc(tid * 16 + i * 8192, R, C); const int Rb = Epi::PERM ? ((R & ~31) + perm32(R & 31)) : R;
        voffA[i] = (unsigned)(R * K + C) * 2u; voffB[i] = (unsigned)(Rb * K + C) * 2u; }
    const size_t kstep = (size_t)(BK * 2);
    const size_t hstep = (size_t)HALF * K * 2;
    const size_t tstep = 2 * hstep;
    const unsigned ldsw = (unsigned)wid * 1024u;
    const int aoff = lds_byte(wr * 64 + fr, fq * 8), boff = lds_byte(wc * 32 + fr, fq * 8);
#define PG8_SA(b, h) (((b) * 2 + (h)) * HTB)
#define PG8_SB(b, h) ((4 + (b) * 2 + (h)) * HTB)
#define PG8_STAGE(bufoff, gbase, voff) do { _Pragma("unroll") for (int _i = 0; _i < 2; ++_i) \
        __builtin_amdgcn_global_load_lds((const unsigned*)((const char*)(gbase) + (voff)[_i]), (PG8_LAS unsigned*)(lds + (bufoff) + ldsw + _i * 8192), 16, 0, 0); } while (0)
#define PG8_LDA(dst, b, h) do { _Pragma("unroll") for (int m = 0; m < 4; ++m) _Pragma("unroll") for (int k = 0; k < 2; ++k) dst[m][k] = *(const PG8_LAS bf16x8*)(lds + PG8_SA(b, h) + aoff + m * 2048 + k * 1024); } while (0)
#define PG8_LDB(dst, b, h) do { _Pragma("unroll") for (int n = 0; n < 2; ++n) _Pragma("unroll") for (int k = 0; k < 2; ++k) dst[n][k] = *(const PG8_LAS bf16x8*)(lds + PG8_SB(b, h) + boff + n * 2048 + k * 1024); } while (0)
#define PG8_MMA(ai, bj, At, Bt) do { __builtin_amdgcn_s_setprio(1); _Pragma("unroll") for (int m = 0; m < 4; ++m) _Pragma("unroll") for (int n = 0; n < 2; ++n) _Pragma("unroll") for (int k = 0; k < 2; ++k) \
        acc[ai][bj][m][n] = __builtin_amdgcn_mfma_f32_16x16x32_bf16(Bt[n][k], At[m][k], acc[ai][bj][m][n], 0, 0, 0); __builtin_amdgcn_s_setprio(0); } while (0)
#define PG8_WAIT_V(n) asm volatile("s_waitcnt vmcnt(" #n ")" ::: "memory")
#define PG8_WAIT_L(n) asm volatile("s_waitcnt lgkmcnt(" #n ")" ::: "memory")
#define PG8_BAR __builtin_amdgcn_s_barrier()
#define PG8_SCHED __builtin_amdgcn_sched_barrier(0)
    Unit cur, nxt; int ui = 0;
    if (!S.next(0, cur)) return;
    f32x4 acc[2][2][4][2];
#pragma unroll
    for (int a = 0; a < 2; ++a)
#pragma unroll
        for (int b = 0; b < 2; ++b)
#pragma unroll
            for (int m = 0; m < 4; ++m)
#pragma unroll
                for (int n = 0; n < 2; ++n) acc[a][b][m][n] = (f32x4){0.f, 0.f, 0.f, 0.f};
    bf16x8 At[4][2], B0[2][2], B1[2][2];
    const char* cA = (const char*)g.A + (size_t)cur.pm * tstep; const char* cB = (const char*)g.Bt + (size_t)cur.pn * tstep;
    S.a_ready(cur);
    if constexpr (SP2) {
        PG8_STAGE(PG8_SB(0, 0), cB, voffB); PG8_STAGE(PG8_SB(0, 1), cB + hstep, voffB); PG8_STAGE(PG8_SA(0, 0), cA, voffA); PG8_STAGE(PG8_SA(0, 1), cA + hstep, voffA);
        if (wr == 1) PG8_BAR;
        PG8_WAIT_V(2); PG8_BAR;
        PG8_STAGE(PG8_SB(1, 0), cB + kstep, voffB); PG8_STAGE(PG8_SA(1, 0), cA + kstep, voffA); PG8_STAGE(PG8_SB(1, 1), cB + hstep + kstep, voffB);
        PG8_WAIT_V(6); PG8_BAR;
    } else {
        PG8_STAGE(PG8_SB(0, 0), cB, voffB); PG8_STAGE(PG8_SA(0, 0), cA, voffA); PG8_STAGE(PG8_SB(0, 1), cB + hstep, voffB); PG8_STAGE(PG8_SA(0, 1), cA + hstep, voffA);
        if (wr == 1) PG8_BAR;
        PG8_WAIT_V(4); PG8_BAR;
        PG8_STAGE(PG8_SB(1, 0), cB + kstep, voffB); PG8_STAGE(PG8_SA(1, 0), cA + kstep, voffA); PG8_STAGE(PG8_SB(1, 1), cB + hstep + kstep, voffB);
        PG8_WAIT_V(6); PG8_BAR;
    }
    for (;;) {
        const bool has_next = S.next(ui + 1, nxt);
        const char* nA = has_next ? (const char*)g.A + (size_t)nxt.pm * tstep : cA; const char* nB = has_next ? (const char*)g.Bt + (size_t)nxt.pn * tstep : cB;
        for (int t = 0; t < nt; t += 2) {
            const bool last = (t == nt - 2);
            const char* a1 = cA + (size_t)(t + 1) * kstep;
            const char* a2 = last ? nA : cA + (size_t)(t + 2) * kstep; const char* b2 = last ? nB : cB + (size_t)(t + 2) * kstep;
            const char* a3 = a2 + kstep; const char* b3 = b2 + kstep;
            if (last && has_next) S.a_ready(nxt);
            if constexpr (SP2) {
            PG8_LDB(B0, 0, 0); PG8_LDB(B1, 0, 1); PG8_SCHED; PG8_LDA(At, 0, 0); PG8_STAGE(PG8_SA(1, 1), a1 + hstep, voffA);
            PG8_WAIT_V(8); PG8_WAIT_L(0); PG8_BAR; PG8_MMA(0, 0, At, B0); PG8_MMA(0, 1, At, B1); PG8_BAR; PG8_SCHED;
            PG8_LDA(At, 0, 1); PG8_STAGE(PG8_SB(0, 0), b2, voffB); PG8_STAGE(PG8_SB(0, 1), b2 + hstep, voffB); PG8_STAGE(PG8_SA(0, 0), a2, voffA);
            PG8_WAIT_V(8); PG8_WAIT_L(0); PG8_BAR; PG8_MMA(1, 0, At, B0); PG8_MMA(1, 1, At, B1); PG8_BAR; PG8_SCHED;
            PG8_LDB(B0, 1, 0); PG8_LDB(B1, 1, 1); PG8_SCHED; PG8_LDA(At, 1, 0); PG8_STAGE(PG8_SA(0, 1), a2 + hstep, voffA);
            PG8_WAIT_V(8); PG8_WAIT_L(0); PG8_BAR; PG8_MMA(0, 0, At, B0); PG8_MMA(0, 1, At, B1); PG8_BAR; PG8_SCHED;
            PG8_LDA(At, 1, 1); PG8_STAGE(PG8_SB(1, 0), b3, voffB); PG8_STAGE(PG8_SB(1, 1), b3 + hstep, voffB); PG8_STAGE(PG8_SA(1, 0), a3, voffA);
            PG8_WAIT_V(8); PG8_WAIT_L(0); PG8_BAR; PG8_MMA(1, 0, At, B0); PG8_MMA(1, 1, At, B1); PG8_BAR; PG8_SCHED;
            } else {
            PG8_LDB(B0, 0, 0); PG8_SCHED; PG8_LDA(At, 0, 0); PG8_STAGE(PG8_SA(1, 1), a1 + hstep, voffA);
            PG8_WAIT_L(8); PG8_BAR; PG8_WAIT_L(0); PG8_MMA(0, 0, At, B0); PG8_BAR; PG8_SCHED;
            PG8_LDB(B1, 0, 1); PG8_STAGE(PG8_SB(0, 0), b2, voffB);
            PG8_BAR; PG8_WAIT_L(0); PG8_MMA(0, 1, At, B1); PG8_BAR;
            PG8_LDA(At, 0, 1); PG8_STAGE(PG8_SA(0, 0), a2, voffA);
            PG8_BAR; PG8_WAIT_L(0); PG8_MMA(1, 0, At, B0); PG8_BAR; PG8_SCHED;
            PG8_STAGE(PG8_SB(0, 1), b2 + hstep, voffB);
            PG8_WAIT_V(6); PG8_BAR; PG8_MMA(1, 1, At, B1); PG8_BAR;
            PG8_LDB(B0, 1, 0); PG8_SCHED; PG8_LDA(At, 1, 0); PG8_STAGE(PG8_SA(0, 1), a2 + hstep, voffA);
            PG8_WAIT_L(8); PG8_BAR; PG8_WAIT_L(0); PG8_MMA(0, 0, At, B0); PG8_BAR; PG8_SCHED;
            PG8_LDB(B1, 1, 1); PG8_STAGE(PG8_SB(1, 0), b3, voffB);
            PG8_BAR; PG8_WAIT_L(0); PG8_MMA(0, 1, At, B1); PG8_BAR;
            PG8_LDA(At, 1, 1); PG8_STAGE(PG8_SA(1, 0), a3, voffA);
            PG8_BAR; PG8_WAIT_L(0); PG8_MMA(1, 0, At, B0); PG8_BAR; PG8_SCHED;
            PG8_STAGE(PG8_SB(1, 1), b3 + hstep, voffB);
            PG8_WAIT_V(6); PG8_BAR; PG8_MMA(1, 1, At, B1); PG8_BAR;
            }
        }
        if constexpr (ALIGN_EPI) { if (wr == 0) PG8_BAR; }
        if constexpr (!Epi::AFTER_DRAIN) { E(acc, cur, wr, wc, fr, fq); S.done(cur); }
        if (!has_next) break;
#pragma unroll
        for (int a = 0; a < 2; ++a)
#pragma unroll
            for (int b = 0; b < 2; ++b)
#pragma unroll
                for (int m = 0; m < 4; ++m)
#pragma unroll
                    for (int n = 0; n < 2; ++n) acc[a][b][m][n] = (f32x4){0.f, 0.f, 0.f, 0.f};
        cur = nxt; cA = nA; cB = nB; ++ui;
        if constexpr (ALIGN_EPI) { if (wr == 1) PG8_BAR; }
    }
    PG8_WAIT_V(0);
    if constexpr (!ALIGN_EPI) { if (wr == 0) PG8_BAR; }
    PG8_BAR;
    if constexpr (Epi::AFTER_DRAIN) { E.fused(acc, cur, wr, wc, fr, fq, lds, wid, lane); S.done(cur); }
#undef PG8_SA
#undef PG8_SB
#undef PG8_STAGE
#undef PG8_LDA
#undef PG8_LDB
#undef PG8_MMA
#undef PG8_WAIT_V
#undef PG8_WAIT_L
#undef PG8_BAR
#undef PG8_SCHED
}
}

#ifndef PG8_SP2
#define PG8_SP2 true
#endif
#ifndef PG8_ALIGN
#define PG8_ALIGN true
#endif

constexpr int D = 1024, NB = 32, SEQ = 2048, CTXL = 256, DEPTH = 4;
constexpr int TLAT = NB * SEQ, TCTX = NB * CTXL, TT = TLAT + TCTX;
constexpr int PROJ_W = 2312, PW = 2304;
constexpr int FF = 2816, NEXP = 8;
constexpr float EPS = 1e-6f;
constexpr int PC_Q = 0, PC_K = 512, PC_V = 640, PC_Z = 768, PC_XBC = 1024, PC_HY = 1536;

constexpr size_t MiB = 1u << 20;
constexpr size_t WS_CTL = 0, CTL_ZERO_BYTES = 1 * MiB;
constexpr size_t WS_SILUC = 1 * MiB;
constexpr size_t WS_MOD = 2 * MiB;
constexpr size_t WS_DT = 6 * MiB;
constexpr size_t WS_COMB = 9 * MiB;
constexpr size_t WS_FILT = 12 * MiB;
constexpr size_t WS_FILTC = 20 * MiB;
constexpr size_t WS_WIN = 22 * MiB;
constexpr size_t WS_WOUT = 27 * MiB;
constexpr size_t WS_F1 = 29 * MiB;
constexpr size_t WS_F2 = 117 * MiB;
constexpr size_t WS_XC = 161 * MiB;
constexpr size_t WS_A = 193 * MiB;
constexpr size_t WS_PROJ = 337 * MiB;
constexpr size_t WS_HID = 337 * MiB;
constexpr size_t WS_ATT = 661 * MiB;
constexpr size_t WS_SSDY = 733 * MiB;
constexpr size_t WS_HYOT = 805 * MiB;
constexpr size_t WS_UT = 841 * MiB;
constexpr size_t WS_ZT = 949 * MiB;
constexpr size_t WS_END = 985 * MiB;
static_assert(WS_HID + (size_t)TT * FF * 2 <= WS_SSDY, "hidden overlay");
constexpr int CW_BAR = 4096;

constexpr int NWAVES = 8, NTHR = 512;
constexpr int LDS_BYTES = 155648;
constexpr int MISC_OFF = 151 * 1024;

#define GAS __attribute__((address_space(1)))
#define LAS __attribute__((address_space(3)))
typedef unsigned short bf16;
typedef unsigned v4u __attribute__((ext_vector_type(4)));
typedef unsigned v2u __attribute__((ext_vector_type(2)));
typedef float f32x4 __attribute__((ext_vector_type(4)));
typedef short bf16x8 __attribute__((ext_vector_type(8)));
typedef float f32x16 __attribute__((ext_vector_type(16)));
#define HY_MFMA(a, b, c) __builtin_amdgcn_mfma_f32_32x32x16_bf16((a), (b), (c), 0, 0, 0)
#define LDS_WAIT() asm volatile("s_waitcnt lgkmcnt(0)" ::: "memory")
__device__ __forceinline__ unsigned f2bf(float f) { unsigned u = __builtin_bit_cast(unsigned, f); return (u + 0x7fffu + ((u >> 16) & 1u)) >> 16; }
__device__ __forceinline__ unsigned pk2(float lo, float hi) { return f2bf(lo) | (f2bf(hi) << 16); }
__device__ __forceinline__ float bf2f(unsigned short b) { return __builtin_bit_cast(float, ((unsigned)b) << 16); }
__device__ __forceinline__ float bflo(unsigned w) { return __builtin_bit_cast(float, w << 16); }
__device__ __forceinline__ float bfhi(unsigned w) { return __builtin_bit_cast(float, w & 0xffff0000u); }
__device__ __forceinline__ float wave_sum(float v) {
#pragma unroll
    for (int o = 1; o < 64; o <<= 1) v += __shfl_xor(v, o);
    return v;
}
__device__ __forceinline__ float silu(float v) { return v / (1.0f + __expf(-v)); }

#define XB_TMO      128
#define XB_XCNT(j)  (256  + 64 * (j))
#define XB_XSUB(j)  (1280 + 64 * (j))
#define XB_XGEN(j)  (2304 + 64 * (j))
#define XB_TOP      3328
#define XB_TOPGEN   3392
#define XCD_BAR_WORDS 3456
#define XB_SPIN_CAP (1u << 20)
__device__ __forceinline__ unsigned xb_ld(unsigned* p)              { return __hip_atomic_load(p, __ATOMIC_RELAXED, __HIP_MEMORY_SCOPE_AGENT); }
__device__ __forceinline__ unsigned xb_add(unsigned* p, unsigned v) { return __hip_atomic_fetch_add(p, v, __ATOMIC_RELAXED, __HIP_MEMORY_SCOPE_AGENT); }
__device__ __forceinline__ unsigned xb_xcc_id() { return (unsigned)__builtin_amdgcn_s_getreg((3 << 11) | 20) & 0xFu; }
#define XB_SPIN(cond, bar) do { unsigned _sp = 0; while (cond) { __builtin_amdgcn_s_sleep(1); \
    if ((++_sp & 255u) == 0u) { if (xb_ld(&(bar)[XB_TMO])) break; if (_sp > XB_SPIN_CAP) { atomicAdd(&(bar)[XB_TMO], 1u); break; } } } } while (0)
struct XcdBarrier { unsigned* bar; unsigned x; volatile LAS unsigned* st; };
__device__ __forceinline__ XcdBarrier xcd_barrier_post(unsigned* bar, volatile LAS unsigned* st) {
    XcdBarrier b; b.bar = bar; b.x = xb_xcc_id(); b.st = st;
    if (threadIdx.x == 0) (void)xb_add(&bar[XB_XCNT(b.x)], 1u);
    return b;
}
__device__ __forceinline__ void xcd_barrier_complete(unsigned* bar, unsigned x, unsigned& nloc, unsigned& nx) {
    const unsigned G = gridDim.x * gridDim.y * gridDim.z;
    unsigned sum, cnt, mine, sp = 0u;
    for (;;) {
        sum = 0u; cnt = 0u; mine = 0u;
#pragma unroll
        for (unsigned j = 0; j < 16; ++j) { const unsigned c = xb_ld(&bar[XB_XCNT(j)]); sum += c; cnt += (c > 0u) ? 1u : 0u; mine = (j == x) ? c : mine; }
        if (sum == G) break;
        __builtin_amdgcn_s_sleep(1);
        if ((++sp & 255u) == 0u) { if (xb_ld(&bar[XB_TMO])) break; if (sp > XB_SPIN_CAP) { atomicAdd(&bar[XB_TMO], 1u); break; } }
    }
    nloc = mine > 0u ? mine : 1u; nx = cnt > 0u ? cnt : 1u;
}
__device__ __forceinline__ void xcd_barrier(const XcdBarrier& b) {
    asm volatile("s_waitcnt vmcnt(0)" ::: "memory");
    __syncthreads();
    if (threadIdx.x == 0) {
        unsigned* bar = b.bar;
        __builtin_amdgcn_s_waitcnt(0);
        unsigned nloc = b.st[0], nx = b.st[1];
        if (nloc == 0u) { xcd_barrier_complete(bar, b.x, nloc, nx); b.st[0] = nloc; b.st[1] = nx; }
        const unsigned old = xb_add(&bar[XB_XSUB(b.x)], 1u);
        const unsigned gen = old / nloc;
        if (old + 1u == (gen + 1u) * nloc) {
            __builtin_amdgcn_fence(__ATOMIC_RELEASE, "agent");
            asm volatile("s_waitcnt vmcnt(0)" ::: "memory");
            const unsigned og = xb_add(&bar[XB_TOP], 1u);
            const unsigned tg = og / nx;
            if (og + 1u == (tg + 1u) * nx) xb_add(&bar[XB_TOPGEN], 1u);
            else XB_SPIN(xb_ld(&bar[XB_TOPGEN]) == tg, bar);
            __builtin_amdgcn_fence(__ATOMIC_ACQUIRE, "agent");
            xb_add(&bar[XB_XGEN(b.x)], 1u);
            asm volatile("s_waitcnt vmcnt(0)" ::: "memory");
        } else {
            XB_SPIN(xb_ld(&bar[XB_XGEN(b.x)]) == gen, bar);
            __builtin_amdgcn_fence(__ATOMIC_ACQUIRE, "agent");
            asm volatile("s_waitcnt vmcnt(0)" ::: "memory");
        }
    }
    __syncthreads();
}

struct Args { const float* in[38]; float* out; unsigned char* ws; int ph_lo, ph_hi, pad0, pad1; };
enum { I_X = 0, I_C, I_CTX, I_CCTX, I_WADA, I_BADA, I_NORM1, I_NORM2, I_WIN, I_WOUT, I_QNORM, I_KNORM, I_SINKS, I_ATTON, I_SCW, I_SCB, I_SDTB, I_SALOG, I_SD, I_SNORM,
       I_HCW, I_HCB, I_HW1, I_HB1, I_HF1, I_HW2, I_HB2, I_HF2, I_HW3, I_HBIAS, I_HON, I_FG, I_FU, I_FD, I_MR, I_MG, I_MU, I_MD };

struct Ctx {
    const float* const* in; float* out; unsigned char* ws; LAS unsigned char* lds;
    int tid, lane, wave, bid, G;
};
#define WSP(type, off) ((type*)(C.ws + (off)))

__device__ __forceinline__ void phase_siluc(const Ctx& C) {
    float* sc = WSP(float, WS_SILUC);
    for (int i = C.bid * NTHR + C.tid; i < 33 * 1024; i += C.G * NTHR) {
        const int r = i >> 10, k = i & 1023; const float v = (r < 32) ? C.in[I_C][r * 1024 + k] : C.in[I_CCTX][k];
        sc[i] = silu(v);
    }
}

template <class SRC>
__device__ __forceinline__ void conv_item(const SRC& S, int K, int ld, bf16* WT, LAS float* scr, int item, int nblk, int lane) {
    const int kb = item / nblk, nb = item % nblk, k0 = 64 * kb, r0 = 32 * nb;
    const float* sp; int col; S(r0 + (lane & 31), sp, col);
#pragma unroll 8
    for (int i = 0; i < 32; ++i) { const int kk = 2 * i + (lane >> 5); scr[kk * 33 + (lane & 31)] = sp[(size_t)(k0 + kk) * ld + col]; }
    LDS_WAIT(); asm volatile("" ::: "memory");
    const int c = lane & 7;
#pragma unroll
    for (int j = 0; j < 4; ++j) { const int n = (lane >> 3) + 8 * j; const LAS float* s = scr + (8 * c) * 33 + n;
        v4u o; o.x = pk2(s[0 * 33], s[1 * 33]); o.y = pk2(s[2 * 33], s[3 * 33]); o.z = pk2(s[4 * 33], s[5 * 33]); o.w = pk2(s[6 * 33], s[7 * 33]);
        *(v4u*)(WT + (size_t)(r0 + n) * K + k0 + 8 * c) = o; }
    LDS_WAIT(); asm volatile("" ::: "memory");
}
struct SrcWin { const float* w; __device__ __forceinline__ void operator()(int rho, const float*& p, int& col) const { p = w; col = rho < 1536 ? rho : rho + 8; } };
struct SrcPlain { const float* w; __device__ __forceinline__ void operator()(int rho, const float*& p, int& col) const { p = w; col = rho; } };
struct SrcGU { const float* g; const float* u; __device__ __forceinline__ void operator()(int rho, const float*& p, int& col) const {
    const int pn = rho >> 8, r = rho & 255, bj = r >> 7, wc = (r >> 5) & 3, fq = (r >> 3) & 3, n = (r >> 2) & 1, e = r & 3;
    p = (const float*)((const char*)g + (long)n * ((const char*)u - (const char*)g)); col = 128 * pn + 32 * wc + 8 * fq + 4 * bj + e; } };

__device__ __forceinline__ void hy_filter_item(const Ctx& C, int layer, int item) {
    const bool lat = item < 64; const int L = lat ? 2048 : 256; const int pos0 = 32 * (lat ? item : item - 64);
    LAS float* z = (LAS float*)C.lds;
    LAS float* h1 = z + 32 * 33;
    LAS float* h2 = h1 + 32 * 64;
    const float* w1 = C.in[I_HW1] + (size_t)layer * 33 * 64; const float* b1 = C.in[I_HB1] + layer * 64; const float* f1 = C.in[I_HF1] + layer * 64;
    const float* w2 = C.in[I_HW2] + (size_t)layer * 64 * 64; const float* b2 = C.in[I_HB2] + layer * 64; const float* f2 = C.in[I_HF2] + layer * 64;
    const float* w3 = C.in[I_HW3] + (size_t)layer * 64 * 1024; const float* hb = C.in[I_HBIAS] + (size_t)layer * 512;
    __syncthreads();
    for (int t = C.tid; t < 32 * 33; t += NTHR) { const int p = t / 33, j = t % 33; const int i = pos0 + p;
        const float tt = (float)i / (float)(L - 1); const float wv = (6.283185307179586f / (float)L) * (float)i;
        float v;
        if (j == 0) v = tt;
        else { const int jj = (j - 1) & 15; const float fr = 1e-4f + (float)jj * ((15.0f - 1e-4f) / 15.0f); const float a = fr * wv; v = (j <= 16) ? cosf(a) : -sinf(a); }
        z[p * 33 + j] = v; }
    __syncthreads();
    for (int t = C.tid; t < 32 * 64; t += NTHR) { const int p = t >> 6, k = t & 63; float s = b1[k];
        for (int j = 0; j < 33; ++j) s += z[p * 33 + j] * w1[j * 64 + k];
        h1[p * 64 + k] = sinf(f1[k] * s); }
    __syncthreads();
    for (int t = C.tid; t < 32 * 64; t += NTHR) { const int p = t >> 6, k = t & 63; float s = b2[k];
        for (int j = 0; j < 64; ++j) s += h1[p * 64 + j] * w2[j * 64 + k];
        h2[p * 64 + k] = sinf(f2[k] * s); }
    __syncthreads();
    const float dmin = -3.0701134573253946f, dmax = -15.350567286626973f;
    float* FL = lat ? WSP(float, WS_FILT) : WSP(float, WS_FILTC); const int FS = lat ? 4096 : 512;
    for (int o = C.tid; o < 1024; o += NTHR) {
        float acc[32];
#pragma unroll
        for (int p = 0; p < 32; ++p) acc[p] = 0.f;
        for (int j = 0; j < 64; ++j) { const float w = w3[j * 1024 + o];
#pragma unroll
            for (int p = 0; p < 32; ++p) acc[p] += h2[p * 64 + j] * w; }
        const int dir = o >> 9, order = (o >> 8) & 1, c = o & 255;
        const float delta = fabsf(dmin + (float)c * ((dmax - dmin) / 255.0f));
        float* fo = FL + ((size_t)order * 256 + c) * FS;
#pragma unroll
        for (int p = 0; p < 32; ++p) { const int lag = pos0 + p; const float tt = (float)lag / (float)(L - 1);
            float v = acc[p] * expf(-tt * delta);
            if (dir == 0) { if (lag == 0) v += hb[order * 256 + c]; fo[(L - 1) - lag] = v; }
            else if (lag >= 1) fo[(L - 1) + lag] = v; }
    }
    __syncthreads();
}

__device__ __forceinline__ void phase_pre(const Ctx& C, int layer) {
    LAS float* scr = (LAS float*)(C.lds + C.wave * 8448);
    const int gw = C.bid * NWAVES + C.wave, NGW = C.G * NWAVES;
    const bool moe = layer & 1; const int j2 = layer >> 1;
    {
        const SrcWin s_in{C.in[I_WIN] + (size_t)layer * D * PROJ_W};
        const SrcPlain s_out{C.in[I_WOUT] + (size_t)layer * D * D};
        constexpr int I_IN = 16 * (PW / 32), I_OUT = 16 * 32, I_F1 = 16 * (2 * FF / 32), I_F2 = (FF / 64) * 32;
        const int ne = moe ? NEXP : 1;
        const int nitems = I_IN + I_OUT + ne * (I_F1 + I_F2);
        for (int it = gw; it < nitems; it += NGW) {
            int r = it;
            if (r < I_IN) { conv_item(s_in, D, PROJ_W, WSP(bf16, WS_WIN), scr, r, PW / 32, C.lane); continue; } r -= I_IN;
            if (r < I_OUT) { conv_item(s_out, D, D, WSP(bf16, WS_WOUT), scr, r, 32, C.lane); continue; } r -= I_OUT;
            const int e = r / (I_F1 + I_F2); r -= e * (I_F1 + I_F2);
            const float *wg, *wu, *wd;
            if (moe) { const size_t o = ((size_t)j2 * NEXP + e) * (size_t)D * FF; wg = C.in[I_MG] + o; wu = C.in[I_MU] + o; wd = C.in[I_MD] + o; }
            else { const size_t o = (size_t)j2 * D * FF; wg = C.in[I_FG] + o; wu = C.in[I_FU] + o; wd = C.in[I_FD] + o; }
            if (r < I_F1) { const SrcGU s{wg, wu}; conv_item(s, D, FF, WSP(bf16, WS_F1) + (size_t)e * 2 * FF * D, scr, r, 2 * FF / 32, C.lane); }
            else { const SrcPlain s{wd}; conv_item(s, FF, D, WSP(bf16, WS_F2) + (size_t)e * D * FF, scr, r - I_F1, 32, C.lane); }
        }
    }
    __syncthreads();
    {
        const float* sc = WSP(float, WS_SILUC); const float* wa = C.in[I_WADA] + (size_t)layer * D * 6144; const float* ba = C.in[I_BADA] + (size_t)layer * 6144;
        float* mod = WSP(float, WS_MOD) + (size_t)layer * 33 * 6144;
        LAS float* part = (LAS float*)C.lds;
        for (int grp = C.bid; grp < 96; grp += C.G) {
            const int n = grp * 64 + C.lane; float acc[33];
#pragma unroll
            for (int r = 0; r < 33; ++r) acc[r] = 0.f;
            const int k0 = C.wave * 128;
            for (int k = k0; k < k0 + 128; ++k) { const float w = wa[(size_t)k * 6144 + n];
#pragma unroll
                for (int r = 0; r < 33; ++r) acc[r] += sc[r * 1024 + k] * w; }
            __syncthreads();
#pragma unroll
            for (int r = 0; r < 33; ++r) part[(C.wave * 33 + r) * 64 + C.lane] = acc[r];
            __syncthreads();
            for (int o = C.tid; o < 33 * 64; o += NTHR) { const int r = o >> 6, l = o & 63; float s = ba[grp * 64 + l];
#pragma unroll
                for (int w = 0; w < 8; ++w) s += part[(w * 33 + r) * 64 + l];
                mod[(size_t)r * 6144 + grp * 64 + l] = s; }
        }
    }
    __syncthreads();
    for (int it = C.bid; it < 72; it += C.G) hy_filter_item(C, layer, it);
    __syncthreads();
}

__device__ __forceinline__ void phase_norm(const Ctx& C, int layer, int which) {
    LAS float* wx = (LAS float*)C.lds;
    const bool moe = layer & 1; const bool need_extra = (which == 0) || moe;
    __syncthreads();
    if (need_extra) {
        for (int i = C.tid; i < 1024 * 8; i += NTHR) { const int k = i >> 3, j = i & 7;
            wx[i] = (which == 0) ? C.in[I_WIN][(size_t)layer * D * PROJ_W + (size_t)k * PROJ_W + 1536 + j] : C.in[I_MR][(size_t)(layer >> 1) * D * 8 + i]; }
    }
    __syncthreads();
    const float* gn = (which == 0 ? C.in[I_NORM1] : C.in[I_NORM2]) + layer * D;
    const float* mod = WSP(float, WS_MOD) + (size_t)layer * 33 * 6144;
    const int i_sh = which == 0 ? 0 : 3, i_sc = which == 0 ? 1 : 4;
    bf16* O = WSP(bf16, WS_A);
    const int gw = C.bid * NWAVES + C.wave, NGW = C.G * NWAVES;
    const int nrows = (which == 1 && layer == DEPTH - 1) ? TLAT : TT;
    for (int m = gw; m < nrows; m += NGW) {
        const bool lat = m < TLAT; const int mr = lat ? (m >> 11) : 32;
        const float* xin; float* xcopy = nullptr;
        if (which == 0 && layer == 0) { xin = lat ? C.in[I_X] + (size_t)m * D : C.in[I_CTX] + (size_t)(m - TLAT) * D; xcopy = lat ? C.out + (size_t)m * D : WSP(float, WS_XC) + (size_t)(m - TLAT) * D; }
        else xin = lat ? C.out + (size_t)m * D : WSP(float, WS_XC) + (size_t)(m - TLAT) * D;
        const f32x4* xr = (const f32x4*)xin + C.lane;
        f32x4 v[4]; float ss = 0.f;
#pragma unroll
        for (int j = 0; j < 4; ++j) { v[j] = xr[64 * j]; ss += (v[j].x * v[j].x + v[j].y * v[j].y) + (v[j].z * v[j].z + v[j].w * v[j].w); }
        if (xcopy) {
#pragma unroll
            for (int j = 0; j < 4; ++j) ((f32x4*)xcopy + C.lane)[64 * j] = v[j]; }
        const float rstd = rsqrtf(wave_sum(ss) * (1.0f / D) + EPS);
        const float* msh = mod + (size_t)mr * 6144 + i_sh * 1024; const float* msc = mod + (size_t)mr * 6144 + i_sc * 1024;
        float ex[8];
#pragma unroll
        for (int j = 0; j < 8; ++j) ex[j] = 0.f;
        unsigned long long* o8 = (unsigned long long*)(O + (size_t)m * D) + C.lane;
#pragma unroll
        for (int j = 0; j < 4; ++j) {
            const int k = 4 * C.lane + 256 * j;
            const f32x4 g = *(const f32x4*)(gn + k), sh = *(const f32x4*)(msh + k), sc = *(const f32x4*)(msc + k);
            f32x4 h = v[j] * rstd * g * (1.0f + sc) + sh;
            o8[64 * j] = (unsigned long long)pk2(h.x, h.y) | ((unsigned long long)pk2(h.z, h.w) << 32);
            if (need_extra) {
#pragma unroll
                for (int e = 0; e < 4; ++e) { const f32x4 w0 = *(const LAS f32x4*)(wx + (k + e) * 8), w1 = *(const LAS f32x4*)(wx + (k + e) * 8 + 4);
                    ex[0] += h[e] * w0.x; ex[1] += h[e] * w0.y; ex[2] += h[e] * w0.z; ex[3] += h[e] * w0.w; ex[4] += h[e] * w1.x; ex[5] += h[e] * w1.y; ex[6] += h[e] * w1.z; ex[7] += h[e] * w1.w; }
            }
        }
        if (need_extra) {
#pragma unroll
            for (int j = 0; j < 8; ++j) ex[j] = wave_sum(ex[j]);
            if (which == 0) { if (C.lane == 0) { float* d = WSP(float, WS_DT) + (size_t)m * 8; *(f32x4*)d = (f32x4){ex[0], ex[1], ex[2], ex[3]}; *(f32x4*)(d + 4) = (f32x4){ex[4], ex[5], ex[6], ex[7]}; } }
            else if (C.lane == 0) {
                int i0 = 0; float v0 = ex[0];
#pragma unroll
                for (int j = 1; j < 8; ++j) if (ex[j] > v0) { v0 = ex[j]; i0 = j; }
                int i1 = -1; float v1 = -3.0e38f;
#pragma unroll
                for (int j = 0; j < 8; ++j) if (j != i0 && ex[j] > v1) { v1 = ex[j]; i1 = j; }
                const float e1 = __expf(v1 - v0); const float w0 = 1.0f / (1.0f + e1), w1 = e1 / (1.0f + e1);
                float cb[8];
#pragma unroll
                for (int j = 0; j < 8; ++j) cb[j] = (j == i0) ? w0 : ((j == i1) ? w1 : 0.f);
                float* d = WSP(float, WS_COMB) + (size_t)m * 8; *(f32x4*)d = (f32x4){cb[0], cb[1], cb[2], cb[3]}; *(f32x4*)(d + 4) = (f32x4){cb[4], cb[5], cb[6], cb[7]};
            }
        }
    }
    __syncthreads();
}

__device__ __forceinline__ void phase_prep(const Ctx& C, int layer) {
    bf16* P = WSP(bf16, WS_PROJ);
    const float* qn = C.in[I_QNORM] + layer * 64; const float* kn = C.in[I_KNORM] + layer * 64;
    const long nit = (long)TT * 10;
    for (long it = (long)C.bid * NTHR + C.tid; it < nit; it += (long)C.G * NTHR) {
        const int m = (int)(it / 10), s = (int)(it % 10);
        const bool isq = s < 8; const int col = isq ? PC_Q + 64 * s : PC_K + 64 * (s - 8);
        v4u* p = (v4u*)(P + (size_t)m * PW + col);
        float v[64]; float ss = 0.f;
#pragma unroll
        for (int j = 0; j < 8; ++j) { const v4u w = p[j];
            v[8 * j + 0] = bflo(w.x); v[8 * j + 1] = bfhi(w.x); v[8 * j + 2] = bflo(w.y); v[8 * j + 3] = bfhi(w.y); v[8 * j + 4] = bflo(w.z); v[8 * j + 5] = bfhi(w.z); v[8 * j + 6] = bflo(w.w); v[8 * j + 7] = bfhi(w.w); }
#pragma unroll
        for (int d = 0; d < 64; ++d) ss += v[d] * v[d];
        const float rstd = rsqrtf(ss * (1.0f / 64.0f) + EPS);
        const float* g = isq ? qn : kn;
#pragma unroll
        for (int d = 0; d < 64; ++d) v[d] = v[d] * rstd * g[d];
        if (m < TLAT) {
            const int t = m & 2047; const float pr = (float)(t >> 6), pc = (float)(t & 63);
#pragma unroll
            for (int a = 0; a < 2; ++a)
#pragma unroll
                for (int f = 0; f < 16; ++f) {
                    const float inv = expf(-(float)(2 * f) * (9.210340371976184f / 32.0f));
                    const float ang = (a == 0 ? pr : pc) * inv; float sn, cs; sincosf(ang, &sn, &cs);
                    const float x1 = v[32 * a + f], x2 = v[32 * a + 16 + f];
                    v[32 * a + f] = x1 * cs - x2 * sn; v[32 * a + 16 + f] = x1 * sn + x2 * cs; }
        }
        const float scl = isq ? 0.125f : 1.0f;
#pragma unroll
        for (int j = 0; j < 8; ++j) { v4u w; w.x = pk2(v[8 * j] * scl, v[8 * j + 1] * scl); w.y = pk2(v[8 * j + 2] * scl, v[8 * j + 3] * scl); w.z = pk2(v[8 * j + 4] * scl, v[8 * j + 5] * scl); w.w = pk2(v[8 * j + 6] * scl, v[8 * j + 7] * scl); p[j] = w; }
    }
    const float* cw = C.in[I_HCW] + (size_t)layer * 3 * 768; const float* cb = C.in[I_HCB] + (size_t)layer * 768;
    bf16* UT = WSP(bf16, WS_UT);
    const long nit2 = (long)TT * 96;
    for (long it = (long)C.bid * NTHR + C.tid; it < nit2; it += (long)C.G * NTHR) {
        const int m = (int)(it / 96), c8 = (int)(it % 96);
        const int t = m < TLAT ? (m & 2047) : ((m - TLAT) & 255); const int L = m < TLAT ? 2048 : 256;
        const v4u zero = (v4u){0u, 0u, 0u, 0u};
        const v4u a0 = t > 0 ? *(const v4u*)(P + (size_t)(m - 1) * PW + PC_HY + 8 * c8) : zero;
        const v4u a1 = *(const v4u*)(P + (size_t)m * PW + PC_HY + 8 * c8);
        const v4u a2 = t < L - 1 ? *(const v4u*)(P + (size_t)(m + 1) * PW + PC_HY + 8 * c8) : zero;
        const unsigned w0[4] = {a0.x, a0.y, a0.z, a0.w}, w1[4] = {a1.x, a1.y, a1.z, a1.w}, w2[4] = {a2.x, a2.y, a2.z, a2.w};
#pragma unroll
        for (int e = 0; e < 8; ++e) { const int ch = 8 * c8 + e;
            const float x0 = (e & 1) ? bfhi(w0[e >> 1]) : bflo(w0[e >> 1]), x1 = (e & 1) ? bfhi(w1[e >> 1]) : bflo(w1[e >> 1]), x2 = (e & 1) ? bfhi(w2[e >> 1]) : bflo(w2[e >> 1]);
            const float y = cw[ch] * x0 + cw[768 + ch] * x1 + cw[1536 + ch] * x2 + cb[ch];
            UT[(size_t)ch * TT + m] = (bf16)f2bf(y); }
    }
}

__device__ __forceinline__ void att_key(const bf16* P, int krow, int kcol, int vcol, const float (&q)[64], float& mx, float& l, float (&acc)[64]) {
    const v4u* kp = (const v4u*)(P + (size_t)krow * PW + kcol);
    float s = 0.f;
#pragma unroll
    for (int j = 0; j < 8; ++j) { const v4u w = kp[j];
        s += q[8 * j] * bflo(w.x) + q[8 * j + 1] * bfhi(w.x) + q[8 * j + 2] * bflo(w.y) + q[8 * j + 3] * bfhi(w.y) + q[8 * j + 4] * bflo(w.z) + q[8 * j + 5] * bfhi(w.z) + q[8 * j + 6] * bflo(w.w) + q[8 * j + 7] * bfhi(w.w); }
    if (s > mx) { const float cr = __expf(mx - s); l *= cr;
#pragma unroll
        for (int d = 0; d < 64; ++d) acc[d] *= cr;
        mx = s; }
    const float p = __expf(s - mx); l += p;
    const v4u* vp = (const v4u*)(P + (size_t)krow * PW + vcol);
#pragma unroll
    for (int j = 0; j < 8; ++j) { const v4u w = vp[j];
        acc[8 * j] += p * bflo(w.x); acc[8 * j + 1] += p * bfhi(w.x); acc[8 * j + 2] += p * bflo(w.y); acc[8 * j + 3] += p * bfhi(w.y); acc[8 * j + 4] += p * bflo(w.z); acc[8 * j + 5] += p * bfhi(w.z); acc[8 * j + 6] += p * bflo(w.w); acc[8 * j + 7] += p * bfhi(w.w); }
}
__device__ __forceinline__ void phase_att_naive(const Ctx& C, int layer) {
    const bf16* P = WSP(bf16, WS_PROJ); bf16* AO = WSP(bf16, WS_ATT);
    const float* sinks = C.in[I_SINKS] + layer * 8;
    const bool last = layer == DEPTH - 1;
    const long nit = (long)(last ? TLAT : TT) * 8;
    for (long it = (long)C.bid * NTHR + C.tid; it < nit; it += (long)C.G * NTHR) {
        const int m = (int)(it >> 3), hd = (int)(it & 7), kvh = hd >> 2;
        float q[64], acc[64];
        { const v4u* qp = (const v4u*)(P + (size_t)m * PW + PC_Q + 64 * hd);
#pragma unroll
          for (int j = 0; j < 8; ++j) { const v4u w = qp[j];
            q[8 * j] = bflo(w.x); q[8 * j + 1] = bfhi(w.x); q[8 * j + 2] = bflo(w.y); q[8 * j + 3] = bfhi(w.y); q[8 * j + 4] = bflo(w.z); q[8 * j + 5] = bfhi(w.z); q[8 * j + 6] = bflo(w.w); q[8 * j + 7] = bfhi(w.w); } }
#pragma unroll
        for (int d = 0; d < 64; ++d) acc[d] = 0.f;
        float mx = -3.0e38f, l = 0.f;
        const int kcol = PC_K + 64 * kvh, vcol = PC_V + 64 * kvh;
        int b;
        if (m < TLAT) { b = m >> 11; const int t = m & 2047; const int j0 = t - 128 < 0 ? 0 : t - 128, j1 = t + 128 > 2047 ? 2047 : t + 128;
            for (int j = j0; j <= j1; ++j) att_key(P, b * 2048 + j, kcol, vcol, q, mx, l, acc); }
        else b = (m - TLAT) >> 8;
        for (int j = 0; j < 256; ++j) att_key(P, TLAT + b * 256 + j, kcol, vcol, q, mx, l, acc);
        const float sk = sinks[hd];
        if (sk > mx) { const float cr = __expf(mx - sk); l *= cr;
#pragma unroll
            for (int d = 0; d < 64; ++d) acc[d] *= cr;
            mx = sk; }
        l += __expf(sk - mx);
        const float il = 1.0f / l;
        v4u* op = (v4u*)(AO + (size_t)m * 512 + 64 * hd);
#pragma unroll
        for (int j = 0; j < 8; ++j) { v4u w; w.x = pk2(acc[8 * j] * il, acc[8 * j + 1] * il); w.y = pk2(acc[8 * j + 2] * il, acc[8 * j + 3] * il); w.z = pk2(acc[8 * j + 4] * il, acc[8 * j + 5] * il); w.w = pk2(acc[8 * j + 6] * il, acc[8 * j + 7] * il); op[j] = w; }
    }
}

constexpr int AT_KROW = 144, AT_VROW = 136, AT_KB = 64 * AT_KROW, AT_VB = 64 * AT_VROW, AT_BUF = AT_KB + AT_VB;
__device__ __forceinline__ void att_unit(const Ctx& C, const bf16* P, bf16* AO, float sinkl2, int b, int kvh, int qrow0, int qpos0, bool lat) {
    LAS unsigned char* lds = C.lds;
    int lane = C.lane; asm volatile("" : "+v"(lane));
    int tid = C.tid; asm volatile("" : "+v"(tid));
    const int r = lane & 31, h = lane >> 5, g = C.wave >> 1, qh = C.wave & 1, hd = kvh * 4 + g;
    const float L2E = 1.4426950408889634f;
    bf16x8 Qf[2][4];
#pragma unroll
    for (int qt = 0; qt < 2; ++qt)
#pragma unroll
        for (int kk = 0; kk < 4; ++kk) Qf[qt][kk] = *(const bf16x8*)(P + (size_t)(qrow0 + 64 * qh + 32 * qt + r) * PW + PC_Q + 64 * hd + 16 * kk + 8 * h);
    f32x16 O[2][2];
#pragma unroll
    for (int dt = 0; dt < 2; ++dt)
#pragma unroll
        for (int qt = 0; qt < 2; ++qt)
#pragma unroll
            for (int e = 0; e < 16; ++e) O[dt][qt][e] = 0.f;
    float mrun[2] = {-1.0e30f, -1.0e30f}, lrun[2] = {0.f, 0.f};
    const int ntile = lat ? 10 : 4;
    const int lkey = tid >> 3, lch = tid & 7;
    const bf16* kvbase = P + PC_K + 64 * kvh + 8 * lch;
    v4u kreg, vreg;
#define AT_TILE_ROW(tx) ((tx) < 4 ? (TLAT + b * 256 + 64 * (tx)) : (b * 2048 + qpos0 - 128 + 64 * ((tx) - 4)))
#define AT_TILE_OK(tx) ((tx) < 4 || ((qpos0 - 128 + 64 * ((tx) - 4)) >= 0 && (qpos0 - 128 + 64 * ((tx) - 4)) < 2048))
    __syncthreads();
    {
        const bf16* src = kvbase + (size_t)(AT_TILE_ROW(0) + lkey) * PW; kreg = *(const v4u*)src; vreg = *(const v4u*)(src + (PC_V - PC_K));
        LAS unsigned char* kb = lds; *(LAS v4u*)(kb + lkey * AT_KROW + lch * 16) = kreg;
        LAS bf16* vb = (LAS bf16*)(kb + AT_KB); const unsigned w[4] = {vreg.x, vreg.y, vreg.z, vreg.w};
#pragma unroll
        for (int e = 0; e < 8; ++e) vb[(8 * lch + e) * (AT_VROW / 2) + lkey] = (bf16)((e & 1) ? (w[e >> 1] >> 16) : (w[e >> 1] & 0xffffu));
    }
    __syncthreads();
    for (int tx = 0; tx < ntile; ++tx) {
        const bool ok = AT_TILE_OK(tx);
        const bool nok = (tx + 1 < ntile) && AT_TILE_OK(tx + 1);
        if (nok) { const bf16* src = kvbase + (size_t)(AT_TILE_ROW(tx + 1) + lkey) * PW; kreg = *(const v4u*)src; vreg = *(const v4u*)(src + (PC_V - PC_K)); }
        const bool mine = ok && !(tx == 9 && qh == 0) && !(tx == 4 && qh == 1);
        if (mine) {
            LAS unsigned char* kb = lds + (tx & 1) * AT_BUF; LAS unsigned char* vb = kb + AT_KB;
            f32x16 S[2][2];
#pragma unroll
            for (int kt = 0; kt < 2; ++kt)
#pragma unroll
                for (int qt = 0; qt < 2; ++qt)
#pragma unroll
                    for (int e = 0; e < 16; ++e) S[kt][qt][e] = 0.f;
#pragma unroll
            for (int kk = 0; kk < 4; ++kk)
#pragma unroll
                for (int kt = 0; kt < 2; ++kt) { const bf16x8 Kf = *(const LAS bf16x8*)(kb + (32 * kt + r) * AT_KROW + 32 * kk + 16 * h);
#pragma unroll
                    for (int qt = 0; qt < 2; ++qt) S[kt][qt] = HY_MFMA(Kf, Qf[qt][kk], S[kt][qt]); }
            const bool band = tx >= 4;
            const int dbase = (-128 + 64 * (tx - 4)) - 64 * qh + 4 * h - r;
#pragma unroll
            for (int qt = 0; qt < 2; ++qt) {
                float mx = -1.0e30f;
#pragma unroll
                for (int kt = 0; kt < 2; ++kt)
#pragma unroll
                    for (int e = 0; e < 16; ++e) { float t = S[kt][qt][e] * L2E;
                        if (band) { const int dl = dbase + 32 * kt - 32 * qt + (e & 3) + 8 * (e >> 2); if (dl < -128 || dl > 128) t = -1.0e30f; }
                        S[kt][qt][e] = t; mx = fmaxf(mx, t); }
                mx = fmaxf(mx, __shfl_xor(mx, 32));
                const float mnew = fmaxf(mrun[qt], mx); const float alpha = __builtin_amdgcn_exp2f(mrun[qt] - mnew); mrun[qt] = mnew;
                float ls = 0.f;
#pragma unroll
                for (int kt = 0; kt < 2; ++kt)
#pragma unroll
                    for (int e = 0; e < 16; ++e) { const float p = __builtin_amdgcn_exp2f(S[kt][qt][e] - mnew); S[kt][qt][e] = p; ls += p; }
                lrun[qt] = lrun[qt] * alpha + ls;
#pragma unroll
                for (int dt = 0; dt < 2; ++dt)
#pragma unroll
                    for (int e = 0; e < 16; ++e) O[dt][qt][e] *= alpha;
            }
#pragma unroll
            for (int kt = 0; kt < 2; ++kt)
#pragma unroll
                for (int s2 = 0; s2 < 2; ++s2) {
                    bf16x8 Pf[2];
#pragma unroll
                    for (int qt = 0; qt < 2; ++qt) { v4u w; w.x = pk2(S[kt][qt][8 * s2 + 0], S[kt][qt][8 * s2 + 1]); w.y = pk2(S[kt][qt][8 * s2 + 2], S[kt][qt][8 * s2 + 3]);
                        w.z = pk2(S[kt][qt][8 * s2 + 4], S[kt][qt][8 * s2 + 5]); w.w = pk2(S[kt][qt][8 * s2 + 6], S[kt][qt][8 * s2 + 7]); Pf[qt] = __builtin_bit_cast(bf16x8, w); }
#pragma unroll
                    for (int dt = 0; dt < 2; ++dt) { const LAS unsigned char* vp = vb + (32 * dt + r) * AT_VROW + 2 * (32 * kt + 16 * s2 + 4 * h);
                        const v2u a = *(const LAS v2u*)vp, c = *(const LAS v2u*)(vp + 16); v4u w; w.x = a.x; w.y = a.y; w.z = c.x; w.w = c.y; const bf16x8 Vf = __builtin_bit_cast(bf16x8, w);
#pragma unroll
                        for (int qt = 0; qt < 2; ++qt) O[dt][qt] = HY_MFMA(Vf, Pf[qt], O[dt][qt]); }
                }
        }
        if (nok) {
            LAS unsigned char* kb = lds + ((tx + 1) & 1) * AT_BUF; *(LAS v4u*)(kb + lkey * AT_KROW + lch * 16) = kreg;
            LAS bf16* vb = (LAS bf16*)(kb + AT_KB); const unsigned w[4] = {vreg.x, vreg.y, vreg.z, vreg.w};
#pragma unroll
            for (int e = 0; e < 8; ++e) vb[(8 * lch + e) * (AT_VROW / 2) + lkey] = (bf16)((e & 1) ? (w[e >> 1] >> 16) : (w[e >> 1] & 0xffffu));
        }
        __syncthreads();
    }
#undef AT_TILE_ROW
#undef AT_TILE_OK
#pragma unroll
    for (int qt = 0; qt < 2; ++qt) {
        float l = lrun[qt]; l += __shfl_xor(l, 32); l += __builtin_amdgcn_exp2f(sinkl2 - mrun[qt]);
        const float il = 1.0f / l;
        bf16* orow = AO + (size_t)(qrow0 + 64 * qh + 32 * qt + r) * 512 + 64 * hd + 4 * h;
#pragma unroll
        for (int dt = 0; dt < 2; ++dt)
#pragma unroll
            for (int gq = 0; gq < 4; ++gq) { v2u w; w.x = pk2(O[dt][qt][4 * gq] * il, O[dt][qt][4 * gq + 1] * il); w.y = pk2(O[dt][qt][4 * gq + 2] * il, O[dt][qt][4 * gq + 3] * il);
                *(v2u*)(orow + 32 * dt + 8 * gq) = w; }
    }
}
__device__ __forceinline__ void phase_att_mfma(const Ctx& C, int layer) {
    const bf16* P = WSP(bf16, WS_PROJ); bf16* AO = WSP(bf16, WS_ATT);
    const bool last = layer == DEPTH - 1;
    const int nlat = NB * 2 * 16, nctx = last ? 0 : NB * 2 * 2;
    for (int u = C.bid; u < nlat + nctx; u += C.G) {
        if (u < nlat) { const int b = u >> 5, kvh = (u >> 4) & 1, qb = u & 15;
            const float sk = C.in[I_SINKS][layer * 8 + kvh * 4 + (C.wave >> 1)] * 1.4426950408889634f;
            att_unit(C, P, AO, sk, b, kvh, b * 2048 + qb * 128, qb * 128, true); }
        else { const int v = u - nlat; const int b = v >> 2, kvh = (v >> 1) & 1, qb = v & 1;
            const float sk = C.in[I_SINKS][layer * 8 + kvh * 4 + (C.wave >> 1)] * 1.4426950408889634f;
            att_unit(C, P, AO, sk, b, kvh, TLAT + b * 256 + qb * 128, 0, false); }
    }
    __syncthreads();
}

__device__ __forceinline__ float conv3_at(const bf16* P, int m, int t, int L, int col, const float* cw, const float* cb) {
    const float x1 = bf2f(P[(size_t)m * PW + col]);
    const float x0 = t > 0 ? bf2f(P[(size_t)(m - 1) * PW + col]) : 0.f;
    const float x2 = t < L - 1 ? bf2f(P[(size_t)(m + 1) * PW + col]) : 0.f;
    const int cc = col - PC_XBC;
    return cw[cc] * x0 + cw[512 + cc] * x1 + cw[1024 + cc] * x2 + cb[cc];
}
__device__ __forceinline__ void phase_ssd_naive(const Ctx& C, int layer) {
    const int gw = C.bid * NWAVES + C.wave, NGW = C.G * NWAVES;
    const bf16* P = WSP(bf16, WS_PROJ); const float* DTR = WSP(float, WS_DT); bf16* Y = WSP(bf16, WS_SSDY);
    const float* cw = C.in[I_SCW] + (size_t)layer * 3 * 512; const float* cb = C.in[I_SCB] + (size_t)layer * 512;
    for (int u = gw; u < NB * 4 * 2; u += NGW) {
        const int b = u >> 3, h = (u >> 1) & 3, dir = u & 1, g = h >> 1, p = C.lane;
        const float a = -expf(C.in[I_SALOG][layer * 8 + dir * 4 + h]); const float dtb = C.in[I_SDTB][layer * 8 + dir * 4 + h]; const float dsk = C.in[I_SD][layer * 4 + h];
        float hs[64];
#pragma unroll
        for (int n = 0; n < 64; ++n) hs[n] = 0.f;
        for (int seg = 0; seg < 2; ++seg) {
            const int L = seg == 0 ? CTXL : SEQ; const int base = seg == 0 ? TLAT + b * CTXL : b * SEQ;
            for (int st = 0; st < L; ++st) {
                const int t = dir ? (L - 1 - st) : st; const int m = base + t;
                const float xs = silu(conv3_at(P, m, t, L, PC_XBC + 64 * h + p, cw, cb));
                const float Bv = silu(conv3_at(P, m, t, L, PC_XBC + 256 + 64 * g + p, cw, cb));
                const float Cv = silu(conv3_at(P, m, t, L, PC_XBC + 384 + 64 * g + p, cw, cb));
                const float dr = DTR[(size_t)m * 8 + dir * 4 + h] + dtb;
                const float dt = dr > 20.f ? dr : log1pf(expf(dr));
                const float dec = expf(dt * a); const float dx = dt * xs;
                float y = 0.f;
#pragma unroll
                for (int n = 0; n < 64; ++n) { const float bn = __builtin_bit_cast(float, __builtin_amdgcn_readlane(__builtin_bit_cast(int, Bv), n)); const float cn = __builtin_bit_cast(float, __builtin_amdgcn_readlane(__builtin_bit_cast(int, Cv), n));
                    hs[n] = hs[n] * dec + dx * bn; y += cn * hs[n]; }
                if (dir == 0) y += xs * dsk;
                Y[((size_t)dir * TT + m) * 256 + 64 * h + p] = (bf16)f2bf(y);
            }
        }
    }
}

__device__ __forceinline__ void phase_hy_naive(const Ctx& C, int layer, int stage) {
    const int gw = C.bid * NWAVES + C.wave, NGW = C.G * NWAVES;
    const bf16* UT = WSP(bf16, WS_UT); bf16* ZT = WSP(bf16, WS_ZT); bf16* HO = WSP(bf16, WS_HYOT);
    const bool last = layer == DEPTH - 1;
    const int nlat = 256 * NB * (SEQ / 64), nctx = last ? 0 : 256 * NB * (CTXL / 64);
    for (int it = gw; it < nlat + nctx; it += NGW) {
        int c, b, tb, L, base; const float* F;
        if (it < nlat) { c = it / (NB * 32); const int r = it % (NB * 32); b = r / 32; tb = r % 32; L = SEQ; base = b * SEQ; F = WSP(float, WS_FILT) + ((size_t)stage * 256 + c) * 4096; }
        else { const int i2 = it - nlat; c = i2 / (NB * 4); const int r = i2 % (NB * 4); b = r / 4; tb = r % 4; L = CTXL; base = TLAT + b * CTXL; F = WSP(float, WS_FILTC) + ((size_t)stage * 256 + c) * 512; }
        const int t = tb * 64 + C.lane;
        const bf16* u = (stage == 0 ? UT + (size_t)c * TT : ZT + (size_t)c * TT) + base;
        const float* f = F + (L - 1) - t;
        float acc = 0.f;
        for (int s = 0; s < L; s += 8) { const v4u w = *(const v4u*)(u + s);
            acc += f[s] * bflo(w.x) + f[s + 1] * bfhi(w.x) + f[s + 2] * bflo(w.y) + f[s + 3] * bfhi(w.y) + f[s + 4] * bflo(w.z) + f[s + 5] * bfhi(w.z) + f[s + 6] * bflo(w.w) + f[s + 7] * bfhi(w.w); }
        const float mul = bf2f(UT[((size_t)(stage + 1) * 256 + c) * TT + base + t]);
        (stage == 0 ? ZT : HO)[(size_t)c * TT + base + t] = (bf16)f2bf(acc * mul);
    }
}

constexpr int SS_XT = 264, SS_BM = 144, SS_BT = 272, SS_CM = 144;
constexpr int SS_OFF_XT = 0, SS_OFF_BM = SS_OFF_XT + 64 * SS_XT, SS_OFF_BT = SS_OFF_BM + 128 * SS_BM, SS_OFF_CM = SS_OFF_BT + 64 * SS_BT, SS_OFF_LA = SS_OFF_CM + 128 * SS_CM,
              SS_OFF_DT = SS_OFF_LA + 512, SS_OFF_CF = SS_OFF_DT + 512, SS_OFF_CW = SS_OFF_CF + 512 + 16, SS_END = SS_OFF_CW + 192 * 16;
static_assert(SS_END <= MISC_OFF, "ssd LDS map");
__device__ __forceinline__ float wave_incl_scan(float v, int lane) {
#pragma unroll
    for (int o = 1; o < 64; o <<= 1) { const float t = __shfl_up(v, o); if (lane >= o) v += t; }
    return v;
}
__device__ __forceinline__ bf16x8 ld2x64(const LAS unsigned char* p) { const v2u a = *(const LAS v2u*)p, c = *(const LAS v2u*)(p + 16); v4u w; w.x = a.x; w.y = a.y; w.z = c.x; w.w = c.y; return __builtin_bit_cast(bf16x8, w); }
__device__ __forceinline__ bf16x8 ld2x64c(const LAS unsigned char* p) { const v2u a = *(const LAS v2u*)p, c = *(const LAS v2u*)(p + 8); v4u w; w.x = a.x; w.y = a.y; w.z = c.x; w.w = c.y; return __builtin_bit_cast(bf16x8, w); }
__device__ __forceinline__ bf16x8 pack8(const f32x16& v, int o) { v4u w; w.x = pk2(v[o], v[o + 1]); w.y = pk2(v[o + 2], v[o + 3]); w.z = pk2(v[o + 4], v[o + 5]); w.w = pk2(v[o + 6], v[o + 7]); return __builtin_bit_cast(bf16x8, w); }
__device__ __forceinline__ void ssd_unit(const Ctx& C, int layer, int b, int hh, int dir) {
    LAS unsigned char* lds = C.lds;
    int lane = C.lane; asm volatile("" : "+v"(lane));
    int tid = C.tid; asm volatile("" : "+v"(tid));
    const int r = lane & 31, h = lane >> 5, lt = C.wave & 3, ph = C.wave >> 2, g = hh >> 1;
    const bf16* P = WSP(bf16, WS_PROJ); const float* DTR = WSP(float, WS_DT); bf16* Y = WSP(bf16, WS_SSDY) + (size_t)dir * TT * 256;
    const float a = -expf(C.in[I_SALOG][layer * 8 + dir * 4 + hh]); const float dtb = C.in[I_SDTB][layer * 8 + dir * 4 + hh]; const float dsk = dir == 0 ? C.in[I_SD][layer * 4 + hh] : 0.f;
    __syncthreads();
    if (tid < 192) { const int ch = tid < 64 ? 64 * hh + tid : (tid < 128 ? 256 + 64 * g + (tid - 64) : 384 + 64 * g + (tid - 128));
        const float* cw = C.in[I_SCW] + (size_t)layer * 3 * 512; const float* cb = C.in[I_SCB] + (size_t)layer * 512;
        *(LAS f32x4*)(lds + SS_OFF_CW + tid * 16) = (f32x4){cw[ch], cw[512 + ch], cw[1024 + ch], cb[ch]}; }
    f32x16 Hacc[2];
#pragma unroll
    for (int nt = 0; nt < 2; ++nt)
#pragma unroll
        for (int e = 0; e < 16; ++e) Hacc[nt][e] = 0.f;
    const int lp = tid & 127, cg0 = tid >> 7;
    for (int ci = 0; ci < 18; ++ci) {
        const bool sctx = ci < 2; const int L = sctx ? 256 : 2048, nch = sctx ? 2 : 16, cidx = sctx ? ci : ci - 2, base = sctx ? TLAT + b * 256 : b * 2048;
        const int cs = dir ? (nch - 1 - cidx) * 128 : cidx * 128;
        const int t = dir ? cs + 127 - lp : cs + lp; const int m = base + t;
        __syncthreads();
        if (C.wave == 0) {
            const int t0 = dir ? cs + 127 - lane : cs + lane, t1 = dir ? cs + 63 - lane : cs + 64 + lane;
            const float r0 = DTR[(size_t)(base + t0) * 8 + dir * 4 + hh] + dtb, r1 = DTR[(size_t)(base + t1) * 8 + dir * 4 + hh] + dtb;
            const float d0 = r0 > 20.f ? r0 : log1pf(expf(r0)), d1 = r1 > 20.f ? r1 : log1pf(expf(r1));
            const float s0 = wave_incl_scan(d0 * a, lane); const float tot0 = __shfl(s0, 63); const float s1 = wave_incl_scan(d1 * a, lane) + tot0; const float lend = __shfl(s1, 63);
            LAS float* LA = (LAS float*)(lds + SS_OFF_LA); LAS float* DTs = (LAS float*)(lds + SS_OFF_DT); LAS float* CF = (LAS float*)(lds + SS_OFF_CF);
            LA[lane] = s0; LA[64 + lane] = s1; DTs[lane] = d0; DTs[64 + lane] = d1; CF[lane] = d0 * expf(lend - s0); CF[64 + lane] = d1 * expf(lend - s1);
            if (lane == 0) CF[128] = lend;
        }
        __syncthreads();
        {
            const float coef = ((const LAS float*)(lds + SS_OFF_CF))[lp];
#pragma unroll
            for (int half = 0; half < 2; ++half) {
                v4u raw[3][3];
#pragma unroll
                for (int j = 0; j < 3; ++j) { const int cg = cg0 + 4 * (3 * half + j);
                    const int ch = cg < 8 ? 64 * hh + 8 * cg : (cg < 16 ? 256 + 64 * g + 8 * (cg - 8) : 384 + 64 * g + 8 * (cg - 16));
                    const bf16* src = P + (size_t)m * PW + PC_XBC + ch; const v4u zero = (v4u){0u, 0u, 0u, 0u};
                    raw[j][0] = t > 0 ? *(const v4u*)(src - PW) : zero; raw[j][1] = *(const v4u*)src; raw[j][2] = t < L - 1 ? *(const v4u*)(src + PW) : zero; }
#pragma unroll
                for (int j = 0; j < 3; ++j) { const int cg = cg0 + 4 * (3 * half + j);
                    const unsigned w0[4] = {raw[j][0].x, raw[j][0].y, raw[j][0].z, raw[j][0].w}, w1[4] = {raw[j][1].x, raw[j][1].y, raw[j][1].z, raw[j][1].w}, w2[4] = {raw[j][2].x, raw[j][2].y, raw[j][2].z, raw[j][2].w};
                    float v[8];
#pragma unroll
                    for (int e = 0; e < 8; ++e) { const f32x4 cw = *(const LAS f32x4*)(lds + SS_OFF_CW + (8 * cg + e) * 16);
                        const float x0 = (e & 1) ? bfhi(w0[e >> 1]) : bflo(w0[e >> 1]), x1 = (e & 1) ? bfhi(w1[e >> 1]) : bflo(w1[e >> 1]), x2 = (e & 1) ? bfhi(w2[e >> 1]) : bflo(w2[e >> 1]);
                        v[e] = silu(cw.x * x0 + cw.y * x1 + cw.z * x2 + cw.w); }
                    if (cg < 8) {
#pragma unroll
                        for (int e = 0; e < 8; ++e) *(LAS bf16*)(lds + SS_OFF_XT + (8 * cg + e) * SS_XT + 2 * lp) = (bf16)f2bf(v[e]);
                    } else if (cg < 16) { const int n0 = 8 * (cg - 8);
                        v4u w; w.x = pk2(v[0], v[1]); w.y = pk2(v[2], v[3]); w.z = pk2(v[4], v[5]); w.w = pk2(v[6], v[7]); *(LAS v4u*)(lds + SS_OFF_BM + lp * SS_BM + 2 * n0) = w;
#pragma unroll
                        for (int e = 0; e < 8; ++e) *(LAS bf16*)(lds + SS_OFF_BT + (n0 + e) * SS_BT + 2 * lp) = (bf16)f2bf(v[e] * coef);
                    } else { const int n0 = 8 * (cg - 16);
                        v4u w; w.x = pk2(v[0], v[1]); w.y = pk2(v[2], v[3]); w.z = pk2(v[4], v[5]); w.w = pk2(v[6], v[7]); *(LAS v4u*)(lds + SS_OFF_CM + lp * SS_CM + 2 * n0) = w; }
                }
            }
        }
        __syncthreads();
        {
            const LAS float* LA = (const LAS float*)(lds + SS_OFF_LA); const LAS float* DTs = (const LAS float*)(lds + SS_OFF_DT);
            const float la_l = LA[32 * lt + r]; const float lend = ((const LAS float*)(lds + SS_OFF_CF))[128];
            f32x16 Yo, Yd;
#pragma unroll
            for (int e = 0; e < 16; ++e) { Yo[e] = 0.f; Yd[e] = 0.f; }
#pragma unroll
            for (int nt = 0; nt < 2; ++nt)
#pragma unroll
                for (int s2 = 0; s2 < 2; ++s2) { const bf16x8 A = pack8(Hacc[nt], 8 * s2);
                    const bf16x8 Bf = ld2x64(lds + SS_OFF_CM + (32 * lt + r) * SS_CM + 2 * (32 * nt + 16 * s2 + 4 * h));
                    Yo = HY_MFMA(A, Bf, Yo); }
            for (int st = 0; st <= lt; ++st) {
                f32x16 S;
#pragma unroll
                for (int e = 0; e < 16; ++e) S[e] = 0.f;
#pragma unroll
                for (int kk = 0; kk < 4; ++kk) { const bf16x8 A = *(const LAS bf16x8*)(lds + SS_OFF_BM + (32 * st + r) * SS_BM + 32 * kk + 16 * h);
                    const bf16x8 Bf = *(const LAS bf16x8*)(lds + SS_OFF_CM + (32 * lt + r) * SS_CM + 32 * kk + 16 * h);
                    S = HY_MFMA(A, Bf, S); }
#pragma unroll
                for (int gq = 0; gq < 4; ++gq) { const int s0 = 32 * st + 8 * gq + 4 * h;
                    const f32x4 las = *(const LAS f32x4*)(LA + s0), dts = *(const LAS f32x4*)(DTs + s0);
#pragma unroll
                    for (int e = 0; e < 4; ++e) { float gv = S[4 * gq + e] * __expf(la_l - las[e]) * dts[e];
                        if (st == lt) { const int sl = 8 * gq + 4 * h + e; if (sl > r) gv = 0.f; if (sl == r) gv += dsk; }
                        S[4 * gq + e] = gv; } }
#pragma unroll
                for (int s2 = 0; s2 < 2; ++s2) { const bf16x8 Bf = pack8(S, 8 * s2);
                    const bf16x8 A = ld2x64(lds + SS_OFF_XT + (32 * ph + r) * SS_XT + 2 * (32 * st + 16 * s2 + 4 * h));
                    Yd = HY_MFMA(A, Bf, Yd); }
            }
            { const int lq = 32 * lt + r; const int tq = dir ? cs + 127 - lq : cs + lq; const float el = __expf(la_l);
              bf16* orow = Y + (size_t)(base + tq) * 256 + 64 * hh + 32 * ph + 4 * h;
              if (!sctx || layer != DEPTH - 1) {
#pragma unroll
                for (int gq = 0; gq < 4; ++gq) { v2u w; w.x = pk2(Yd[4 * gq] + el * Yo[4 * gq], Yd[4 * gq + 1] + el * Yo[4 * gq + 1]); w.y = pk2(Yd[4 * gq + 2] + el * Yo[4 * gq + 2], Yd[4 * gq + 3] + el * Yo[4 * gq + 3]);
                    *(v2u*)(orow + 8 * gq) = w; } } }
            { const float ea = __expf(lend);
#pragma unroll
              for (int nt = 0; nt < 2; ++nt) {
#pragma unroll
                for (int e = 0; e < 16; ++e) Hacc[nt][e] *= ea;
#pragma unroll
                for (int k = 0; k < 8; ++k) { const bf16x8 A = *(const LAS bf16x8*)(lds + SS_OFF_BT + (32 * nt + r) * SS_BT + 32 * k + 16 * h);
                    const bf16x8 Bf = ld2x64c(lds + SS_OFF_XT + (32 * ph + r) * SS_XT + 32 * k + 16 * h);
                    Hacc[nt] = HY_MFMA(A, Bf, Hacc[nt]); } } }
        }
    }
}
__device__ __forceinline__ void phase_ssd_mfma(const Ctx& C, int layer) {
    for (int u = C.bid; u < NB * 4 * 2; u += C.G) ssd_unit(C, layer, u >> 3, (u >> 1) & 3, u & 1);
    __syncthreads();
}

constexpr int HY_ROW = 4112, HY_ROWC = 528;
constexpr int HY_F0 = 32 * HY_ROW, HY_F1 = HY_F0 + 8192 + 64, HY_LDS_END = HY_F1 + 8192;
static_assert(HY_LDS_END <= MISC_OFF, "hyena LDS map");
__device__ __forceinline__ bf16x8 hy_ldA(LAS unsigned char* lds, unsigned addr) {
    const LAS unsigned* p = (const LAS unsigned*)(lds + addr); v4u w; w.x = p[0]; w.y = p[1]; w.z = p[2]; w.w = p[3]; return __builtin_bit_cast(bf16x8, w);
}
__device__ __forceinline__ void hy_load_filter(LAS unsigned char* lds, const float* R, int n, int tid) {
    asm volatile("" : "+v"(tid));
    LAS bf16* c0 = (LAS bf16*)(lds + HY_F0); LAS bf16* c1 = (LAS bf16*)(lds + HY_F1);
    for (int i = tid; i < n; i += NTHR) { const bf16 v = (bf16)f2bf(i < n - 1 ? R[i] : 0.f); c0[i] = v; if (i >= 1) c1[i - 1] = v; if (i == n - 1) c1[i] = 0; }
}
template <int L, int ROW>
__device__ __forceinline__ void hy_load_rows(LAS unsigned char* lds, const bf16* src, int tid) {
    asm volatile("" : "+v"(tid));
    constexpr int CPR = L / 8, NCH = 32 * CPR, PER = NCH / NTHR;
    v4u v[PER];
#pragma unroll
    for (int j = 0; j < PER; ++j) v[j] = *((const v4u*)src + tid + NTHR * j);
#pragma unroll
    for (int j = 0; j < PER; ++j) { const int q = tid + NTHR * j, b = q / CPR, ch = q % CPR; *(LAS v4u*)(lds + b * ROW + ch * 16) = v[j]; }
}
template <int L, int ROW>
__device__ __forceinline__ void hy_store_rows(LAS unsigned char* lds, bf16* dst, int tid) {
    asm volatile("" : "+v"(tid));
    constexpr int CPR = L / 8, NCH = 32 * CPR, PER = NCH / NTHR;
#pragma unroll
    for (int j = 0; j < PER; ++j) { const int q = tid + NTHR * j, b = q / CPR, ch = q % CPR; *((v4u*)dst + q) = *(const LAS v4u*)(lds + b * ROW + ch * 16); }
}
template <int NTILE, int ROW>
__device__ __forceinline__ void hy_mul_inplace(LAS unsigned char* lds, const f32x16 (&acc)[NTILE], int wave, int lane) {
    asm volatile("" : "+v"(lane));
    const int r = lane & 31, h = lane >> 5;
#pragma unroll
    for (int i = 0; i < NTILE; ++i)
#pragma unroll
        for (int g = 0; g < 4; ++g) { const int t = 32 * NTILE * wave + 32 * i + 8 * g + 4 * h;
            LAS v2u* p = (LAS v2u*)(lds + r * ROW + 2 * t); const v2u x = *p;
            v2u o; o.x = pk2(bflo(x.x) * acc[i][4 * g + 0], bfhi(x.x) * acc[i][4 * g + 1]); o.y = pk2(bflo(x.y) * acc[i][4 * g + 2], bfhi(x.y) * acc[i][4 * g + 3]); *p = o; }
}
__device__ __forceinline__ void hy_conv_lat(LAS unsigned char* lds, f32x16 (&acc)[8], int wave, int lane_in) {
    int lane = lane_in; asm volatile("" : "+v"(lane));
    const int r = lane & 31, h = lane >> 5, odd = (r + 1) & 1;
    const unsigned LA7 = HY_F0 + odd * (HY_F1 - HY_F0) + 2 * (2047 - r + 8 * h - odd) - 512 * wave - 448;
    const unsigned LB = r * HY_ROW + 16 * h;
#pragma unroll
    for (int i = 0; i < 8; ++i)
#pragma unroll
        for (int e = 0; e < 16; ++e) acc[i][e] = 0.f;
    bf16x8 We[8], Wo[8];
#pragma unroll
    for (int i = 1; i < 8; ++i) { We[i] = hy_ldA(lds, LA7 + 64 * (7 - i)); Wo[i] = hy_ldA(lds, LA7 + 64 * (7 - i) + 32); }
    unsigned fa = LA7 + 448, fb = LB;
    bf16x8 An = hy_ldA(lds, fa), Bn = *(const LAS bf16x8*)(lds + fb);
#pragma unroll 1
    for (int kb = 0; kb < 8; ++kb) {
#pragma unroll
        for (int u = 0; u < 8; ++u) {
            {
                const bf16x8 Bc = Bn; We[0] = An;
                An = hy_ldA(lds, fa + 32 * (2 * u + 1)); Bn = *(const LAS bf16x8*)(lds + fb + 32 * (2 * u + 1));
#pragma unroll
                for (int i = 0; i < 8; ++i) acc[i] = HY_MFMA(We[i], Bc, acc[i]);
#pragma unroll
                for (int i = 7; i >= 1; --i) We[i] = We[i - 1];
            }
            {
                const bf16x8 Bc = Bn; Wo[0] = An;
                An = hy_ldA(lds, fa + 32 * (2 * u + 2)); Bn = *(const LAS bf16x8*)(lds + fb + 32 * (2 * u + 2));
#pragma unroll
                for (int i = 0; i < 8; ++i) acc[i] = HY_MFMA(Wo[i], Bc, acc[i]);
#pragma unroll
                for (int i = 7; i >= 1; --i) Wo[i] = Wo[i - 1];
            }
        }
        fa += 512; fb += 512;
    }
}
__device__ __forceinline__ void hy_conv_ctx(LAS unsigned char* lds, f32x16 (&acc)[1], int wave, int lane) {
    asm volatile("" : "+v"(lane));
    const int r = lane & 31, h = lane >> 5, odd = (r + 1) & 1;
    const unsigned LA = HY_F0 + odd * (HY_F1 - HY_F0) + 2 * (255 - r + 8 * h - odd) - 64 * wave;
    const unsigned LB = r * HY_ROWC + 16 * h;
#pragma unroll
    for (int e = 0; e < 16; ++e) acc[0][e] = 0.f;
#pragma unroll
    for (int k = 0; k < 16; ++k) { const bf16x8 A = hy_ldA(lds, LA + 32 * k); const bf16x8 B = *(const LAS bf16x8*)(lds + LB + 32 * k); acc[0] = HY_MFMA(A, B, acc[0]); }
}
__device__ __forceinline__ void phase_hy_mfma(const Ctx& C, int layer) {
    const bf16* UT = WSP(bf16, WS_UT); bf16* HO = WSP(bf16, WS_HYOT);
    const bool last = layer == DEPTH - 1;
    LAS unsigned char* lds = C.lds;
    for (int c = C.bid; c < 256; c += C.G) {
        __syncthreads();
        {
            f32x16 acc[8];
            hy_load_filter(lds, WSP(float, WS_FILT) + (size_t)c * 4096, 4096, C.tid);
            hy_load_rows<2048, HY_ROW>(lds, UT + (size_t)c * TT, C.tid);
            __syncthreads();
            hy_conv_lat(lds, acc, C.wave, C.lane);
            __syncthreads();
            hy_load_filter(lds, WSP(float, WS_FILT) + (size_t)(256 + c) * 4096, 4096, C.tid);
            hy_load_rows<2048, HY_ROW>(lds, UT + (size_t)(256 + c) * TT, C.tid);
            __syncthreads();
            hy_mul_inplace<8, HY_ROW>(lds, acc, C.wave, C.lane);
            __syncthreads();
            hy_conv_lat(lds, acc, C.wave, C.lane);
            __syncthreads();
            hy_load_rows<2048, HY_ROW>(lds, UT + (size_t)(512 + c) * TT, C.tid);
            __syncthreads();
            hy_mul_inplace<8, HY_ROW>(lds, acc, C.wave, C.lane);
            __syncthreads();
            hy_store_rows<2048, HY_ROW>(lds, HO + (size_t)c * TT, C.tid);
        }
        if (!last) {
            __syncthreads();
            f32x16 acc[1];
            hy_load_filter(lds, WSP(float, WS_FILTC) + (size_t)c * 512, 512, C.tid);
            hy_load_rows<256, HY_ROWC>(lds, UT + (size_t)c * TT + TLAT, C.tid);
            __syncthreads();
            hy_conv_ctx(lds, acc, C.wave, C.lane);
            __syncthreads();
            hy_load_filter(lds, WSP(float, WS_FILTC) + (size_t)(256 + c) * 512, 512, C.tid);
            hy_load_rows<256, HY_ROWC>(lds, UT + (size_t)(256 + c) * TT + TLAT, C.tid);
            __syncthreads();
            hy_mul_inplace<1, HY_ROWC>(lds, acc, C.wave, C.lane);
            __syncthreads();
            hy_conv_ctx(lds, acc, C.wave, C.lane);
            __syncthreads();
            hy_load_rows<256, HY_ROWC>(lds, UT + (size_t)(512 + c) * TT + TLAT, C.tid);
            __syncthreads();
            hy_mul_inplace<1, HY_ROWC>(lds, acc, C.wave, C.lane);
            __syncthreads();
            hy_store_rows<256, HY_ROWC>(lds, HO + (size_t)c * TT + TLAT, C.tid);
        }
    }
    __syncthreads();
}

__device__ __forceinline__ void phase_merge(const Ctx& C, int layer) {
    const int gw = C.bid * NWAVES + C.wave, NGW = C.G * NWAVES;
    const bf16* AO = WSP(bf16, WS_ATT); const bf16* SY = WSP(bf16, WS_SSDY); const bf16* HO = WSP(bf16, WS_HYOT); const bf16* P = WSP(bf16, WS_PROJ);
    bf16* Y = WSP(bf16, WS_A);
    const float* g_att = C.in[I_ATTON] + layer * 512; const float* g_ssd = C.in[I_SNORM] + layer * 256; const float* g_hy = C.in[I_HON] + layer * 256;
    const int nrows = (layer == DEPTH - 1) ? TLAT : TT;
    for (int m = gw; m < nrows; m += NGW) {
        { const v4u w = *((const v4u*)(AO + (size_t)m * 512) + C.lane);
          float v[8] = {bflo(w.x), bfhi(w.x), bflo(w.y), bfhi(w.y), bflo(w.z), bfhi(w.z), bflo(w.w), bfhi(w.w)}; float ss = 0.f;
#pragma unroll
          for (int e = 0; e < 8; ++e) ss += v[e] * v[e];
          const float rstd = rsqrtf(wave_sum(ss) * (1.0f / 512.0f) + EPS);
          const float* g = g_att + 8 * C.lane;
          v4u o; o.x = pk2(v[0] * rstd * g[0], v[1] * rstd * g[1]); o.y = pk2(v[2] * rstd * g[2], v[3] * rstd * g[3]); o.z = pk2(v[4] * rstd * g[4], v[5] * rstd * g[5]); o.w = pk2(v[6] * rstd * g[6], v[7] * rstd * g[7]);
          *((v4u*)(Y + (size_t)m * D) + C.lane) = o; }
        { const v2u w0 = *((const v2u*)(SY + (size_t)m * 256) + C.lane), w1 = *((const v2u*)(SY + ((size_t)TT + m) * 256) + C.lane), wz = *((const v2u*)(P + (size_t)m * PW + PC_Z) + C.lane);
          float v[4] = {bflo(w0.x) + bflo(w1.x), bfhi(w0.x) + bfhi(w1.x), bflo(w0.y) + bflo(w1.y), bfhi(w0.y) + bfhi(w1.y)};
          const float z[4] = {bflo(wz.x), bfhi(wz.x), bflo(wz.y), bfhi(wz.y)}; float ss = 0.f;
#pragma unroll
          for (int e = 0; e < 4; ++e) { v[e] *= silu(z[e]); ss += v[e] * v[e]; }
          const float rstd = rsqrtf(wave_sum(ss) * (1.0f / 256.0f) + EPS);
          const float* g = g_ssd + 4 * C.lane;
          v2u o; o.x = pk2(v[0] * rstd * g[0], v[1] * rstd * g[1]); o.y = pk2(v[2] * rstd * g[2], v[3] * rstd * g[3]);
          *((v2u*)(Y + (size_t)m * D + 512) + C.lane) = o; }
        { float v[4]; float ss = 0.f;
#pragma unroll
          for (int e = 0; e < 4; ++e) { v[e] = bf2f(HO[(size_t)(4 * C.lane + e) * TT + m]); ss += v[e] * v[e]; }
          ss += __shfl_xor(ss, 1); ss += __shfl_xor(ss, 2); ss += __shfl_xor(ss, 4); ss += __shfl_xor(ss, 8);
          const float rstd = rsqrtf(ss * (1.0f / 64.0f) + EPS);
          const float* g = g_hy + 4 * C.lane;
          v2u o; o.x = pk2(v[0] * rstd * g[0], v[1] * rstd * g[1]); o.y = pk2(v[2] * rstd * g[2], v[3] * rstd * g[3]);
          *((v2u*)(Y + (size_t)m * D + 768) + C.lane) = o; }
    }
}

constexpr int NPL = 24;
constexpr int NPHASES = 1 + DEPTH * NPL;
__global__ void __launch_bounds__(NTHR, 2) mega_fwd(Args args) {
    extern __shared__ __attribute__((aligned(16))) unsigned char lds_raw[];
    Ctx C0; C0.in = args.in; C0.out = args.out; C0.ws = args.ws; C0.lds = (LAS unsigned char*)lds_raw;
    C0.tid = threadIdx.x; C0.lane = C0.tid & 63; C0.wave = __builtin_amdgcn_readfirstlane(C0.tid >> 6); C0.bid = blockIdx.x; C0.G = gridDim.x;
    const Ctx& C = C0;
    volatile LAS unsigned* MISC = (volatile LAS unsigned*)(C.lds + MISC_OFF);
    if (C.tid < 64) MISC[C.tid] = 0u;
    __syncthreads();
    const int lo = args.ph_lo, hi = args.ph_hi;
    const bool multi = (hi - lo) > 1;
    XcdBarrier bar; bar.bar = (unsigned*)(C.ws + WS_CTL) + CW_BAR; bar.x = 0; bar.st = MISC + 8;
    if (multi) bar = xcd_barrier_post((unsigned*)(C.ws + WS_CTL) + CW_BAR, MISC + 8);
    int ph = 0;
#ifndef PHMASK
#define PHMASK 0xffffffffu
#endif
#define PHM(i) ((PHMASK >> (i)) & 1u)
#define PH_BEGIN if (ph >= lo && ph < hi) { Ctx C = C0; { unsigned long long _b = (unsigned long long)C0.out, _c = (unsigned long long)C0.ws; int _t = C0.tid; \
        asm volatile("" : "+s"(_b), "+s"(_c), "+v"(_t)); C.out = (float*)_b; C.ws = (unsigned char*)_c; C.tid = _t; C.lane = _t & 63; C.wave = __builtin_amdgcn_readfirstlane(_t >> 6); }
#define PH_END } if (ph >= lo && ph + 1 < hi) xcd_barrier(bar); ++ph;

    PH_BEGIN if (PHM(0)) phase_siluc(C); PH_END
    for (int layer = 0; layer < DEPTH; ++layer) {
        const bool last = layer == DEPTH - 1; const bool moe = layer & 1;
        PH_BEGIN if (PHM(1)) phase_pre(C, layer); PH_END
        PH_BEGIN if (PHM(2)) phase_norm(C, layer, 0); PH_END
        PH_BEGIN if (PHM(3)) { pg8::Gemm g{WSP(bf16, WS_A), WSP(bf16, WS_WIN), TT, PW, D}; pg8::StaticOrder S; S.init(TT, PW, C.G, C.bid);
                   pg8::EpiStore E{WSP(bf16, WS_PROJ), PW};
                   pg8::gemm_phase<pg8::EpiStore, pg8::StaticOrder, PG8_ALIGN, PG8_SP2>(C.lds, g, S, E, C.tid); } PH_END
        PH_BEGIN if (PHM(4)) phase_prep(C, layer); PH_END
        PH_BEGIN if (PHM(5)) phase_att_mfma(C, layer); if (PHM(6)) phase_ssd_mfma(C, layer); if (PHM(7)) phase_hy_mfma(C, layer); PH_END
        PH_BEGIN if (PHM(9)) phase_merge(C, layer); PH_END
        PH_BEGIN if (PHM(10)) { const int M = last ? TLAT : TT; pg8::Gemm g{WSP(bf16, WS_A), WSP(bf16, WS_WOUT), M, D, D}; pg8::StaticOrder S; S.init(M, D, C.G, C.bid);
                   pg8::EpiResid E{C.out, WSP(float, WS_XC), WSP(float, WS_MOD) + (size_t)layer * 33 * 6144 + 2 * 1024, nullptr, 0};
                   pg8::gemm_phase<pg8::EpiResid, pg8::StaticOrder, PG8_ALIGN, PG8_SP2>(C.lds, g, S, E, C.tid); } PH_END
        PH_BEGIN if (PHM(11)) phase_norm(C, layer, 1); PH_END
        for (int e = 0; e < NEXP; ++e) {
            const bool act = moe || e == 0; const int M = last ? TLAT : TT;
            PH_BEGIN if (PHM(12) && act) { pg8::Gemm g{WSP(bf16, WS_A), WSP(bf16, WS_F1) + (size_t)e * 2 * FF * D, M, 2 * FF, D}; pg8::StaticOrder S; S.init(M, 2 * FF, C.G, C.bid);
                   pg8::EpiSwiglu E{WSP(bf16, WS_HID), FF};
                   pg8::gemm_phase<pg8::EpiSwiglu, pg8::StaticOrder, PG8_ALIGN, PG8_SP2>(C.lds, g, S, E, C.tid); } PH_END
            PH_BEGIN if (PHM(13) && act) { pg8::Gemm g{WSP(bf16, WS_HID), WSP(bf16, WS_F2) + (size_t)e * D * FF, M, D, FF}; pg8::StaticOrder S; S.init(M, D, C.G, C.bid);
                   pg8::EpiResid E{C.out, WSP(float, WS_XC), WSP(float, WS_MOD) + (size_t)layer * 33 * 6144 + 5 * 1024, moe ? WSP(float, WS_COMB) + e : nullptr, 8};
                   pg8::gemm_phase<pg8::EpiResid, pg8::StaticOrder, PG8_ALIGN, PG8_SP2>(C.lds, g, S, E, C.tid); } PH_END
        }
    }
#undef PH_BEGIN
#undef PH_END
}

#ifndef MK_ONE_LAUNCH
#define MK_ONE_LAUNCH 1
#endif
extern "C" void kernel_launch(void* const* d_in, const int* in_sizes, int n_in, void* d_out, int out_size, void* d_ws, size_t ws_size, hipStream_t stream) {
    static int grid = 0;
    if (grid == 0) {
        if (n_in != 38 || out_size != TLAT * D || ws_size < WS_END) { fprintf(stderr, "kernel_launch: unexpected shapes (n_in %d, out %d, ws %zu)\n", n_in, out_size, ws_size); grid = -1; return; }
        int dev = 0, cus = 0, per_cu = 0;
        if (hipGetDevice(&dev) != hipSuccess || hipDeviceGetAttribute(&cus, hipDeviceAttributeMultiprocessorCount, dev) != hipSuccess) { grid = -1; return; }
        if (hipFuncSetAttribute((const void*)mega_fwd, hipFuncAttributeMaxDynamicSharedMemorySize, LDS_BYTES) != hipSuccess) { fprintf(stderr, "kernel_launch: hipFuncSetAttribute failed\n"); grid = -1; return; }
        if (hipOccupancyMaxActiveBlocksPerMultiprocessor(&per_cu, (const void*)mega_fwd, NTHR, LDS_BYTES) != hipSuccess || per_cu < 1) { fprintf(stderr, "kernel_launch: occupancy query says %d\n", per_cu); (void)hipGetLastError(); grid = -1; return; }
        grid = cus;
    }
    if (grid < 0) return;
    (void)hipMemsetAsync((char*)d_ws + WS_CTL, 0, CTL_ZERO_BYTES, stream);
    Args a{};
    for (int i = 0; i < 38; ++i) a.in[i] = (const float*)d_in[i];
    a.out = (float*)d_out; a.ws = (unsigned char*)d_ws;
#if MK_ONE_LAUNCH
    a.ph_lo = 0; a.ph_hi = NPHASES;
    hipLaunchKernelGGL(mega_fwd, dim3(grid), dim3(NTHR), LDS_BYTES, stream, a);
#else
    for (int ph = 0; ph < NPHASES; ++ph) {
        const int r = ph == 0 ? -1 : (ph - 1) % NPL, layer = ph == 0 ? 0 : (ph - 1) / NPL;
        if (!(layer & 1) && r >= 10) continue;
        a.ph_lo = ph; a.ph_hi = ph + 1;
        hipLaunchKernelGGL(mega_fwd, dim3(grid), dim3(NTHR), LDS_BYTES, stream, a);
    }
#endif
}
```

```cpp
#include <hip/hip_runtime.h>
#include <cstdio>
#include <cstdint>
__device__ __forceinline__ int lane_now() { int l; asm volatile("v_mbcnt_lo_u32_b32 %0, -1, 0\n\tv_mbcnt_hi_u32_b32 %0, -1, %0" : "=v"(l)); return l; }
__device__ __forceinline__ float shx(float v, int o, int lane) { return __builtin_bit_cast(float, __builtin_amdgcn_ds_bpermute((lane ^ o) << 2, __builtin_bit_cast(int, v))); }
__device__ __forceinline__ float shup(float v, int o, int lane) { return __builtin_bit_cast(float, __builtin_amdgcn_ds_bpermute(((lane - o) & 63) << 2, __builtin_bit_cast(int, v))); }
namespace pg8 {
#define PG8_LAS __attribute__((address_space(3)))
typedef unsigned short bf16_t;
typedef short bf16x8 __attribute__((ext_vector_type(8)));
typedef float f32x4 __attribute__((ext_vector_type(4)));
typedef unsigned u32x4 __attribute__((ext_vector_type(4)));
constexpr int BM = 256, BK = 64, HALF = 128, HTB = HALF * BK * 2  , STAGE_BYTES = 8 * HTB, NXCD = 8, WGM = 8;

__host__ __device__ __forceinline__ int lds_byte(int r, int c) { const int st = (r >> 4) * 2 + (c >> 5), rr = r & 15, cc = c & 31, ob = rr * 64 + cc * 2; return st * 1024 + (ob ^ (((ob >> 9) & 1) << 5)); }
__host__ __device__ __forceinline__ void stage_rc(int b, int& R, int& C) { const int st = b / 1024, sb = b % 1024, swz = sb ^ (((sb >> 9) & 1) << 5); R = (st >> 1) * 16 + swz / 64; C = (st & 1) * 32 + (swz % 64) / 2; }
__host__ __device__ __forceinline__ int perm32(int rho) { const int n = rho >> 4, i = rho & 15; return 8 * (i >> 2) + 4 * n + (i & 3); }

struct Unit { int pm, pn; };
struct Gemm { const bf16_t* A; const bf16_t* Bt; int M, N, K; };

struct StaticOrder {
    int nM, nN, nwg, G, c;
    __host__ __device__ void init(int M, int N, int G_, int c_) { nM = M / BM; nN = N / BM; nwg = nM * nN; G = G_; c = c_; }
    __host__ __device__ bool next(int i, Unit& u) const {
        const long L = (long)i * G + c; if (L >= nwg) return false;
        int wgid = (int)L; { const int q = nwg / NXCD, r = nwg % NXCD, xcd = wgid % NXCD, off = wgid / NXCD; wgid = (xcd < r ? xcd * (q + 1) : r * (q + 1) + (xcd - r) * q) + off; }
        const int nig = WGM * nN, gid = wgid / nig, fm = gid * WGM, gsz = (nM - fm) < WGM ? (nM - fm) : WGM;
        u.pm = fm + ((wgid % nig) % gsz); u.pn = (wgid % nig) / gsz; return true;
    }
    __device__ __forceinline__ void a_ready(const Unit&) const {}
    __device__ __forceinline__ void done(const Unit&) const {}
    __device__ __forceinline__ const char* b_base(const Gemm& g, const Unit& u, size_t tstep) const { return (const char*)g.Bt + (size_t)u.pn * tstep; }
    __device__ __forceinline__ const char* a_base(const Gemm& g, const Unit& u, size_t tstep) const { return (const char*)g.A + (size_t)u.pm * tstep; }
};
struct ProjOrder {
    StaticOrder a; int nA, nC, nB, ctxpm;
    __device__ __forceinline__ void init(int M, int G_, int c_, bool ctx_kv_only) {
        if (ctx_kv_only) { a.init(M - 8192, 1536, G_, c_); nA = a.nwg; ctxpm = (M - 8192) / BM; nC = 3 * 32; nB = 3 * ctxpm; }
        else { a.init(M, 1536, G_, c_); nA = a.nwg; ctxpm = 0; nC = 0; nB = 3 * (M / BM); } }
    __device__ __forceinline__ bool next(int i, Unit& u) const { const long L = (long)i * a.G + a.c; if (L < nA) return a.next(i, u);
        int l2 = (int)(L - nA);
        if (l2 < nC) { const int j = l2 % 3; u.pm = ctxpm + l2 / 3; u.pn = j == 0 ? 2 : 3 + j; return true; }
        l2 -= nC; if (l2 >= nB) return false; u.pm = l2 % 3; u.pn = 1024 + l2 / 3; return true; }
    __device__ __forceinline__ void a_ready(const Unit&) const {}
    __device__ __forceinline__ void done(const Unit&) const {}
    __device__ __forceinline__ const char* a_base(const Gemm& g, const Unit& u, size_t tstep) const { return u.pn < 1024 ? (const char*)g.A + (size_t)u.pm * tstep : (const char*)g.Bt + (size_t)(6 + u.pm) * tstep; }
    __device__ __forceinline__ const char* b_base(const Gemm& g, const Unit& u, size_t tstep) const { return u.pn < 1024 ? (const char*)g.Bt + (size_t)u.pn * tstep : (const char*)g.A + (size_t)(u.pn - 1024) * tstep; }
};
struct MoeOrder : StaticOrder {
    int ts[9]; size_t estride; const unsigned* goff;
    __device__ __forceinline__ const char* b_base(const Gemm& g, const Unit& u, size_t tstep) const { int e = 0;
#pragma unroll
        for (int j = 1; j < 8; ++j) e += (u.pm >= ts[j]) ? 1 : 0;
        return (const char*)g.Bt + (size_t)e * estride + (size_t)u.pn * tstep; }
};


__device__ __forceinline__ unsigned cvt_pk_bf16(float lo, float hi) { unsigned r; asm volatile("v_cvt_pk_bf16_f32 %0, %1, %2" : "=v"(r) : "v"(lo), "v"(hi)); return r; }
__device__ __forceinline__ float silu_f(float v) { return v * __builtin_amdgcn_rcpf(1.0f + __expf(-v)); }

struct EpiStore {
    static constexpr bool PERM = true, AFTER_DRAIN = false;
    bf16_t* O; int ldc;
    __device__ __forceinline__ void operator()(const f32x4 (&acc)[2][2][4][2], const Unit& u, int wr, int wc, int fr, int fq) const {
        const int row0 = u.pm * BM + wr * 64 + fr; const int col0 = u.pn * BM + wc * 32 + 8 * fq;
#pragma unroll
        for (int ai = 0; ai < 2; ++ai)
#pragma unroll
            for (int m = 0; m < 4; ++m) { bf16_t* rowp = O + (size_t)(row0 + ai * HALF + m * 16) * ldc + col0;
#pragma unroll
                for (int bj = 0; bj < 2; ++bj) { const f32x4 v0 = acc[ai][bj][m][0], v1 = acc[ai][bj][m][1];
                    u32x4 w; w.x = cvt_pk_bf16(v0[0], v0[1]); w.y = cvt_pk_bf16(v0[2], v0[3]); w.z = cvt_pk_bf16(v1[0], v1[1]); w.w = cvt_pk_bf16(v1[2], v1[3]);
                    *(u32x4*)(rowp + bj * HALF) = w; } }
    }
};
struct EpiSwiglu {
    static constexpr bool PERM = true, AFTER_DRAIN = false;
    bf16_t* H; int ldh;
    __device__ __forceinline__ void operator()(const f32x4 (&acc)[2][2][4][2], const Unit& u, int wr, int wc, int fr, int fq) const {
        const int row0 = u.pm * BM + wr * 64 + fr; const int hid0 = u.pn * 128 + wc * 32 + 8 * fq;
#pragma unroll
        for (int ai = 0; ai < 2; ++ai)
#pragma unroll
            for (int m = 0; m < 4; ++m) { bf16_t* rowp = H + (size_t)(row0 + ai * HALF + m * 16) * ldh + hid0;
                float h[8];
#pragma unroll
                for (int bj = 0; bj < 2; ++bj)
#pragma unroll
                    for (int e = 0; e < 4; ++e) h[4 * bj + e] = silu_f(acc[ai][bj][m][0][e]) * acc[ai][bj][m][1][e];
                u32x4 w; w.x = cvt_pk_bf16(h[0], h[1]); w.y = cvt_pk_bf16(h[2], h[3]); w.z = cvt_pk_bf16(h[4], h[5]); w.w = cvt_pk_bf16(h[6], h[7]);
                *(u32x4*)rowp = w; }
    }
};
struct EpiResid {
    static constexpr bool PERM = true, AFTER_DRAIN = false;
    const void* slat; const void* sctx; void* dlat; void* dctx; int sf32, df32;
    const float* gate; const int* rowtok;
    const float* cw; int cw_stride;
    int dry;
    typedef unsigned u32x4_t __attribute__((ext_vector_type(4)));
    __device__ __forceinline__ void operator()(const f32x4 (&acc)[2][2][4][2], const Unit& u, int wr, int wc, int fr, int fq) const {
        const int row0 = u.pm * BM + wr * 64 + fr, col0 = u.pn * BM + wc * 32 + 8 * fq;
        unsigned long long sl = (unsigned long long)slat, sx = (unsigned long long)sctx, dl = (unsigned long long)dlat, dx = (unsigned long long)dctx;
        asm volatile("" : "+s"(sl), "+s"(sx), "+s"(dl), "+s"(dx));
        int tok[2][4]; float sc[2][4];
#pragma unroll
        for (int ai = 0; ai < 2; ++ai)
#pragma unroll
            for (int m = 0; m < 4; ++m) { const int row = row0 + ai * HALF + m * 16; tok[ai][m] = rowtok ? rowtok[row] : row; sc[ai][m] = cw ? cw[(size_t)row * cw_stride] : 1.0f; }
        f32x4 gu[2][2];
        if (!rowtok) { const int t0 = u.pm * BM; const float* g = gate + (size_t)(t0 < 65536 ? (t0 >> 11) : 32) * 6144 + col0;
#pragma unroll
            for (int bj = 0; bj < 2; ++bj)
#pragma unroll
                for (int n = 0; n < 2; ++n) gu[bj][n] = *(const f32x4*)(g + bj * HALF + 4 * n); }
#pragma unroll
        for (int ai = 0; ai < 2; ++ai)
#pragma unroll
          for (int mh = 0; mh < 2; ++mh) {
            f32x4 xv[2][2][2]; size_t ro[2]; int mr[2]; unsigned long long sb[2], db[2];
#pragma unroll
            for (int mm = 0; mm < 2; ++mm) { const int m = 2 * mh + mm; const int t = tok[ai][m] < 0 ? 0 : tok[ai][m];
                const bool lt = t < 65536; ro[mm] = (size_t)(lt ? t : t - 65536) * 1024 + col0; mr[mm] = lt ? (t >> 11) : 32; sb[mm] = lt ? sl : sx; db[mm] = lt ? dl : dx;
                if (sf32) { const __attribute__((address_space(1))) float* p = (const __attribute__((address_space(1))) float*)sb[mm] + ro[mm];
#pragma unroll
                    for (int bj = 0; bj < 2; ++bj)
#pragma unroll
                        for (int n = 0; n < 2; ++n) xv[mm][bj][n] = *(const __attribute__((address_space(1))) f32x4*)(p + bj * HALF + 4 * n);
                } else { const __attribute__((address_space(1))) bf16_t* p = (const __attribute__((address_space(1))) bf16_t*)sb[mm] + ro[mm];
#pragma unroll
                    for (int bj = 0; bj < 2; ++bj) { const u32x4_t w = *(const __attribute__((address_space(1))) u32x4_t*)(p + bj * HALF);
                        xv[mm][bj][0] = (f32x4){__builtin_bit_cast(float, w.x << 16), __builtin_bit_cast(float, w.x & 0xffff0000u), __builtin_bit_cast(float, w.y << 16), __builtin_bit_cast(float, w.y & 0xffff0000u)};
                        xv[mm][bj][1] = (f32x4){__builtin_bit_cast(float, w.z << 16), __builtin_bit_cast(float, w.z & 0xffff0000u), __builtin_bit_cast(float, w.w << 16), __builtin_bit_cast(float, w.w & 0xffff0000u)}; } } }
#pragma unroll
            for (int mm = 0; mm < 2; ++mm) { const int m = 2 * mh + mm; const float* g = gate + (size_t)mr[mm] * 6144 + col0; const float s = sc[ai][m];
                if (tok[ai][m] >= 0 && (s != 0.0f || sb[mm] != db[mm])) {
#pragma unroll
                    for (int bj = 0; bj < 2; ++bj) { f32x4 r[2];
#pragma unroll
                        for (int n = 0; n < 2; ++n) { const f32x4 gv = rowtok ? *(const f32x4*)(g + bj * HALF + 4 * n) : gu[bj][n];
                            r[n] = dry ? xv[mm][bj][n] : xv[mm][bj][n] + gv * s * acc[ai][bj][m][n]; }
                        if (df32) { __attribute__((address_space(1))) float* q = (__attribute__((address_space(1))) float*)db[mm] + ro[mm] + bj * HALF;
                            *((__attribute__((address_space(1))) f32x4*)q) = r[0]; *((__attribute__((address_space(1))) f32x4*)(q + 4)) = r[1]; }
                        else { u32x4_t w; w.x = cvt_pk_bf16(r[0].x, r[0].y); w.y = cvt_pk_bf16(r[0].z, r[0].w); w.z = cvt_pk_bf16(r[1].x, r[1].y); w.w = cvt_pk_bf16(r[1].z, r[1].w);
                            *((__attribute__((address_space(1))) u32x4_t*)((__attribute__((address_space(1))) bf16_t*)db[mm] + ro[mm] + bj * HALF)) = w; } } } }
          }
    }
};
struct EpiProj {
    static constexpr bool PERM = true, AFTER_DRAIN = false;
    bf16_t* P; bf16_t* HYT; int ldh; const float* qn; const float* kn; const float* ropeR; const float* ropeC;
    __device__ __forceinline__ void operator()(const f32x4 (&acc)[2][2][4][2], const Unit& u, int wr, int wc, int fr, int fq) const {
        if (u.pn >= 3) {
            bf16_t* O; int ldc, pn;
            if (u.pn >= 1024) { O = HYT; ldc = ldh; pn = u.pn - 1024; } else { O = P; ldc = 1536; pn = u.pn; }
            const int row0 = u.pm * BM + wr * 64 + fr; const int col0 = pn * BM + wc * 32 + 8 * fq;
#pragma unroll
            for (int ai = 0; ai < 2; ++ai)
#pragma unroll
                for (int m = 0; m < 4; ++m) { bf16_t* rowp = O + (size_t)(row0 + ai * HALF + m * 16) * ldc + col0;
#pragma unroll
                    for (int bj = 0; bj < 2; ++bj) { const f32x4 v0 = acc[ai][bj][m][0], v1 = acc[ai][bj][m][1];
                        u32x4 w; w.x = cvt_pk_bf16(v0[0], v0[1]); w.y = cvt_pk_bf16(v0[2], v0[3]); w.z = cvt_pk_bf16(v1[0], v1[1]); w.w = cvt_pk_bf16(v1[2], v1[3]);
                        *(u32x4*)(rowp + bj * HALF) = w; } }
            return;
        }
        const bool isq = u.pn < 2, isk = (u.pn == 2) && (wc < 2);
        const int colbase = u.pn * BM + wc * 64 + 16 * fq;
        const float* gsrc = isq ? qn : kn;
        f32x4 g[2][2];
#pragma unroll
        for (int bj = 0; bj < 2; ++bj)
#pragma unroll
            for (int n = 0; n < 2; ++n) g[bj][n] = *(const f32x4*)(gsrc + 32 * bj + 16 * n + 4 * fq);
        const float scl = isq ? 0.125f * 1.4426950408889634f : 1.0f;
#pragma unroll
        for (int ai = 0; ai < 2; ++ai)
#pragma unroll
            for (int m = 0; m < 4; ++m) { const int row = u.pm * BM + ai * HALF + wr * 64 + m * 16 + fr;
                f32x4 v[2][2];
#pragma unroll
                for (int bj = 0; bj < 2; ++bj)
#pragma unroll
                    for (int n = 0; n < 2; ++n) v[bj][n] = acc[ai][bj][m][n];
                if (isq || isk) {
                    float ss = 0.f;
#pragma unroll
                    for (int bj = 0; bj < 2; ++bj)
#pragma unroll
                        for (int n = 0; n < 2; ++n) ss += (v[bj][n][0] * v[bj][n][0] + v[bj][n][1] * v[bj][n][1]) + (v[bj][n][2] * v[bj][n][2] + v[bj][n][3] * v[bj][n][3]);
                    { const int ln_ = ::lane_now(); ss += ::shx(ss, 16, ln_); ss += ::shx(ss, 32, ln_); }
                    const float rstd = __builtin_amdgcn_rsqf(ss * (1.0f / 64.0f) + 1e-6f);
#pragma unroll
                    for (int bj = 0; bj < 2; ++bj)
#pragma unroll
                        for (int n = 0; n < 2; ++n) v[bj][n] = v[bj][n] * rstd * g[bj][n];
                    if (row < 65536) { const int t = row & 2047;
#pragma unroll
                        for (int bj = 0; bj < 2; ++bj) { const float* tb = (bj == 0 ? ropeR + (t >> 6) * 32 : ropeC + (t & 63) * 32) + 4 * fq;
                            const f32x4 cs = *(const f32x4*)tb, sn = *(const f32x4*)(tb + 16);
                            const f32x4 x1 = v[bj][0], x2 = v[bj][1]; v[bj][0] = x1 * cs - x2 * sn; v[bj][1] = x1 * sn + x2 * cs; } }
#pragma unroll
                    for (int bj = 0; bj < 2; ++bj)
#pragma unroll
                        for (int n = 0; n < 2; ++n) v[bj][n] = v[bj][n] * scl;
                }
                bf16_t* rowp = P + (size_t)row * 1536 + colbase;
#pragma unroll
                for (int bj = 0; bj < 2; ++bj) { u32x4 w; w.x = cvt_pk_bf16(v[bj][0][0], v[bj][0][1]); w.y = cvt_pk_bf16(v[bj][0][2], v[bj][0][3]); w.z = cvt_pk_bf16(v[bj][1][0], v[bj][1][1]); w.w = cvt_pk_bf16(v[bj][1][2], v[bj][1][3]);
                    *(u32x4*)(rowp + 8 * bj) = w; } }
    }
};
template <class Epi, class Sched, bool ALIGN_EPI = false, bool SP2 = false, bool GATHER = false>
__device__ __forceinline__ void gemm_phase(PG8_LAS unsigned char* lds, const Gemm g, const Sched& S, const Epi& E, const int tid) {
    const int wid = __builtin_amdgcn_readfirstlane(tid >> 6), lane = tid & 63, wr = wid >> 2, wc = wid & 3, fr = lane & 15, fq = lane >> 4;
    const int K = g.K, nt = K / BK;
    unsigned voffA[2], voffB[2];
#pragma unroll
    for (int i = 0; i < 2; ++i) { int R, C; stage_rc(tid * 16 + i * 8192, R, C); const int Rb = Epi::PERM ? ((R & ~31) + perm32(R & 31)) : R;
        voffA[i] = (unsigned)(R * K + C) * 2u; voffB[i] = (unsigned)(Rb * K + C) * 2u; }
    const size_t kstep = (size_t)(BK * 2);
    const size_t hstep = (size_t)HALF * K * 2;
    const size_t tstep = 2 * hstep;
    const unsigned ldsw = (unsigned)wid * 1024u;
    const int aoff = lds_byte(wr * 64 + fr, fq * 8), boff = lds_byte(wc * 32 + fr, fq * 8);
#define PG8_SA(b, h) (((b) * 2 + (h)) * HTB)
#define PG8_SB(b, h) ((4 + (b) * 2 + (h)) * HTB)
#define PG8_STAGE(bufoff, gbase, voff) do { _Pragma("unroll") for (int _i = 0; _i < 2; ++_i) \
        __builtin_amdgcn_global_load_lds((const unsigned*)((const char*)(gbase) + (voff)[_i]), (PG8_LAS unsigned*)(lds + (bufoff) + ldsw + _i * 8192), 16, 0, 0); } while (0)
#define PG8_STAGE_A(bufoff, base, h) do { if constexpr (GATHER) { PG8_STAGE(bufoff, base, gcur[h]); } else { PG8_STAGE(bufoff, (base) + ((h) ? hstep : 0), voffA); } } while (0)
#define PG8_GROWS(dst, unit) do { int _R, _C; stage_rc(tid * 16, _R, _C); u32x4 _o; \
        if (S.goff) _o = *(const u32x4*)(S.goff + (size_t)(unit).pm * BM + 4 * _R); else { const unsigned _b = (unsigned)((unit).pm * BM + _R) * (unsigned)(K * 2); const unsigned _s = 64u * (unsigned)(K * 2); _o = (u32x4){_b, _b + _s, _b + 2 * _s, _b + 3 * _s}; } \
        dst[0][0] = _o[0] + (unsigned)_C * 2u; dst[0][1] = _o[1] + (unsigned)_C * 2u; dst[1][0] = _o[2] + (unsigned)_C * 2u; dst[1][1] = _o[3] + (unsigned)_C * 2u; } while (0)
#define PG8_LDA(dst, b, h) do { _Pragma("unroll") for (int m = 0; m < 4; ++m) _Pragma("unroll") for (int k = 0; k < 2; ++k) dst[m][k] = *(const PG8_LAS bf16x8*)(lds + PG8_SA(b, h) + aoff + m * 2048 + k * 1024); } while (0)
#define PG8_LDB(dst, b, h) do { _Pragma("unroll") for (int n = 0; n < 2; ++n) _Pragma("unroll") for (int k = 0; k < 2; ++k) dst[n][k] = *(const PG8_LAS bf16x8*)(lds + PG8_SB(b, h) + boff + n * 2048 + k * 1024); } while (0)
#define PG8_MMA(ai, bj, At, Bt) do { __builtin_amdgcn_s_setprio(1); _Pragma("unroll") for (int m = 0; m < 4; ++m) _Pragma("unroll") for (int n = 0; n < 2; ++n) _Pragma("unroll") for (int k = 0; k < 2; ++k) \
        acc[ai][bj][m][n] = __builtin_amdgcn_mfma_f32_16x16x32_bf16(Bt[n][k], At[m][k], acc[ai][bj][m][n], 0, 0, 0); __builtin_amdgcn_s_setprio(0); } while (0)
#define PG8_WAIT_V(n) asm volatile("s_waitcnt vmcnt(" #n ")" ::: "memory")
#define PG8_WAIT_L(n) asm volatile("s_waitcnt lgkmcnt(" #n ")" ::: "memory")
#define PG8_BAR __builtin_amdgcn_s_barrier()
#define PG8_SCHED __builtin_amdgcn_sched_barrier(0)
    Unit cur, nxt; int ui = 0;
    if (!S.next(0, cur)) return;
    f32x4 acc[2][2][4][2];
#pragma unroll
    for (int a = 0; a < 2; ++a)
#pragma unroll
        for (int b = 0; b < 2; ++b)
#pragma unroll
            for (int m = 0; m < 4; ++m)
#pragma unroll
                for (int n = 0; n < 2; ++n) acc[a][b][m][n] = (f32x4){0.f, 0.f, 0.f, 0.f};
    bf16x8 At[4][2], B0[2][2], B1[2][2];
    const char* cA = GATHER ? (const char*)g.A : S.a_base(g, cur, tstep); const char* cB = S.b_base(g, cur, tstep);
    unsigned gcur[2][2];
    if constexpr (GATHER) { PG8_GROWS(gcur, cur); }
    S.a_ready(cur);
    if constexpr (SP2) {
        PG8_STAGE(PG8_SB(0, 0), cB, voffB); PG8_STAGE(PG8_SB(0, 1), cB + hstep, voffB); PG8_STAGE_A(PG8_SA(0, 0), cA, 0); PG8_STAGE_A(PG8_SA(0, 1), cA, 1);
        if (wr == 1) PG8_BAR;
        PG8_WAIT_V(2); PG8_BAR;
        PG8_STAGE(PG8_SB(1, 0), cB + kstep, voffB); PG8_STAGE_A(PG8_SA(1, 0), cA + kstep, 0); PG8_STAGE(PG8_SB(1, 1), cB + hstep + kstep, voffB);
        PG8_WAIT_V(6); PG8_BAR;
    } else {
        PG8_STAGE(PG8_SB(0, 0), cB, voffB); PG8_STAGE(PG8_SA(0, 0), cA, voffA); PG8_STAGE(PG8_SB(0, 1), cB + hstep, voffB); PG8_STAGE(PG8_SA(0, 1), cA + hstep, voffA);
        if (wr == 1) PG8_BAR;
        PG8_WAIT_V(4); PG8_BAR;
        PG8_STAGE(PG8_SB(1, 0), cB + kstep, voffB); PG8_STAGE(PG8_SA(1, 0), cA + kstep, voffA); PG8_STAGE(PG8_SB(1, 1), cB + hstep + kstep, voffB);
        PG8_WAIT_V(6); PG8_BAR;
    }
    for (;;) {
        const bool has_next = S.next(ui + 1, nxt);
        const char* nA = GATHER ? (const char*)g.A : (has_next ? S.a_base(g, nxt, tstep) : cA); const char* nB = has_next ? S.b_base(g, nxt, tstep) : cB;
        for (int t = 0; t < nt; t += 2) {
            const bool last = (t == nt - 2);
            const char* a1 = cA + (size_t)(t + 1) * kstep;
            const char* a2 = last ? nA : cA + (size_t)(t + 2) * kstep; const char* b2 = last ? nB : cB + (size_t)(t + 2) * kstep;
            const char* a3 = a2 + kstep; const char* b3 = b2 + kstep;
            if (last && has_next) S.a_ready(nxt);
            if constexpr (SP2) {
            PG8_LDB(B0, 0, 0); PG8_LDB(B1, 0, 1); PG8_SCHED; PG8_LDA(At, 0, 0); PG8_STAGE_A(PG8_SA(1, 1), a1, 1);
            if constexpr (GATHER) { if (last && has_next) PG8_GROWS(gcur, nxt); }
            PG8_WAIT_V(8); PG8_WAIT_L(0); PG8_BAR; PG8_MMA(0, 0, At, B0); PG8_MMA(0, 1, At, B1); PG8_BAR; PG8_SCHED;
            PG8_LDA(At, 0, 1); PG8_STAGE(PG8_SB(0, 0), b2, voffB); PG8_STAGE(PG8_SB(0, 1), b2 + hstep, voffB); PG8_STAGE_A(PG8_SA(0, 0), a2, 0);
            PG8_WAIT_V(8); PG8_WAIT_L(0); PG8_BAR; PG8_MMA(1, 0, At, B0); PG8_MMA(1, 1, At, B1); PG8_BAR; PG8_SCHED;
            PG8_LDB(B0, 1, 0); PG8_LDB(B1, 1, 1); PG8_SCHED; PG8_LDA(At, 1, 0); PG8_STAGE_A(PG8_SA(0, 1), a2, 1);
            PG8_WAIT_V(8); PG8_WAIT_L(0); PG8_BAR; PG8_MMA(0, 0, At, B0); PG8_MMA(0, 1, At, B1); PG8_BAR; PG8_SCHED;
            PG8_LDA(At, 1, 1); PG8_STAGE(PG8_SB(1, 0), b3, voffB); PG8_STAGE(PG8_SB(1, 1), b3 + hstep, voffB); PG8_STAGE_A(PG8_SA(1, 0), a3, 0);
            PG8_WAIT_V(8); PG8_WAIT_L(0); PG8_BAR; PG8_MMA(1, 0, At, B0); PG8_MMA(1, 1, At, B1); PG8_BAR; PG8_SCHED;
            } else {
            PG8_LDB(B0, 0, 0); PG8_SCHED; PG8_LDA(At, 0, 0); PG8_STAGE(PG8_SA(1, 1), a1 + hstep, voffA);
            PG8_WAIT_L(8); PG8_BAR; PG8_WAIT_L(0); PG8_MMA(0, 0, At, B0); PG8_BAR; PG8_SCHED;
            PG8_LDB(B1, 0, 1); PG8_STAGE(PG8_SB(0, 0), b2, voffB);
            PG8_BAR; PG8_WAIT_L(0); PG8_MMA(0, 1, At, B1); PG8_BAR;
            PG8_LDA(At, 0, 1); PG8_STAGE(PG8_SA(0, 0), a2, voffA);
            PG8_BAR; PG8_WAIT_L(0); PG8_MMA(1, 0, At, B0); PG8_BAR; PG8_SCHED;
            PG8_STAGE(PG8_SB(0, 1), b2 + hstep, voffB);
            PG8_WAIT_V(6); PG8_BAR; PG8_MMA(1, 1, At, B1); PG8_BAR;
            PG8_LDB(B0, 1, 0); PG8_SCHED; PG8_LDA(At, 1, 0); PG8_STAGE(PG8_SA(0, 1), a2 + hstep, voffA);
            PG8_WAIT_L(8); PG8_BAR; PG8_WAIT_L(0); PG8_MMA(0, 0, At, B0); PG8_BAR; PG8_SCHED;
            PG8_LDB(B1, 1, 1); PG8_STAGE(PG8_SB(1, 0), b3, voffB);
            PG8_BAR; PG8_WAIT_L(0); PG8_MMA(0, 1, At, B1); PG8_BAR;
            PG8_LDA(At, 1, 1); PG8_STAGE(PG8_SA(1, 0), a3, voffA);
            PG8_BAR; PG8_WAIT_L(0); PG8_MMA(1, 0, At, B0); PG8_BAR; PG8_SCHED;
            PG8_STAGE(PG8_SB(1, 1), b3 + hstep, voffB);
            PG8_WAIT_V(6); PG8_BAR; PG8_MMA(1, 1, At, B1); PG8_BAR;
            }
        }
        if constexpr (ALIGN_EPI) { if (wr == 0) PG8_BAR; }
        if constexpr (!Epi::AFTER_DRAIN) { E(acc, cur, wr, wc, fr, fq); S.done(cur); }
        if (!has_next) break;
#pragma unroll
        for (int a = 0; a < 2; ++a)
#pragma unroll
            for (int b = 0; b < 2; ++b)
#pragma unroll
                for (int m = 0; m < 4; ++m)
#pragma unroll
                    for (int n = 0; n < 2; ++n) acc[a][b][m][n] = (f32x4){0.f, 0.f, 0.f, 0.f};
        cur = nxt; cA = nA; cB = nB; ++ui;
        if constexpr (ALIGN_EPI) { if (wr == 1) PG8_BAR; }
    }
    PG8_WAIT_V(0);
    if constexpr (!ALIGN_EPI) { if (wr == 0) PG8_BAR; }
    PG8_BAR;
    if constexpr (Epi::AFTER_DRAIN) { E.fused(acc, cur, wr, wc, fr, fq, lds, wid, lane); S.done(cur); }
#undef PG8_SA
#undef PG8_SB
#undef PG8_STAGE
#undef PG8_STAGE_A
#undef PG8_GROWS
#undef PG8_LDA
#undef PG8_LDB
#undef PG8_MMA
#undef PG8_WAIT_V
#undef PG8_WAIT_L
#undef PG8_BAR
#undef PG8_SCHED
}
}

#ifndef PG8_SP2
#define PG8_SP2 true
#endif
#ifndef PG8_ALIGN
#define PG8_ALIGN true
#endif

constexpr int D = 1024, NB = 32, SEQ = 2048, CTXL = 256, DEPTH = 4;
constexpr int TLAT = NB * SEQ, TCTX = NB * CTXL, TT = TLAT + TCTX;
constexpr int PROJ_W = 2312, PW = 1536, WROWS = 2304;
constexpr int FF = 2816, NEXP = 8;
constexpr float EPS = 1e-6f;
constexpr int PC_Q = 0, PC_K = 512, PC_V = 640, PC_Z = 768, PC_XBC = 1024;

constexpr size_t MiB = 1u << 20;
constexpr size_t WS_CTL = 0, CTL_ZERO_BYTES = 1 * MiB;
constexpr size_t WS_SILUC = 1 * MiB;
constexpr size_t WS_MOD = 2 * MiB;
constexpr size_t WS_DT = 6 * MiB;
constexpr size_t WS_COMB = 9 * MiB;
constexpr size_t WS_FILT = 12 * MiB;
constexpr size_t WS_FILTC = 20 * MiB;
constexpr size_t WS_ROPE = 22 * MiB - 64 * 1024;
constexpr size_t WS_ROWTOK = 21 * MiB;
constexpr size_t WS_ROWW = 21 * MiB + 512 * 1024;
constexpr size_t WS_ROWTOK1 = 12 * MiB, WS_ROWW1 = 12 * MiB + 512 * 1024;
constexpr size_t WS_GOFF = 13 * MiB, WS_GOFF1 = 13 * MiB + 512 * 1024;
constexpr size_t WS_WIN = 22 * MiB;
constexpr size_t WS_WOUT = 27 * MiB;
constexpr size_t WS_F1 = 29 * MiB;
constexpr size_t WS_F2 = 117 * MiB;
constexpr size_t WS_XC = 161 * MiB;
constexpr size_t WS_XR = 805 * MiB;
constexpr size_t WS_A = 193 * MiB;
constexpr size_t WS_PROJ = 337 * MiB;
constexpr size_t WS_HID = 337 * MiB;
constexpr size_t WS_ATT = 661 * MiB;
constexpr size_t WS_SSDY = 733 * MiB;
constexpr size_t WS_HYOT = 805 * MiB;
constexpr size_t WS_HYT = 841 * MiB;
constexpr size_t WS_FILTB = 953 * MiB;
constexpr size_t WS_FILTCB = 969 * MiB;
constexpr size_t WS_AS = 805 * MiB;
constexpr size_t WS_END = 985 * MiB;
constexpr int MROWS = TT + 2048;
static_assert(WS_HID + (size_t)MROWS * FF * 2 <= WS_HYOT && WS_AS + (size_t)MROWS * D * 2 <= WS_FILTB && WS_HYT + (size_t)768 * TT * 2 <= WS_FILTB, "hidden / sorted overlays");
constexpr int CW_BAR = 4096;
constexpr int CW_GCNT = 4096 + 3 * 3456;
constexpr int CW_WQ = 4096 + 3 * 3456 + 256;
constexpr int CW_BB = 16384;

constexpr int NWAVES = 8, NTHR = 512;
constexpr int LDS_BYTES = 155648;
constexpr int MISC_OFF = 151 * 1024;

#define GAS __attribute__((address_space(1)))
#define LAS __attribute__((address_space(3)))
#define CAS __attribute__((address_space(4)))
typedef unsigned short bf16;
typedef unsigned v4u __attribute__((ext_vector_type(4)));
typedef unsigned v2u __attribute__((ext_vector_type(2)));
typedef float f32x4 __attribute__((ext_vector_type(4)));
typedef short bf16x8 __attribute__((ext_vector_type(8)));
typedef float f32x16 __attribute__((ext_vector_type(16)));
#define HY_MFMA(a, b, c) __builtin_amdgcn_mfma_f32_32x32x16_bf16((a), (b), (c), 0, 0, 0)
#define LDS_WAIT() asm volatile("s_waitcnt lgkmcnt(0)" ::: "memory")
__device__ __forceinline__ unsigned f2bf(float f) { unsigned u = __builtin_bit_cast(unsigned, f); return (u + 0x7fffu + ((u >> 16) & 1u)) >> 16; }
__device__ __forceinline__ unsigned pk2(float lo, float hi) { unsigned r; asm("v_cvt_pk_bf16_f32 %0, %1, %2" : "=v"(r) : "v"(lo), "v"(hi)); return r; }
__device__ __forceinline__ float bf2f(unsigned short b) { return __builtin_bit_cast(float, ((unsigned)b) << 16); }
__device__ __forceinline__ float bflo(unsigned w) { return __builtin_bit_cast(float, w << 16); }
__device__ __forceinline__ float bfhi(unsigned w) { return __builtin_bit_cast(float, w & 0xffff0000u); }
__device__ __forceinline__ float wave_sum(float v) {
    const int ln_ = lane_now();
#pragma unroll
    for (int o = 1; o < 64; o <<= 1) v += shx(v, o, ln_);
    return v;
}
__device__ __forceinline__ float silu(float v) { return v / (1.0f + __expf(-v)); }
__device__ __forceinline__ float silu_fast(float v) { return v * __builtin_amdgcn_rcpf(1.0f + __builtin_amdgcn_exp2f(-1.4426950408889634f * v)); }

#define XB_TMO      128
#define XB_XCNT(j)  (256  + 64 * (j))
#define XB_XSUB(j)  (1280 + 64 * (j))
#define XB_XGEN(j)  (2304 + 64 * (j))
#define XB_TOP      3328
#define XB_TOPGEN   3392
#define XCD_BAR_WORDS 3456
#define XB_SPIN_CAP (1u << 20)
__device__ __forceinline__ unsigned xb_ld(unsigned* p)              { return __hip_atomic_load(p, __ATOMIC_RELAXED, __HIP_MEMORY_SCOPE_AGENT); }
__device__ __forceinline__ unsigned xb_add(unsigned* p, unsigned v) { return __hip_atomic_fetch_add(p, v, __ATOMIC_RELAXED, __HIP_MEMORY_SCOPE_AGENT); }
__device__ __forceinline__ unsigned xb_xcc_id() { return (unsigned)__builtin_amdgcn_s_getreg((3 << 11) | 20) & 0xFu; }
#define XB_SPIN(cond, bar) do { unsigned _sp = 0; while (cond) { __builtin_amdgcn_s_sleep(1); \
    if ((++_sp & 255u) == 0u) { if (xb_ld(&(bar)[XB_TMO])) break; if (_sp > XB_SPIN_CAP) { atomicAdd(&(bar)[XB_TMO], 1u); break; } } } } while (0)
struct XcdBarrier { unsigned* bar; unsigned x; volatile LAS unsigned* st; int wv; };
__device__ __forceinline__ XcdBarrier xcd_barrier_post(unsigned* bar, volatile LAS unsigned* st) {
    XcdBarrier b; b.bar = bar; b.x = xb_xcc_id(); b.st = st;
    if (threadIdx.x == 0) (void)xb_add(&bar[XB_XCNT(b.x)], 1u);
    return b;
}
__device__ __forceinline__ void xcd_barrier_complete(unsigned* bar, unsigned x, unsigned& nloc, unsigned& nx) {
    const unsigned G = gridDim.x * gridDim.y * gridDim.z;
    unsigned sum, cnt, mine, sp = 0u;
    for (;;) {
        sum = 0u; cnt = 0u; mine = 0u;
#pragma unroll
        for (unsigned j = 0; j < 16; ++j) { const unsigned c = xb_ld(&bar[XB_XCNT(j)]); sum += c; cnt += (c > 0u) ? 1u : 0u; mine = (j == x) ? c : mine; }
        if (sum == G) break;
        __builtin_amdgcn_s_sleep(1);
        if ((++sp & 255u) == 0u) { if (xb_ld(&bar[XB_TMO])) break; if (sp > XB_SPIN_CAP) { atomicAdd(&bar[XB_TMO], 1u); break; } }
    }
    nloc = mine > 0u ? mine : 1u; nx = cnt > 0u ? cnt : 1u;
}
__device__ __forceinline__ void xcd_barrier(const XcdBarrier& b) {
    asm volatile("s_waitcnt vmcnt(0)" ::: "memory");
    __syncthreads();
    int l0_; asm volatile("v_mbcnt_lo_u32_b32 %0, -1, 0\n\tv_mbcnt_hi_u32_b32 %0, -1, %0" : "=v"(l0_));
    if (b.wv == 0 && l0_ == 0) {
        unsigned* bar = b.bar;
        __builtin_amdgcn_s_waitcnt(0);
        unsigned nloc = b.st[0], nx = b.st[1];
        if (nloc == 0u) { xcd_barrier_complete(bar, b.x, nloc, nx); b.st[0] = nloc; b.st[1] = nx; }
        const unsigned old = xb_add(&bar[XB_XSUB(b.x)], 1u);
        const unsigned gen = old / nloc;
        if (old + 1u == (gen + 1u) * nloc) {
            __builtin_amdgcn_fence(__ATOMIC_RELEASE, "agent");
            asm volatile("s_waitcnt vmcnt(0)" ::: "memory");
            const unsigned og = xb_add(&bar[XB_TOP], 1u);
            const unsigned tg = og / nx;
            if (og + 1u == (tg + 1u) * nx) xb_add(&bar[XB_TOPGEN], 1u);
            else XB_SPIN(xb_ld(&bar[XB_TOPGEN]) == tg, bar);
            __builtin_amdgcn_fence(__ATOMIC_ACQUIRE, "agent");
            xb_add(&bar[XB_XGEN(b.x)], 1u);
            asm volatile("s_waitcnt vmcnt(0)" ::: "memory");
        } else {
            XB_SPIN(xb_ld(&bar[XB_XGEN(b.x)]) == gen, bar);
            __builtin_amdgcn_fence(__ATOMIC_ACQUIRE, "agent");
            asm volatile("s_waitcnt vmcnt(0)" ::: "memory");
        }
    }
    __syncthreads();
}

struct Args { const float* in[38]; float* out; unsigned char* ws; int ph_lo, ph_hi, pad0, pad1; };
enum { I_X = 0, I_C, I_CTX, I_CCTX, I_WADA, I_BADA, I_NORM1, I_NORM2, I_WIN, I_WOUT, I_QNORM, I_KNORM, I_SINKS, I_ATTON, I_SCW, I_SCB, I_SDTB, I_SALOG, I_SD, I_SNORM,
       I_HCW, I_HCB, I_HW1, I_HB1, I_HF1, I_HW2, I_HB2, I_HF2, I_HW3, I_HBIAS, I_HON, I_FG, I_FU, I_FD, I_MR, I_MG, I_MU, I_MD };

struct Ctx {
    const float* const CAS* in; float* out; unsigned char* ws; LAS unsigned char* lds;
    int tid, lane, wave, bid, G, dry;
};
#define WSP(type, off) ((type*)(C.ws + (off)))

__device__ __forceinline__ void phase_siluc(const Ctx& C) {
    float* sc = WSP(float, WS_SILUC);
    for (int i = C.bid * NTHR + C.tid; i < 33 * 1024; i += C.G * NTHR) {
        const int r = i >> 10, k = i & 1023; const float v = (r < 32) ? C.in[I_C][r * 1024 + k] : C.in[I_CCTX][k];
        sc[i] = silu(v);
    }
    float* rp = WSP(float, WS_ROPE);
    for (int i = C.bid * NTHR + C.tid; i < 96 * 16; i += C.G * NTHR) { const int pos = i >> 4, f = i & 15;
        const float inv = powf(10000.0f, -(float)(2 * f) / 32.0f); const float ang = (float)(pos < 32 ? pos : pos - 32) * inv;
        rp[pos * 32 + f] = cosf(ang); rp[pos * 32 + 16 + f] = sinf(ang); }
}

template <class SRC>
__device__ __forceinline__ void conv_item(const SRC& S, int K, int ld, bf16* WT, LAS float* scr, int item, int nblk, int lane) {
    const int kb = item / nblk, nb = item % nblk, k0 = 64 * kb;
    const float* sp; int col; const int myrow = S.row(nb, lane); S(myrow, sp, col);
    float tmp[64];
#pragma unroll
    for (int i = 0; i < 64; ++i) tmp[i] = sp[(size_t)(k0 + i) * ld + col];
#pragma unroll
    for (int i = 0; i < 64; ++i) scr[i * 65 + lane] = tmp[i];
    LDS_WAIT(); asm volatile("" ::: "memory");
    const int c = lane & 7;
#pragma unroll
    for (int j = 0; j < 8; ++j) { const int n = (lane >> 3) + 8 * j; const LAS float* s = scr + (8 * c) * 65 + n;
        v4u o; o.x = pk2(s[0 * 65], s[1 * 65]); o.y = pk2(s[2 * 65], s[3 * 65]); o.z = pk2(s[4 * 65], s[5 * 65]); o.w = pk2(s[6 * 65], s[7 * 65]);
        *(v4u*)(WT + (size_t)S.row(nb, n) * K + k0 + 8 * c) = o; }
    LDS_WAIT(); asm volatile("" ::: "memory");
}
struct SrcWin { const float* w; __device__ __forceinline__ int row(int nb, int l) const { return 64 * nb + l; }
    __device__ __forceinline__ void operator()(int rho, const float*& p, int& col) const { p = w;
    if (rho >= 1536) col = rho + 8; else if (rho >= 768) col = rho; else {
        const int pn = rho >> 8, r = rho & 255, bj = r >> 7, wc = (r >> 5) & 3, fq = (r >> 3) & 3, n = (r >> 2) & 1, e = r & 3;
        col = pn * 256 + wc * 64 + ((pn == 2 && wc >= 2) ? (16 * fq + 8 * bj + 4 * n + e) : (32 * bj + 16 * n + 4 * fq + e)); } } };
struct SrcPlain { const float* w; __device__ __forceinline__ int row(int nb, int l) const { return 64 * nb + l; }
    __device__ __forceinline__ void operator()(int rho, const float*& p, int& col) const { p = w; col = rho; } };
struct SrcGU { const float* g; const float* u;
    __device__ __forceinline__ int row(int nb, int l) const { return 256 * (nb >> 2) + 128 * (l >> 5) + 32 * (nb & 3) + (l & 31); }
    __device__ __forceinline__ void operator()(int rho, const float*& p, int& col) const {
    const int pn = rho >> 8, r = rho & 255, bj = r >> 7, wc = (r >> 5) & 3, fq = (r >> 3) & 3, n = (r >> 2) & 1, e = r & 3;
    p = (const float*)((const char*)g + (long)n * ((const char*)u - (const char*)g)); col = 128 * pn + 32 * wc + 8 * fq + 4 * bj + e; } };

__device__ __forceinline__ void hy_filter_item(const Ctx& C, int layer, int item) {
    const bool lat = item < 64; const int L = lat ? 2048 : 256; const int pos0 = 32 * (lat ? item : item - 64);
    LAS float* z = (LAS float*)C.lds;
    LAS float* h1 = z + 32 * 33;
    LAS float* h2 = h1 + 32 * 64;
    const float* w1 = C.in[I_HW1] + (size_t)layer * 33 * 64; const float* b1 = C.in[I_HB1] + layer * 64; const float* f1 = C.in[I_HF1] + layer * 64;
    const float* w2 = C.in[I_HW2] + (size_t)layer * 64 * 64; const float* b2 = C.in[I_HB2] + layer * 64; const float* f2 = C.in[I_HF2] + layer * 64;
    const float* w3 = C.in[I_HW3] + (size_t)layer * 64 * 1024; const float* hb = C.in[I_HBIAS] + (size_t)layer * 512;
    __syncthreads();
    for (int t = C.tid; t < 32 * 33; t += NTHR) { const int p = t / 33, j = t % 33; const int i = pos0 + p;
        const float tt = (float)i / (float)(L - 1); const float wv = (6.283185307179586f / (float)L) * (float)i;
        float v;
        if (j == 0) v = tt;
        else { const int jj = (j - 1) & 15; const float fr = 1e-4f + (float)jj * ((15.0f - 1e-4f) / 15.0f); const float a = fr * wv; v = (j <= 16) ? cosf(a) : -sinf(a); }
        z[p * 33 + j] = v; }
    __syncthreads();
    {
        const int k = C.tid & 63, p0 = C.tid >> 6;
        { float wc[33];
#pragma unroll
          for (int j = 0; j < 33; ++j) wc[j] = w1[j * 64 + k];
          const float bb = b1[k], ff = f1[k];
#pragma unroll 1
          for (int i = 0; i < 4; ++i) { const int p = p0 + 8 * i; float s = bb;
#pragma unroll
              for (int j = 0; j < 33; ++j) s += z[p * 33 + j] * wc[j];
              h1[p * 64 + k] = sinf(ff * s); } }
        __syncthreads();
        { float wd[64];
#pragma unroll
          for (int j = 0; j < 64; ++j) wd[j] = w2[j * 64 + k];
          const float bb = b2[k], ff = f2[k];
#pragma unroll 1
          for (int i = 0; i < 4; ++i) { const int p = p0 + 8 * i; float s = bb;
#pragma unroll
              for (int j = 0; j < 64; ++j) s += h1[p * 64 + j] * wd[j];
              h2[p * 64 + k] = sinf(ff * s); } }
    }
    __syncthreads();
    const float dmin = -3.0701134573253946f, dmax = -15.350567286626973f;
    bf16* FL = lat ? WSP(bf16, WS_FILTB) + (size_t)layer * 512 * 4096 : WSP(bf16, WS_FILTCB) + (size_t)layer * 512 * 512; const int FS = lat ? 4096 : 512;
    for (int o = C.tid; o < 1024; o += NTHR) {
        float acc[32];
#pragma unroll
        for (int p = 0; p < 32; ++p) acc[p] = 0.f;
#pragma unroll 2
        for (int j0 = 0; j0 < 64; j0 += 4) {
            const float wa = w3[j0 * 1024 + o], wb = w3[(j0 + 1) * 1024 + o], wc_ = w3[(j0 + 2) * 1024 + o], wd_ = w3[(j0 + 3) * 1024 + o];
#pragma unroll
            for (int p = 0; p < 32; ++p) { const f32x4 hv = *(const LAS f32x4*)(h2 + p * 64 + j0); acc[p] += (hv.x * wa + hv.y * wb) + (hv.z * wc_ + hv.w * wd_); } }
        const int dir = o >> 9, order = (o >> 8) & 1, c = o & 255;
        const float delta = fabsf(dmin + (float)c * ((dmax - dmin) / 255.0f));
        bf16* fo = FL + ((size_t)order * 256 + c) * FS;
#pragma unroll
        for (int p = 0; p < 32; ++p) { const int lag = pos0 + p; const float tt = (float)lag / (float)(L - 1);
            float v = acc[p] * expf(-tt * delta);
            if (dir == 0) { if (lag == 0) v += hb[order * 256 + c]; fo[(L - 1) - lag] = (bf16)f2bf(v); }
            else if (lag >= 1) fo[(L - 1) + lag] = (bf16)f2bf(v); }
    }
    __syncthreads();
}

__device__ __forceinline__ void conv_block_load(f32x4 (&v)[16], const float* W, int ld, int k0, int c0, int tid) {
#pragma unroll
    for (int j = 0; j < 16; ++j) { const int kr = (tid >> 6) + 8 * j; v[j] = *(const f32x4*)(W + (size_t)(k0 + kr) * ld + c0 + 4 * (tid & 63)); }
}
constexpr int CB_PITCH = 520;
__device__ __forceinline__ void conv_block_tile(const Ctx& C, const f32x4 (&v)[16]) {
    const int tid = C.tid;
#pragma unroll
    for (int j = 0; j < 16; ++j) { const int kr = (tid >> 6) + 8 * j; v2u o; o.x = pk2(v[j].x, v[j].y); o.y = pk2(v[j].z, v[j].w); *(LAS v2u*)(C.lds + kr * CB_PITCH + 8 * (tid & 63)) = o; }
    __syncthreads();
}
template <class DST>
__device__ __forceinline__ void conv_block_out(const Ctx& C, int K, int k0, int c0, bf16* WT, const DST& dst) {
    const int tid = C.tid, n = tid & 255, half = tid >> 8;
    bf16* orow = WT + (size_t)dst(c0 + n) * K + k0 + 64 * half;
#pragma unroll
    for (int c = 0; c < 8; ++c) { unsigned short e[8];
#pragma unroll
        for (int i = 0; i < 8; ++i) e[i] = *(const LAS unsigned short*)(C.lds + (64 * half + 8 * c + i) * CB_PITCH + 2 * n);
        v4u o; o.x = e[0] | ((unsigned)e[1] << 16); o.y = e[2] | ((unsigned)e[3] << 16); o.z = e[4] | ((unsigned)e[5] << 16); o.w = e[6] | ((unsigned)e[7] << 16);
        *(v4u*)(orow + 8 * c) = o; }
    __syncthreads();
}
struct DstPlain { __device__ __forceinline__ int operator()(int c) const { return c; } };
struct DstGU { int n; __device__ __forceinline__ int operator()(int hid) const { const int pn = hid >> 7, r = hid & 127, wc = r >> 5, fq = (r >> 3) & 3, bj = (r >> 2) & 1, e = r & 3;
    return 256 * pn + 128 * bj + 32 * wc + 8 * fq + 4 * n + e; } };
__device__ __forceinline__ void phase_pre(const Ctx& C, int layer) {
    LAS float* scr = (LAS float*)(C.lds + C.wave * 16640);
    const bool moe = layer & 1; const int j2 = layer >> 1;
    const int ne = moe ? NEXP : 1;
    unsigned* heads = (unsigned*)(C.ws + WS_CTL) + CW_WQ + 8 * C.dry;
    volatile LAS int* bcast = (volatile LAS int*)(C.lds + MISC_OFF + 64);
    __syncthreads();
    {
        const int nit = ne * 264;
        f32x4 v[16];
        int it, itn;
#define CB_DECODE(IT, W_, LD_, K_, K0_, C0_, WT_, NSEL_, ISGU_) do { const int _e = (IT) / 264; int _r = (IT) % 264; const float *wg, *wu, *wd; \
            if (moe) { const size_t o = ((size_t)j2 * NEXP + _e) * (size_t)D * FF; wg = C.in[I_MG] + o; wu = C.in[I_MU] + o; wd = C.in[I_MD] + o; } \
            else { const size_t o = (size_t)j2 * D * FF; wg = C.in[I_FG] + o; wu = C.in[I_FU] + o; wd = C.in[I_FD] + o; } \
            if (_r < 176) { NSEL_ = _r / 88; _r %= 88; ISGU_ = true; W_ = NSEL_ ? wu : wg; LD_ = FF; K_ = D; K0_ = 128 * (_r / 11); C0_ = 256 * (_r % 11); WT_ = WSP(bf16, WS_F1) + (size_t)_e * 2 * FF * D; } \
            else { _r -= 176; NSEL_ = 0; ISGU_ = false; W_ = wd; LD_ = D; K_ = FF; K0_ = 128 * (_r / 4); C0_ = 256 * (_r % 4); WT_ = WSP(bf16, WS_F2) + (size_t)_e * D * FF; } } while (0)
#define CB_POP(DSTV) do { if (C.tid == 0) bcast[0] = (int)__hip_atomic_fetch_add(heads + 4 + layer, 1u, __ATOMIC_RELAXED, __HIP_MEMORY_SCOPE_AGENT); __syncthreads(); DSTV = bcast[0]; __syncthreads(); } while (0)
        CB_POP(it);
        const float* W = nullptr; int ld = 0, K = 0, k0 = 0, c0 = 0, nsel = 0; bool isgu = false; bf16* WT = nullptr;
        if (it < nit) { CB_DECODE(it, W, ld, K, k0, c0, WT, nsel, isgu); conv_block_load(v, W, ld, k0, c0, C.tid); }
        while (it < nit) {
            conv_block_tile(C, v);
            CB_POP(itn);
            const float* Wn = nullptr; int ldn = 0, Kn = 0, k0n = 0, c0n = 0, nseln = 0; bool isgun = false; bf16* WTn = nullptr;
            if (itn < nit) { CB_DECODE(itn, Wn, ldn, Kn, k0n, c0n, WTn, nseln, isgun); conv_block_load(v, Wn, ldn, k0n, c0n, C.tid); }
            if (isgu) { const DstGU d{nsel}; conv_block_out(C, K, k0, c0, WT, d); } else { const DstPlain d{}; conv_block_out(C, K, k0, c0, WT, d); }
            it = itn; W = Wn; ld = ldn; K = Kn; k0 = k0n; c0 = c0n; WT = WTn; nsel = nseln; isgu = isgun;
        }
#undef CB_DECODE
#undef CB_POP
    }
    {
        const SrcWin s_in{C.in[I_WIN] + (size_t)layer * D * PROJ_W};
        const SrcPlain s_out{C.in[I_WOUT] + (size_t)layer * D * D};
        constexpr int I_IN = 16 * (WROWS / 64), I_OUT = 16 * 16;
        for (;;) {
            int it = 0; if (C.lane == 0) it = (int)__hip_atomic_fetch_add(heads + layer, 1u, __ATOMIC_RELAXED, __HIP_MEMORY_SCOPE_AGENT);
            it = __builtin_amdgcn_readfirstlane(it);
            if (it >= I_IN + I_OUT) break;
            if (it < I_IN) conv_item(s_in, D, PROJ_W, WSP(bf16, WS_WIN), scr, it, WROWS / 64, C.lane);
            else conv_item(s_out, D, D, WSP(bf16, WS_WOUT), scr, it - I_IN, 16, C.lane);
        }
    }
    __syncthreads();
}
__device__ __forceinline__ void mod_task(const Ctx& C, int layer, int grp) {
    const float* sc = WSP(float, WS_SILUC); const float* wa = C.in[I_WADA] + (size_t)layer * D * 6144; const float* ba = C.in[I_BADA] + (size_t)layer * 6144;
    float* mod = WSP(float, WS_MOD) + (size_t)layer * 33 * 6144;
    LAS float* part = (LAS float*)C.lds;
    LAS float* SL = (LAS float*)C.lds + C.wave * (33 * 128);
    const int n = grp * 128 + C.lane; float acc[2][33];
    const int k0 = C.wave * 128;
    __syncthreads();
    for (int i = C.lane; i < 33 * 32; i += 64) { const int r = i >> 5, c4 = i & 31; *(LAS f32x4*)(SL + r * 128 + 4 * c4) = *(const f32x4*)(sc + r * 1024 + k0 + 4 * c4); }
#pragma unroll
    for (int r = 0; r < 33; ++r) { acc[0][r] = 0.f; acc[1][r] = 0.f; }
    asm volatile("s_waitcnt vmcnt(0) lgkmcnt(0)" ::: "memory");
    for (int kk = 0; kk < 128; kk += 8) { float w[2][8];
#pragma unroll
        for (int u = 0; u < 8; ++u) { w[0][u] = wa[(size_t)(k0 + kk + u) * 6144 + n]; w[1][u] = wa[(size_t)(k0 + kk + u) * 6144 + n + 64]; }
#pragma unroll
        for (int r = 0; r < 33; ++r) { const f32x4 s0 = *(const LAS f32x4*)(SL + r * 128 + kk), s1 = *(const LAS f32x4*)(SL + r * 128 + kk + 4);
#pragma unroll
            for (int c = 0; c < 2; ++c)
                acc[c][r] += (s0.x * w[c][0] + s0.y * w[c][1]) + (s0.z * w[c][2] + s0.w * w[c][3]) + (s1.x * w[c][4] + s1.y * w[c][5]) + (s1.z * w[c][6] + s1.w * w[c][7]); } }
    __syncthreads();
#pragma unroll
    for (int r = 0; r < 33; ++r) { part[(C.wave * 33 + r) * 128 + C.lane] = acc[0][r]; part[(C.wave * 33 + r) * 128 + 64 + C.lane] = acc[1][r]; }
    __syncthreads();
    for (int o = C.tid; o < 33 * 128; o += NTHR) { const int r = o >> 7, l = o & 127; float s = ba[grp * 128 + l];
#pragma unroll
        for (int w = 0; w < 8; ++w) s += part[(w * 33 + r) * 128 + l];
        mod[(size_t)r * 6144 + grp * 128 + l] = s; }
    __syncthreads();
}
__device__ __forceinline__ void phase_setup(const Ctx& C) {
    for (int t = C.bid; t < 4 * 120; t += C.G) { const int layer = t / 120, r = t % 120;
#if defined(PROBE_SETUP_ONLY)
        if (C.dry && ((PROBE_SETUP_ONLY == 0) != (r < 48))) continue;
#endif
        if (r < 48) mod_task(C, layer, r); else hy_filter_item(C, layer, r - 48); }
    __syncthreads();
}

__device__ __forceinline__ const float* norm_row_ptr_f32(const Ctx& C, int m) { return m < TLAT ? C.in[I_X] + (size_t)m * D : C.in[I_CTX] + (size_t)(m - TLAT) * D; }
__device__ __forceinline__ const bf16* norm_row_ptr_bf(const Ctx& C, int m) { return m < TLAT ? (const bf16*)C.out + (size_t)m * D : WSP(bf16, WS_XC) + (size_t)(m - TLAT) * D; }
__device__ __forceinline__ void phase_norm(const Ctx& C, int layer, int which) {
    LAS int* lcnt = (LAS int*)(C.lds + 32768);
    if (C.tid < 16) lcnt[C.tid] = 0;
    const bool moe = layer & 1; const bool need_extra = (which == 0) || moe;
    __syncthreads();
    const int lane = C.lane;
    f32x4 wlo[4][4], whi[4][4];
#pragma unroll
    for (int j = 0; j < 4; ++j)
#pragma unroll
        for (int e = 0; e < 4; ++e) { const int k = 8 * lane + 512 * (j >> 1) + 4 * (j & 1) + e;
            if (need_extra) {
                if (which == 0) { const float* wp = C.in[I_WIN] + (size_t)layer * D * PROJ_W + (size_t)k * PROJ_W + 1536; wlo[j][e] = *(const f32x4*)wp; whi[j][e] = *(const f32x4*)(wp + 4); }
                else { const float* wp = C.in[I_MR] + (size_t)(layer >> 1) * D * 8 + (size_t)k * 8; wlo[j][e] = *(const f32x4*)wp; whi[j][e] = *(const f32x4*)(wp + 4); }
            } else { wlo[j][e] = (f32x4){0.f, 0.f, 0.f, 0.f}; whi[j][e] = wlo[j][e]; } }
    const float* gn = (which == 0 ? C.in[I_NORM1] : C.in[I_NORM2]) + layer * D;
    const float* mod = WSP(float, WS_MOD) + (size_t)layer * 33 * 6144;
    const int i_sh = which == 0 ? 0 : 3, i_sc = which == 0 ? 1 : 4;
    bf16* O = WSP(bf16, WS_A);
    const int gw = C.bid * NWAVES + C.wave, NGW = C.G * NWAVES;
    const int nrows = (which == 1 && layer == DEPTH - 1) ? TLAT : TT;
    const int rpw = (nrows + NGW - 1) / NGW;
    int m0 = gw * rpw; asm volatile("" : "+s"(m0));
    const int m1 = (m0 + rpw < nrows) ? m0 + rpw : nrows;
    const bool first = which == 0 && layer == 0;
    f32x4 gA[4], gB[4]; int cur_mr = -1;
    f32x4 v[4]; v4u rw[2];
    if (m0 < m1) {
        if (first) { const f32x4* xr = (const f32x4*)norm_row_ptr_f32(C, m0) + 2 * lane;
#pragma unroll
            for (int j = 0; j < 4; ++j) v[j] = xr[128 * (j >> 1) + (j & 1)]; }
        else { const v4u* xr = (const v4u*)norm_row_ptr_bf(C, m0) + lane;
#pragma unroll
            for (int j = 0; j < 2; ++j) rw[j] = xr[64 * j]; } }
    for (int m = m0; m < m1; ++m) {
        const bool lat = m < TLAT; const int mr = lat ? (m >> 11) : 32;
        if (mr != cur_mr) { cur_mr = mr; const float* msh = mod + (size_t)mr * 6144 + i_sh * 1024; const float* msc = mod + (size_t)mr * 6144 + i_sc * 1024;
#pragma unroll
            for (int j = 0; j < 4; ++j) { const int k = 8 * lane + 512 * (j >> 1) + 4 * (j & 1); gA[j] = *(const f32x4*)(gn + k) * (1.0f + *(const f32x4*)(msc + k)); gB[j] = *(const f32x4*)(msh + k); } }
        f32x4 cv[4];
#pragma unroll
        for (int j = 0; j < 4; ++j) { const unsigned a = (j & 1) ? rw[j >> 1].z : rw[j >> 1].x, b = (j & 1) ? rw[j >> 1].w : rw[j >> 1].y; cv[j] = first ? v[j] : (f32x4){bflo(a), bfhi(a), bflo(b), bfhi(b)}; }
        if (m + 1 < m1) {
            if (first) { const f32x4* xr = (const f32x4*)norm_row_ptr_f32(C, m + 1) + 2 * lane;
#pragma unroll
                for (int j = 0; j < 4; ++j) v[j] = xr[128 * (j >> 1) + (j & 1)]; }
            else { const v4u* xr = (const v4u*)norm_row_ptr_bf(C, m + 1) + lane;
#pragma unroll
                for (int j = 0; j < 2; ++j) rw[j] = xr[64 * j]; } }
        float ss = 0.f;
#pragma unroll
        for (int j = 0; j < 4; ++j) ss += (cv[j].x * cv[j].x + cv[j].y * cv[j].y) + (cv[j].z * cv[j].z + cv[j].w * cv[j].w);
        const float rstd = rsqrtf(wave_sum(ss) * (1.0f / D) + EPS);
        f32x4 elo = (f32x4){0.f, 0.f, 0.f, 0.f}, ehi = elo;
        v4u* o16 = (v4u*)(O + (size_t)m * D) + lane; unsigned pw[8];
#pragma unroll
        for (int j = 0; j < 4; ++j) {
            const f32x4 h = cv[j] * rstd * gA[j] + gB[j];
            pw[2 * j] = pk2(h.x, h.y); pw[2 * j + 1] = pk2(h.z, h.w);
            if (j & 1) o16[64 * (j >> 1)] = (v4u){pw[2 * j - 2], pw[2 * j - 1], pw[2 * j], pw[2 * j + 1]};
            if (need_extra) {
#pragma unroll
                for (int e = 0; e < 4; ++e) { elo = elo + h[e] * wlo[j][e]; ehi = ehi + h[e] * whi[j][e]; } }
        }
        if (need_extra) {
            const bool b0 = lane & 1, b1 = lane & 2, b2 = lane & 4;
            float k4[4], k2[2];
#pragma unroll
            for (int j = 0; j < 4; ++j) { const float send = b0 ? elo[j] : ehi[j], keep = b0 ? ehi[j] : elo[j]; k4[j] = keep + shx(send, 1, lane); }
#pragma unroll
            for (int j = 0; j < 2; ++j) { const float send = b1 ? k4[j] : k4[2 + j], keep = b1 ? k4[2 + j] : k4[j]; k2[j] = keep + shx(send, 2, lane); }
            float k1; { const float send = b2 ? k2[0] : k2[1], keep = b2 ? k2[1] : k2[0]; k1 = keep + shx(send, 4, lane); }
            k1 += shx(k1, 8, lane); k1 += shx(k1, 16, lane); k1 += shx(k1, 32, lane);
            if (which == 0) { if (lane < 8) WSP(float, WS_DT)[(size_t)m * 8 + 4 * (lane & 1) + (lane & 2) + ((lane >> 2) & 1)] = k1; }
            else {
                float ex[8]; const int ki = __builtin_bit_cast(int, k1);
                ex[0] = __builtin_bit_cast(float, __builtin_amdgcn_readlane(ki, 0)); ex[1] = __builtin_bit_cast(float, __builtin_amdgcn_readlane(ki, 4));
                ex[2] = __builtin_bit_cast(float, __builtin_amdgcn_readlane(ki, 2)); ex[3] = __builtin_bit_cast(float, __builtin_amdgcn_readlane(ki, 6));
                ex[4] = __builtin_bit_cast(float, __builtin_amdgcn_readlane(ki, 1)); ex[5] = __builtin_bit_cast(float, __builtin_amdgcn_readlane(ki, 5));
                ex[6] = __builtin_bit_cast(float, __builtin_amdgcn_readlane(ki, 3)); ex[7] = __builtin_bit_cast(float, __builtin_amdgcn_readlane(ki, 7));
                int i0 = 0; float v0 = ex[0];
#pragma unroll
                for (int j = 1; j < 8; ++j) if (ex[j] > v0) { v0 = ex[j]; i0 = j; }
                int i1 = -1; float v1 = -3.0e38f;
#pragma unroll
                for (int j = 0; j < 8; ++j) if (j != i0 && ex[j] > v1) { v1 = ex[j]; i1 = j; }
                if (lane == 0) {
                    const float e1 = __expf(v1 - v0); const float w0 = 1.0f / (1.0f + e1), w1 = e1 / (1.0f + e1);
                    const int lp0 = __hip_atomic_fetch_add(lcnt + i0, 1, __ATOMIC_RELAXED, __HIP_MEMORY_SCOPE_WORKGROUP), lp1 = __hip_atomic_fetch_add(lcnt + 8 + i1, 1, __ATOMIC_RELAXED, __HIP_MEMORY_SCOPE_WORKGROUP);
                    int* d = (int*)(WSP(float, WS_COMB) + (size_t)m * 8);
                    *(v4u*)d = (v4u){(unsigned)i0, (unsigned)i1, (unsigned)lp0, (unsigned)lp1}; *(f32x4*)(d + 4) = (f32x4){w0, w1, 0.f, 0.f};
                }
            }
        }
    }
    __syncthreads();
    if (which == 1 && moe && C.tid < 16) {
        unsigned* ctl = (unsigned*)(C.ws + WS_CTL);
        const unsigned base = __hip_atomic_fetch_add(ctl + CW_GCNT + 64 * C.dry + layer * 16 + C.tid, (unsigned)lcnt[C.tid], __ATOMIC_RELAXED, __HIP_MEMORY_SCOPE_AGENT);
        ctl[CW_BB + 4096 * C.dry + C.bid * 16 + C.tid] = base;
    }
    __syncthreads();
}

__device__ __forceinline__ void moe_offsets(const Ctx& C, int layer, int slot, int (&off)[9]) {
    const unsigned* cnt = (const unsigned*)(C.ws + WS_CTL) + CW_GCNT + 64 * C.dry + layer * 16 + slot * 8;
    off[0] = 0;
#pragma unroll
    for (int e = 0; e < 8; ++e) { const int c = (int)__builtin_amdgcn_readfirstlane((int)__hip_atomic_load(cnt + e, __ATOMIC_RELAXED, __HIP_MEMORY_SCOPE_AGENT)); off[e + 1] = off[e] + ((c + 255) & ~255); }
}
__device__ __forceinline__ void phase_moe_maps(const Ctx& C, int layer) {
    const unsigned* ctl = (const unsigned*)(C.ws + WS_CTL);
    const int NGW = C.G * NWAVES;
    const int nrows = (layer == DEPTH - 1) ? TLAT : TT;
    const int rpw = (nrows + NGW - 1) / NGW;
#pragma unroll
    for (int slot = 0; slot < 2; ++slot) {
        int off[9]; moe_offsets(C, layer, slot, off);
        int* rowtok = slot ? WSP(int, WS_ROWTOK1) : WSP(int, WS_ROWTOK); float* roww = slot ? WSP(float, WS_ROWW1) : WSP(float, WS_ROWW);
        unsigned* goff = slot ? WSP(unsigned, WS_GOFF1) : WSP(unsigned, WS_GOFF);
        for (int m = C.bid * NTHR + C.tid; m < nrows; m += C.G * NTHR) {
            const int* rt = (const int*)(WSP(float, WS_COMB) + (size_t)m * 8);
            const int e = rt[slot], lp = rt[2 + slot]; const float w = ((const float*)rt)[4 + slot];
            const int blk = (m / rpw) >> 3;
            int oe = 0;
#pragma unroll
            for (int j = 0; j < 8; ++j) oe = (e == j) ? off[j] : oe;
            const int pos = oe + (int)ctl[CW_BB + 4096 * C.dry + blk * 16 + slot * 8 + e] + lp;
            rowtok[pos] = m; roww[pos] = w; goff[(pos & ~255) + 4 * (pos & 63) + ((pos >> 6) & 3)] = (unsigned)m * 2048u;
        }
        const unsigned* cnt = ctl + CW_GCNT + 64 * C.dry + layer * 16 + slot * 8;
        for (int i = C.bid * NTHR + C.tid; i < 8 * 256; i += C.G * NTHR) { const int e = i >> 8, j = i & 255;
            int oe = 0, on = 0;
#pragma unroll
            for (int k = 0; k < 8; ++k) { oe = (e == k) ? off[k] : oe; on = (e == k) ? off[k + 1] : on; }
            const int r = oe + (int)cnt[e] + j; if (r < on) { rowtok[r] = -1; goff[(r & ~255) + 4 * (r & 63) + ((r >> 6) & 3)] = 0u; } }
    }
}

constexpr int AT_KROW = 144, AT_VROW = 320, AT_KB = 64 * AT_KROW, AT_VB = 64 * AT_VROW, AT_BUF = AT_KB + AT_VB, AT_NBUF = 4;
static_assert(AT_NBUF * AT_BUF <= MISC_OFF, "attention LDS ring");
__device__ __forceinline__ v4u pk8s(float a0, float a1, float a2, float a3, float a4, float a5, float a6, float a7) {
    v4u w; asm("s_nop 0\n\tv_cvt_pk_bf16_f32 %0, %4, %5\n\tv_cvt_pk_bf16_f32 %1, %6, %7\n\tv_cvt_pk_bf16_f32 %2, %8, %9\n\tv_cvt_pk_bf16_f32 %3, %10, %11"
                   : "=&v"(w.x), "=&v"(w.y), "=&v"(w.z), "=&v"(w.w) : "v"(a0), "v"(a1), "v"(a2), "v"(a3), "v"(a4), "v"(a5), "v"(a6), "v"(a7)); return w; }
template <int KT> __device__ __forceinline__ void at_qk(f32x16 (&S)[2], const LAS unsigned char* kb, const bf16x8 (&Qf)[2][4], int r, int h) {
    const LAS unsigned char* kp = kb + (32 * KT + r) * AT_KROW + 16 * h;
    const f32x16 Z = {0.f, 0.f, 0.f, 0.f, 0.f, 0.f, 0.f, 0.f, 0.f, 0.f, 0.f, 0.f, 0.f, 0.f, 0.f, 0.f};
    { const bf16x8 Kf = *(const LAS bf16x8*)kp;
#pragma unroll
      for (int qt = 0; qt < 2; ++qt) S[qt] = HY_MFMA(Kf, Qf[qt][0], Z); }
#pragma unroll
    for (int kk = 1; kk < 4; ++kk) { const bf16x8 Kf = *(const LAS bf16x8*)(kp + 32 * kk);
#pragma unroll
        for (int qt = 0; qt < 2; ++qt) S[qt] = HY_MFMA(Kf, Qf[qt][kk], S[qt]); }
}
template <int KT> __device__ __forceinline__ void at_pv(f32x16 (&O)[2][2], const v4u (&Pp)[2][2], unsigned va) {
#pragma unroll
    for (int s2 = 0; s2 < 2; ++s2) {
        v2u t00, t01, t10, t11;
        asm volatile("ds_read_b64_tr_b16 %0, %1 offset:%2" : "=&v"(t00) : "v"(va), "i"((32 * KT + 16 * s2) * AT_VROW) : "memory");
        asm volatile("ds_read_b64_tr_b16 %0, %1 offset:%2" : "=&v"(t01) : "v"(va), "i"((32 * KT + 16 * s2 + 8) * AT_VROW) : "memory");
        asm volatile("ds_read_b64_tr_b16 %0, %1 offset:%2" : "=&v"(t10) : "v"(va), "i"((32 * KT + 16 * s2) * AT_VROW + 64) : "memory");
        asm volatile("ds_read_b64_tr_b16 %0, %1 offset:%2" : "=&v"(t11) : "v"(va), "i"((32 * KT + 16 * s2 + 8) * AT_VROW + 64) : "memory");
        asm volatile("s_waitcnt lgkmcnt(0)" ::: "memory"); __builtin_amdgcn_sched_barrier(0);
        { v4u w; w.x = t00.x; w.y = t00.y; w.z = t01.x; w.w = t01.y; const bf16x8 Vf = __builtin_bit_cast(bf16x8, w);
#pragma unroll
          for (int qt = 0; qt < 2; ++qt) O[0][qt] = HY_MFMA(Vf, __builtin_bit_cast(bf16x8, Pp[qt][s2]), O[0][qt]); }
        { v4u w; w.x = t10.x; w.y = t10.y; w.z = t11.x; w.w = t11.y; const bf16x8 Vf = __builtin_bit_cast(bf16x8, w);
#pragma unroll
          for (int qt = 0; qt < 2; ++qt) O[1][qt] = HY_MFMA(Vf, __builtin_bit_cast(bf16x8, Pp[qt][s2]), O[1][qt]); }
    }
}
__device__ __forceinline__ void at_sm(f32x16 (&S)[2], v4u (&Pp)[2][2], float (&mrun)[2], float (&lrun)[2], f32x16 (&O)[2][2], bool band, int dl0) {
#pragma unroll
    for (int qt = 0; qt < 2; ++qt) {
        float mx = -1.0e30f;
#pragma unroll
        for (int e = 0; e < 16; ++e) { float t = S[qt][e];
            if (band) { const int dl = dl0 - 32 * qt + (e & 3) + 8 * (e >> 2); if (dl < -128 || dl > 128) t = -1.0e30f; }
            S[qt][e] = t; mx = fmaxf(mx, t); }
        { const auto rr = __builtin_amdgcn_permlane32_swap(__float_as_uint(mx), __float_as_uint(mx), false, false); mx = fmaxf(__uint_as_float(rr[0]), __uint_as_float(rr[1])); }
        const bool up = mx > mrun[qt] + 8.0f;
        const float mnew = up ? mx : mrun[qt];
        float ls = 0.f;
#pragma unroll
        for (int e = 0; e < 16; ++e) { const float p = __builtin_amdgcn_exp2f(S[qt][e] - mnew); S[qt][e] = p; ls += p; }
        if (__builtin_amdgcn_ballot_w64(up) != 0ull) {
            const float alpha = __builtin_amdgcn_exp2f(mrun[qt] - mnew); mrun[qt] = mnew;
            lrun[qt] = lrun[qt] * alpha + ls;
#pragma unroll
            for (int dt = 0; dt < 2; ++dt)
#pragma unroll
                for (int e = 0; e < 16; ++e) O[dt][qt][e] *= alpha;
        } else lrun[qt] += ls;
#pragma unroll
        for (int s2 = 0; s2 < 2; ++s2) Pp[qt][s2] = pk8s(S[qt][8 * s2 + 0], S[qt][8 * s2 + 1], S[qt][8 * s2 + 2], S[qt][8 * s2 + 3], S[qt][8 * s2 + 4], S[qt][8 * s2 + 5], S[qt][8 * s2 + 6], S[qt][8 * s2 + 7]);
    }
}
__device__ __forceinline__ void at_sm_fix(f32x16 (&S)[2], v4u (&Pp)[2][2], float (&lrun)[2], bool band, int dl0) {
#pragma unroll
    for (int qt = 0; qt < 2; ++qt) {
        float ls = 0.f;
#pragma unroll
        for (int e = 0; e < 16; ++e) { float t = S[qt][e];
            if (band) { const int dl = dl0 - 32 * qt + (e & 3) + 8 * (e >> 2); if (dl < -128 || dl > 128) t = -1.0e30f; }
            const float p = __builtin_amdgcn_exp2f(t); S[qt][e] = p; ls += p; }
        if (__builtin_amdgcn_ballot_w64(ls < 0.f) != 0ull) lrun[qt] = 0.f; else lrun[qt] += ls;
#pragma unroll
        for (int s2 = 0; s2 < 2; ++s2) Pp[qt][s2] = pk8s(S[qt][8 * s2 + 0], S[qt][8 * s2 + 1], S[qt][8 * s2 + 2], S[qt][8 * s2 + 3], S[qt][8 * s2 + 4], S[qt][8 * s2 + 5], S[qt][8 * s2 + 6], S[qt][8 * s2 + 7]);
    }
}
template <bool FIX> __device__ __forceinline__ void att_unit(const Ctx& C, const bf16* P, bf16* AO, float sinkl2, int b, int kvh, int qrow0, int qpos0, bool lat) {
    LAS unsigned char* lds = C.lds;
    int lane; asm volatile("v_mbcnt_lo_u32_b32 %0, -1, 0\n\tv_mbcnt_hi_u32_b32 %0, -1, %0" : "=v"(lane));
    const int tid = C.wave * 64 + lane;
    const int r = lane & 31, h = lane >> 5, g = C.wave & 3, qh = C.wave >> 2, hd = kvh * 4 + g;
    bf16x8 Qf[2][4];
#pragma unroll
    for (int qt = 0; qt < 2; ++qt)
#pragma unroll
        for (int kk = 0; kk < 4; ++kk) Qf[qt][kk] = *(const bf16x8*)(P + (size_t)(qrow0 + 64 * qh + 32 * qt + r) * PW + PC_Q + 64 * hd + 16 * kk + 8 * h);
    f32x16 O[2][2];
#pragma unroll
    for (int dt = 0; dt < 2; ++dt)
#pragma unroll
        for (int qt = 0; qt < 2; ++qt)
#pragma unroll
            for (int e = 0; e < 16; ++e) O[dt][qt][e] = 0.f;
    float mrun[2] = {-1.0e30f, -1.0e30f}, lrun[2] = {0.f, 0.f};
    const int T0 = lat ? (qpos0 == 0 ? 2 : 0) : 2, T1 = lat ? (qpos0 == 2048 - 128 ? 8 : 10) : 6;
    const int w0 = lat ? (T0 > qh ? T0 : qh) : 2, w1 = lat ? (T1 - 1 < 8 + qh ? T1 - 1 : 8 + qh) : 5;
    const int lkey = tid >> 3, lch = tid & 7;
    const unsigned vtr = (unsigned)(unsigned long)(lds + AT_KB) + (unsigned)((4 * h + ((lane & 15) >> 2)) * AT_VROW + 2 * (16 * ((lane >> 4) & 1) + 4 * (lane & 3)));
    const bf16* kvbase = P + PC_K + 64 * kvh + 8 * lch;
    v4u kreg, vreg;
#define AT_TILE_ROW(ix) (((ix) >= 2 && (ix) < 6) ? (TLAT + b * 256 + 64 * ((ix) - 2)) : (b * 2048 + qpos0 - 128 + 64 * ((ix) < 2 ? (ix) : (ix) - 4)))
#define AT_KBUF(ix) (lds + ((ix) & 3) * AT_BUF)
#define AT_VBUF(ix) (vtr + (unsigned)(((ix) & 3) * AT_BUF))
    __syncthreads();
    {
        const bf16* s0 = kvbase + (size_t)(AT_TILE_ROW(T0) + lkey) * PW; const bf16* s1 = kvbase + (size_t)(AT_TILE_ROW(T0 + 1) + lkey) * PW;
        kreg = *(const v4u*)s0; vreg = *(const v4u*)(s0 + (PC_V - PC_K)); const v4u k2 = *(const v4u*)s1, v2 = *(const v4u*)(s1 + (PC_V - PC_K));
        LAS unsigned char* kb = AT_KBUF(T0); *(LAS v4u*)(kb + lkey * AT_KROW + lch * 16) = kreg; *(LAS v4u*)(kb + AT_KB + lkey * AT_VROW + lch * 16) = vreg;
        kb = AT_KBUF(T0 + 1); *(LAS v4u*)(kb + lkey * AT_KROW + lch * 16) = k2; *(LAS v4u*)(kb + AT_KB + lkey * AT_VROW + lch * 16) = v2;
    }
    asm volatile("s_waitcnt lgkmcnt(0)" ::: "memory");
    __syncthreads();
    f32x16 S0[2], S1[2]; v4u Pp[2][2];
    if (qh == 0) __builtin_amdgcn_s_setprio(2);
    at_qk<0>(S0, AT_KBUF(w0), Qf, r, h);
    for (int tx = T0; tx < T1; ++tx) {
#if defined(PROBE_ATT_SLEEP)
        if (qh == 1) __builtin_amdgcn_s_sleep(PROBE_ATT_SLEEP);
#endif
        const bool nok = tx + 2 < T1;
        if (nok) { const bf16* src = kvbase + (size_t)(AT_TILE_ROW(tx + 2) + lkey) * PW; kreg = *(const v4u*)src; vreg = *(const v4u*)(src + (PC_V - PC_K)); }
        if (tx >= w0 && tx <= w1) {
            const int bj = tx < 2 ? tx : tx - 4;
            const bool band = lat && (tx < 2 || tx >= 6) && (bj - qh == 0 || bj - qh == 4);
            const int dbase = (-128 + 64 * bj) - 64 * qh + 4 * h - r;
            at_qk<1>(S1, AT_KBUF(tx), Qf, r, h);
            if (tx > w0) at_pv<1>(O, Pp, AT_VBUF(tx - 1));
            if constexpr (FIX) at_sm_fix(S0, Pp, lrun, band, dbase); else at_sm(S0, Pp, mrun, lrun, O, band, dbase);
            if (tx < w1) at_qk<0>(S0, AT_KBUF(tx + 1), Qf, r, h);
            at_pv<0>(O, Pp, AT_VBUF(tx));
            if constexpr (FIX) at_sm_fix(S1, Pp, lrun, band, dbase + 32); else at_sm(S1, Pp, mrun, lrun, O, band, dbase + 32);
        }
        if (nok) {
            LAS unsigned char* kb = AT_KBUF(tx + 2); *(LAS v4u*)(kb + lkey * AT_KROW + lch * 16) = kreg;
            *(LAS v4u*)(kb + AT_KB + lkey * AT_VROW + lch * 16) = vreg;
        }
        asm volatile("s_waitcnt lgkmcnt(0)" ::: "memory");
        __syncthreads();
    }
    at_pv<1>(O, Pp, AT_VBUF(w1));
    __builtin_amdgcn_s_setprio(0);
#undef AT_TILE_ROW
#undef AT_KBUF
#undef AT_VBUF
#pragma unroll
    for (int qt = 0; qt < 2; ++qt) {
        float l = lrun[qt]; { const auto rr = __builtin_amdgcn_permlane32_swap(__float_as_uint(l), __float_as_uint(l), false, false); l = __uint_as_float(rr[0]) + __uint_as_float(rr[1]); } l += __builtin_amdgcn_exp2f(FIX ? sinkl2 : sinkl2 - mrun[qt]);
        const float il = 1.0f / l;
        bf16* orow = AO + (size_t)(qrow0 + 64 * qh + 32 * qt + r) * 512 + 64 * hd + 4 * h;
#pragma unroll
        for (int dt = 0; dt < 2; ++dt)
#pragma unroll
            for (int gq = 0; gq < 4; ++gq) { v2u w; w.x = pk2(O[dt][qt][4 * gq] * il, O[dt][qt][4 * gq + 1] * il); w.y = pk2(O[dt][qt][4 * gq + 2] * il, O[dt][qt][4 * gq + 3] * il);
                *(v2u*)(orow + 32 * dt + 8 * gq) = w; }
    }
}
__device__ __forceinline__ void phase_att_mfma(const Ctx& C, int layer) {
    const bf16* P = WSP(bf16, WS_PROJ); bf16* AO = WSP(bf16, WS_ATT);
    const bool last = layer == DEPTH - 1;
    const int nlat = NB * 2 * 16, nctx = last ? 0 : NB * 2 * 2;
    const int vcu = (C.G % 8 == 0) ? (C.bid % 8) * (C.G / 8) + C.bid / 8 : C.bid;
    int bl; asm volatile("v_mbcnt_lo_u32_b32 %0, -1, 0\n\tv_mbcnt_hi_u32_b32 %0, -1, %0" : "=v"(bl));
    float gq = fabsf(C.in[I_QNORM][layer * 64 + bl]), gk = fabsf(C.in[I_KNORM][layer * 64 + bl]);
#pragma unroll
    for (int o = 1; o < 64; o <<= 1) { gq = fmaxf(gq, shx(gq, o, bl)); gk = fmaxf(gk, shx(gk, o, bl)); }
    const float sbound = __uint_as_float(__builtin_amdgcn_readfirstlane(__float_as_uint(1.02f * 64.0f * gq * gk * 0.125f * 1.4426950408889634f + 1.0f)));
    const bool fix = sbound <= 40.0f;
    for (int u = vcu; u < nlat + nctx; u += C.G) {
        if (u < nlat) { const int b = u >> 5, kvh = (u >> 4) & 1, qb = u & 15;
            const float sk = C.in[I_SINKS][layer * 8 + kvh * 4 + (C.wave & 3)] * 1.4426950408889634f;
            if (fix) att_unit<true>(C, P, AO, sk, b, kvh, b * 2048 + qb * 128, qb * 128, true); else att_unit<false>(C, P, AO, sk, b, kvh, b * 2048 + qb * 128, qb * 128, true); }
        else { const int v = u - nlat; const int b = v >> 2, kvh = (v >> 1) & 1, qb = v & 1;
            const float sk = C.in[I_SINKS][layer * 8 + kvh * 4 + (C.wave & 3)] * 1.4426950408889634f;
            if (fix) att_unit<true>(C, P, AO, sk, b, kvh, TLAT + b * 256 + qb * 128, 0, false); else att_unit<false>(C, P, AO, sk, b, kvh, TLAT + b * 256 + qb * 128, 0, false); }
    }
    __syncthreads();
}

constexpr int SS_XT = 144, SS_BM = 144, SS_BT = 144, SS_CM = 144;
constexpr int SS_OFF_XT = 0, SS_OFF_BM = SS_OFF_XT + 128 * SS_XT, SS_OFF_BT = SS_OFF_BM + 128 * SS_BM, SS_OFF_CM = SS_OFF_BT + 128 * SS_BT, SS_OFF_LA = SS_OFF_CM + 128 * SS_CM,
              SS_OFF_DT = SS_OFF_LA + 512, SS_OFF_CF = SS_OFF_DT + 512, SS_OFF_CW = SS_OFF_CF + 512 + 16, SS_END = SS_OFF_CW + 192 * 16;
static_assert(SS_END <= MISC_OFF, "ssd LDS map");
__device__ __forceinline__ float wave_incl_scan(float v, int lane) {
#pragma unroll
    for (int o = 1; o < 64; o <<= 1) { const float t = shup(v, o, lane); if (lane >= o) v += t; }
    return v;
}
__device__ __forceinline__ bf16x8 ld2x64(const LAS unsigned char* p) { const v2u a = *(const LAS v2u*)p, c = *(const LAS v2u*)(p + 16); v4u w; w.x = a.x; w.y = a.y; w.z = c.x; w.w = c.y; return __builtin_bit_cast(bf16x8, w); }
__device__ __forceinline__ bf16x8 ld2x64c(const LAS unsigned char* p) { const v2u a = *(const LAS v2u*)p, c = *(const LAS v2u*)(p + 8); v4u w; w.x = a.x; w.y = a.y; w.z = c.x; w.w = c.y; return __builtin_bit_cast(bf16x8, w); }
__device__ __forceinline__ bf16x8 pack8(const f32x16& v, int o) { v4u w; w.x = pk2(v[o], v[o + 1]); w.y = pk2(v[o + 2], v[o + 3]); w.z = pk2(v[o + 4], v[o + 5]); w.w = pk2(v[o + 6], v[o + 7]); return __builtin_bit_cast(bf16x8, w); }
#define SS_TR2(a, b, addr, off0, off1) do { asm volatile("ds_read_b64_tr_b16 %0, %1 offset:%2" : "=&v"(a) : "v"(addr), "i"(off0) : "memory"); \
        asm volatile("ds_read_b64_tr_b16 %0, %1 offset:%2" : "=&v"(b) : "v"(addr), "i"(off1) : "memory"); } while (0)
#define SS_TRWAIT() do { asm volatile("s_waitcnt lgkmcnt(0)" ::: "memory"); __builtin_amdgcn_sched_barrier(0); } while (0)
__device__ __forceinline__ bf16x8 ss_frag(v2u a, v2u b) { v4u w; w.x = a.x; w.y = a.y; w.z = b.x; w.w = b.y; return __builtin_bit_cast(bf16x8, w); }
__device__ __forceinline__ void ssd_chunk_geo(int ci, int b, int dir, int& L, int& base, int& cs) {
    const bool sctx = ci < 2; L = sctx ? 256 : 2048; const int nch = sctx ? 2 : 16, cidx = sctx ? ci : ci - 2; base = sctx ? TLAT + b * 256 : b * 2048;
    cs = dir ? (nch - 1 - cidx) * 128 : cidx * 128;
}
constexpr int SS_STG = SS_END, SS_STG_ROW = 25 * 16, SS_STG_END = SS_STG + 7 * 512 * 16;
constexpr int SS_LA_ALL = SS_STG_END, SS_DT_ALL = SS_LA_ALL + 18 * 512, SS_LEND_ALL = SS_DT_ALL + 18 * 512, SS_ALL_END = SS_LEND_ALL + 128;
static_assert(SS_STG % 16 == 0 && SS_ALL_END <= MISC_OFF, "ssd staging");
__device__ __forceinline__ void ssd_stage(const bf16* P, LAS unsigned char* lds, int ci, int b, int hh, int g, int dir, int tid, int wave) {
    int L, base, cs; ssd_chunk_geo(ci, b, dir, L, base, cs);
#pragma unroll
    for (int j = 0; j < 7; ++j) { const int sl = j * 512 + tid; int rho = sl / 25, cg = sl - rho * 25; rho = rho > 129 ? 129 : rho; cg = cg > 23 ? 23 : cg;
        int t = cs - 1 + rho; t = t < 0 ? 0 : (t > L - 1 ? L - 1 : t);
        const int ch = cg < 8 ? 64 * hh + 8 * cg : (cg < 16 ? 256 + 64 * g + 8 * (cg - 8) : 384 + 64 * g + 8 * (cg - 16));
        __builtin_amdgcn_global_load_lds((const unsigned*)(P + (size_t)(base + t) * PW + PC_XBC + ch), (LAS unsigned*)(lds + SS_STG + (j * 512 + wave * 64) * 16), 16, 0, 0); }
}
__device__ __forceinline__ void ssd_unit(const Ctx& C, int layer, int b, int hh, int dir) {
    LAS unsigned char* lds = C.lds;
    int lane = C.lane; asm volatile("" : "+v"(lane));
    int tid = C.tid; asm volatile("" : "+v"(tid));
    const int r = lane & 31, h = lane >> 5, ph = C.wave >> 2, lt = ph ? 3 - (C.wave & 3) : (C.wave & 3), g = hh >> 1;
    const bf16* P = WSP(bf16, WS_PROJ); const float* DTR = WSP(float, WS_DT); bf16* Y = WSP(bf16, WS_SSDY) + (size_t)dir * TT * 256;
    const float a = -expf(C.in[I_SALOG][layer * 8 + dir * 4 + hh]); const float dtb = C.in[I_SDTB][layer * 8 + dir * 4 + hh]; const float dsk = dir == 0 ? C.in[I_SD][layer * 4 + hh] : 0.f;
    __syncthreads();
    if (tid < 192) { const int ch = tid < 64 ? 64 * hh + tid : (tid < 128 ? 256 + 64 * g + (tid - 64) : 384 + 64 * g + (tid - 128));
        const float* cw = C.in[I_SCW] + (size_t)layer * 3 * 512; const float* cb = C.in[I_SCB] + (size_t)layer * 512;
        *(LAS f32x4*)(lds + SS_OFF_CW + tid * 16) = (f32x4){cw[ch], cw[512 + ch], cw[1024 + ch], cb[ch]}; }
    f32x16 Hacc[2];
#pragma unroll
    for (int nt = 0; nt < 2; ++nt)
#pragma unroll
        for (int e = 0; e < 16; ++e) Hacc[nt][e] = 0.f;
    const int lp = tid & 127, cg0 = tid >> 7;
    const unsigned trlane = (unsigned)(((lane & 15) >> 2) * 144 + 2 * (16 * ((lane >> 4) & 1) + 4 * (lane & 3)));
    const unsigned trx4 = (unsigned)(unsigned long)(lds + SS_OFF_XT) + trlane + (unsigned)(4 * h * SS_XT + 64 * ph);
    const unsigned trx8 = (unsigned)(unsigned long)(lds + SS_OFF_XT) + trlane + (unsigned)(8 * h * SS_XT + 64 * ph);
    const unsigned trb8 = (unsigned)(unsigned long)(lds + SS_OFF_BT) + trlane + (unsigned)(8 * h * SS_BT);
    ssd_stage(P, lds, 0, b, hh, g, dir, tid, C.wave);
    for (int cj = C.wave; cj < 18; cj += 8) { int L, base, cs; ssd_chunk_geo(cj, b, dir, L, base, cs);
        const int t0 = dir ? cs + 127 - lane : cs + lane, t1 = dir ? cs + 63 - lane : cs + 64 + lane;
        const float r0 = DTR[(size_t)(base + t0) * 8 + dir * 4 + hh] + dtb, r1 = DTR[(size_t)(base + t1) * 8 + dir * 4 + hh] + dtb;
        const float d0 = r0 > 20.f ? r0 : log1pf(expf(r0)), d1 = r1 > 20.f ? r1 : log1pf(expf(r1));
        const float s0 = wave_incl_scan(d0 * a, lane); const float tot0 = __builtin_bit_cast(float, __builtin_amdgcn_readlane(__builtin_bit_cast(int, s0), 63)); const float s1 = wave_incl_scan(d1 * a, lane) + tot0;
        LAS float* LA = (LAS float*)(lds + SS_LA_ALL) + cj * 128; LAS float* DTs = (LAS float*)(lds + SS_DT_ALL) + cj * 128;
        LA[lane] = s0; LA[64 + lane] = s1; DTs[lane] = d0; DTs[64 + lane] = d1; if (lane == 63) ((LAS float*)(lds + SS_LEND_ALL))[cj] = s1; }
    for (int ci = 0; ci < 18; ++ci) {
        int L, base, cs; ssd_chunk_geo(ci, b, dir, L, base, cs); const bool sctx = ci < 2;
        asm volatile("s_waitcnt vmcnt(0)" ::: "memory");
        __syncthreads();
        {
            const float lend_c = ((const LAS float*)(lds + SS_LEND_ALL))[ci];
            const float coef = ((const LAS float*)(lds + SS_DT_ALL))[ci * 128 + lp] * __expf(lend_c - ((const LAS float*)(lds + SS_LA_ALL))[ci * 128 + lp]);
            const int tt = dir ? cs + 127 - lp : cs + lp; const int rho = tt - cs + 1;
#pragma unroll
            for (int j = 0; j < 6; ++j) { const int cg = cg0 + 4 * j;
                const LAS unsigned char* sp = lds + SS_STG + rho * SS_STG_ROW + cg * 16; const v4u zero = (v4u){0u, 0u, 0u, 0u};
                const v4u r0 = tt > 0 ? *(const LAS v4u*)(sp - SS_STG_ROW) : zero, r1 = *(const LAS v4u*)sp, r2 = tt < L - 1 ? *(const LAS v4u*)(sp + SS_STG_ROW) : zero;
                const unsigned w0[4] = {r0.x, r0.y, r0.z, r0.w}, w1[4] = {r1.x, r1.y, r1.z, r1.w}, w2[4] = {r2.x, r2.y, r2.z, r2.w};
                float v[8];
#pragma unroll
                for (int e = 0; e < 8; ++e) { const f32x4 cw = *(const LAS f32x4*)(lds + SS_OFF_CW + (8 * cg + e) * 16);
                    const float x0 = (e & 1) ? bfhi(w0[e >> 1]) : bflo(w0[e >> 1]), x1 = (e & 1) ? bfhi(w1[e >> 1]) : bflo(w1[e >> 1]), x2 = (e & 1) ? bfhi(w2[e >> 1]) : bflo(w2[e >> 1]);
                    v[e] = silu_fast(cw.x * x0 + cw.y * x1 + cw.z * x2 + cw.w); }
                if (cg < 8) {
                    v4u w; w.x = pk2(v[0], v[1]); w.y = pk2(v[2], v[3]); w.z = pk2(v[4], v[5]); w.w = pk2(v[6], v[7]); *(LAS v4u*)(lds + SS_OFF_XT + lp * SS_XT + 16 * cg) = w;
                } else if (cg < 16) { const int n0 = 8 * (cg - 8);
                    v4u w; w.x = pk2(v[0], v[1]); w.y = pk2(v[2], v[3]); w.z = pk2(v[4], v[5]); w.w = pk2(v[6], v[7]); *(LAS v4u*)(lds + SS_OFF_BM + lp * SS_BM + 2 * n0) = w;
                    v4u ws; ws.x = pk2(v[0] * coef, v[1] * coef); ws.y = pk2(v[2] * coef, v[3] * coef); ws.z = pk2(v[4] * coef, v[5] * coef); ws.w = pk2(v[6] * coef, v[7] * coef); *(LAS v4u*)(lds + SS_OFF_BT + lp * SS_BT + 2 * n0) = ws;
                } else { const int n0 = 8 * (cg - 16);
                    v4u w; w.x = pk2(v[0], v[1]); w.y = pk2(v[2], v[3]); w.z = pk2(v[4], v[5]); w.w = pk2(v[6], v[7]); *(LAS v4u*)(lds + SS_OFF_CM + lp * SS_CM + 2 * n0) = w; }
            }
        }
        asm volatile("s_waitcnt lgkmcnt(0)" ::: "memory");
        __syncthreads();
        if (ci + 1 < 18) ssd_stage(P, lds, ci + 1, b, hh, g, dir, tid, C.wave);
        {
            const LAS float* LA = (const LAS float*)(lds + SS_LA_ALL) + ci * 128; const LAS float* DTs = (const LAS float*)(lds + SS_DT_ALL) + ci * 128;
            const float la_l = LA[32 * lt + r]; const float lend = ((const LAS float*)(lds + SS_LEND_ALL))[ci];
            f32x16 Yo, Yd;
#pragma unroll
            for (int e = 0; e < 16; ++e) { Yo[e] = 0.f; Yd[e] = 0.f; }
#pragma unroll
            for (int nt = 0; nt < 2; ++nt)
#pragma unroll
                for (int s2 = 0; s2 < 2; ++s2) { const bf16x8 A = pack8(Hacc[nt], 8 * s2);
                    const bf16x8 Bf = ld2x64(lds + SS_OFF_CM + (32 * lt + r) * SS_CM + 2 * (32 * nt + 16 * s2 + 4 * h));
                    Yo = HY_MFMA(A, Bf, Yo); }
            for (int st = 0; st <= lt; ++st) {
                f32x16 S;
#pragma unroll
                for (int e = 0; e < 16; ++e) S[e] = 0.f;
#pragma unroll
                for (int kk = 0; kk < 4; ++kk) { const bf16x8 A = *(const LAS bf16x8*)(lds + SS_OFF_BM + (32 * st + r) * SS_BM + 32 * kk + 16 * h);
                    const bf16x8 Bf = *(const LAS bf16x8*)(lds + SS_OFF_CM + (32 * lt + r) * SS_CM + 32 * kk + 16 * h);
                    S = HY_MFMA(A, Bf, S); }
#pragma unroll
                for (int gq = 0; gq < 4; ++gq) { const int s0 = 32 * st + 8 * gq + 4 * h;
                    const f32x4 las = *(const LAS f32x4*)(LA + s0), dts = *(const LAS f32x4*)(DTs + s0);
#pragma unroll
                    for (int e = 0; e < 4; ++e) { float gv = S[4 * gq + e] * __expf(la_l - las[e]) * dts[e];
                        if (st == lt) { const int sl = 8 * gq + 4 * h + e; if (sl > r) gv = 0.f; if (sl == r) gv += dsk; }
                        S[4 * gq + e] = gv; } }
                {
                    const unsigned xa = trx4 + (unsigned)(st * 32 * SS_XT); v2u a0, a1, c0, c1;
                    SS_TR2(a0, a1, xa, 0, 8 * SS_XT); SS_TR2(c0, c1, xa, 16 * SS_XT, 24 * SS_XT); SS_TRWAIT();
                    Yd = HY_MFMA(ss_frag(a0, a1), pack8(S, 0), Yd); Yd = HY_MFMA(ss_frag(c0, c1), pack8(S, 8), Yd); }
            }
            { const int lq = 32 * lt + r; const int tq = dir ? cs + 127 - lq : cs + lq; const float el = __expf(la_l);
              bf16* orow = Y + (size_t)(base + tq) * 256 + 64 * hh + 32 * ph + 4 * h;
              if (!sctx || layer != DEPTH - 1) {
#pragma unroll
                for (int gq = 0; gq < 4; ++gq) { v2u w; w.x = pk2(Yd[4 * gq] + el * Yo[4 * gq], Yd[4 * gq + 1] + el * Yo[4 * gq + 1]); w.y = pk2(Yd[4 * gq + 2] + el * Yo[4 * gq + 2], Yd[4 * gq + 3] + el * Yo[4 * gq + 3]);
                    *(v2u*)(orow + 8 * gq) = w; } } }
            { const float ea = __expf(lend);
#pragma unroll
              for (int nt = 0; nt < 2; ++nt)
#pragma unroll
                for (int e = 0; e < 16; ++e) Hacc[nt][e] *= ea;
#pragma unroll
              for (int kh = 0; kh < 2; ++kh) {
                v2u ax[4][2], a0[4][2], a1[4][2];
#pragma unroll
                for (int kk = 0; kk < 4; ++kk) { const int k = 4 * kh + kk;
                    SS_TR2(ax[kk][0], ax[kk][1], trx8, 16 * k * SS_XT, (16 * k + 4) * SS_XT);
                    SS_TR2(a0[kk][0], a0[kk][1], trb8, 16 * k * SS_BT, (16 * k + 4) * SS_BT);
                    SS_TR2(a1[kk][0], a1[kk][1], trb8, 16 * k * SS_BT + 64, (16 * k + 4) * SS_BT + 64); }
                SS_TRWAIT();
#pragma unroll
                for (int kk = 0; kk < 4; ++kk) { const bf16x8 Bf = ss_frag(ax[kk][0], ax[kk][1]);
                    Hacc[0] = HY_MFMA(ss_frag(a0[kk][0], a0[kk][1]), Bf, Hacc[0]); Hacc[1] = HY_MFMA(ss_frag(a1[kk][0], a1[kk][1]), Bf, Hacc[1]); } } }
        }
    }
}
__device__ __forceinline__ void phase_ssd_mfma(const Ctx& C, int layer) {
    for (int u = C.bid; u < NB * 4 * 2; u += C.G) ssd_unit(C, layer, u >> 3, (u >> 1) & 3, u & 1);
    __syncthreads();
}

constexpr int HY_ROW = 4112, HY_ROWC = 528;
constexpr int HY_F0 = 32 * HY_ROW, HY_F1 = HY_F0 + 8192 + 64, HY_LDS_END = HY_F1 + 8192;
static_assert(HY_LDS_END <= MISC_OFF, "hyena LDS map");
__device__ __forceinline__ bf16x8 hy_ldA(LAS unsigned char* lds, unsigned addr) {
    const LAS unsigned* p = (const LAS unsigned*)(lds + addr); v4u w; w.x = p[0]; w.y = p[1]; w.z = p[2]; w.w = p[3]; return __builtin_bit_cast(bf16x8, w);
}
__device__ __forceinline__ void hy_load_filter(LAS unsigned char* lds, const bf16* R, int n, int tid) {
    asm volatile("" : "+v"(tid));
    for (int q = tid; q < n / 8; q += NTHR) { v4u v = *((const v4u*)R + q); const unsigned nxt = (q < n / 8 - 1) ? (unsigned)R[8 * q + 8] : 0u;
        if (q == n / 8 - 1) v.w &= 0xffffu;
        *(LAS v4u*)(lds + HY_F0 + 16 * q) = v;
        v4u s; s.x = (v.x >> 16) | (v.y << 16); s.y = (v.y >> 16) | (v.z << 16); s.z = (v.z >> 16) | (v.w << 16); s.w = (v.w >> 16) | (nxt << 16);
        *(LAS v4u*)(lds + HY_F1 + 16 * q) = s; }
}
template <int L, int ROW>
__device__ __forceinline__ void hy_load_rows(LAS unsigned char* lds, const bf16* src, float w0, float w1, float w2, float bias, int tid) {
    asm volatile("" : "+v"(tid));
    constexpr int CPR = L / 8, NCH = 32 * CPR, PER = NCH / NTHR, HP = PER > 8 ? 8 : PER;
#pragma unroll
    for (int j0 = 0; j0 < PER; j0 += HP) {
        v4u v[HP]; unsigned short pv[HP], nx[HP];
#pragma unroll
        for (int j = 0; j < HP; ++j) { const int q = tid + NTHR * (j0 + j), ch = q % CPR; v[j] = *((const v4u*)src + q);
            pv[j] = ch > 0 ? src[(size_t)q * 8 - 1] : (unsigned short)0; nx[j] = ch < CPR - 1 ? src[(size_t)q * 8 + 8] : (unsigned short)0; }
#pragma unroll
        for (int j = 0; j < HP; ++j) { const int q = tid + NTHR * (j0 + j), b = q / CPR, ch = q % CPR;
            float x[10]; x[0] = bf2f(pv[j]); x[9] = bf2f(nx[j]);
            x[1] = bflo(v[j].x); x[2] = bfhi(v[j].x); x[3] = bflo(v[j].y); x[4] = bfhi(v[j].y); x[5] = bflo(v[j].z); x[6] = bfhi(v[j].z); x[7] = bflo(v[j].w); x[8] = bfhi(v[j].w);
            float y[8];
#pragma unroll
            for (int e = 0; e < 8; ++e) y[e] = w0 * x[e] + w1 * x[e + 1] + w2 * x[e + 2] + bias;
            v4u o; o.x = pk2(y[0], y[1]); o.y = pk2(y[2], y[3]); o.z = pk2(y[4], y[5]); o.w = pk2(y[6], y[7]);
            *(LAS v4u*)(lds + b * ROW + ch * 16) = o; }
    }
}
template <int L, int ROW>
__device__ __forceinline__ void hy_store_rows(LAS unsigned char* lds, bf16* dst, int tid) {
    asm volatile("" : "+v"(tid));
    constexpr int CPR = L / 8, NCH = 32 * CPR, PER = NCH / NTHR;
#pragma unroll
    for (int j = 0; j < PER; ++j) { const int q = tid + NTHR * j, b = q / CPR, ch = q % CPR; *((v4u*)dst + q) = *(const LAS v4u*)(lds + b * ROW + ch * 16); }
}
template <int NTILE, int ROW>
__device__ __forceinline__ void hy_mul_inplace(LAS unsigned char* lds, const f32x16 (&acc)[NTILE], int wave, int lane) {
    asm volatile("" : "+v"(lane));
    const int r = lane & 31, h = lane >> 5;
#pragma unroll
    for (int i = 0; i < NTILE; ++i)
#pragma unroll
        for (int g = 0; g < 4; ++g) { const int t = 32 * NTILE * wave + 32 * i + 8 * g + 4 * h;
            LAS v2u* p = (LAS v2u*)(lds + r * ROW + 2 * t); const v2u x = *p;
            v2u o; o.x = pk2(bflo(x.x) * acc[i][4 * g + 0], bfhi(x.x) * acc[i][4 * g + 1]); o.y = pk2(bflo(x.y) * acc[i][4 * g + 2], bfhi(x.y) * acc[i][4 * g + 3]); *p = o; }
}
__device__ __forceinline__ void hy_conv_lat(LAS unsigned char* lds, f32x16 (&acc)[8], int wave, int lane_in) {
    int lane = lane_in; asm volatile("" : "+v"(lane));
    const int r = lane & 31, h = lane >> 5, odd = (r + 1) & 1;
    const unsigned LA7 = HY_F0 + odd * (HY_F1 - HY_F0) + 2 * (2047 - r + 8 * h - odd) - 512 * wave - 448;
    const unsigned LB = r * HY_ROW + 16 * h;
#pragma unroll
    for (int i = 0; i < 8; ++i)
#pragma unroll
        for (int e = 0; e < 16; ++e) acc[i][e] = 0.f;
    bf16x8 We[8], Wo[8];
#pragma unroll
    for (int i = 1; i < 8; ++i) { We[i] = hy_ldA(lds, LA7 + 64 * (7 - i)); Wo[i] = hy_ldA(lds, LA7 + 64 * (7 - i) + 32); }
    unsigned fa = LA7 + 448, fb = LB;
    bf16x8 An = hy_ldA(lds, fa), Bn = *(const LAS bf16x8*)(lds + fb);
#pragma unroll 1
    for (int kb = 0; kb < 8; ++kb) {
#pragma unroll
        for (int u = 0; u < 8; ++u) {
            {
                const bf16x8 Bc = Bn; We[0] = An;
                An = hy_ldA(lds, fa + 32 * (2 * u + 1)); Bn = *(const LAS bf16x8*)(lds + fb + 32 * (2 * u + 1));
#pragma unroll
                for (int i = 0; i < 8; ++i) acc[i] = HY_MFMA(We[i], Bc, acc[i]);
#pragma unroll
                for (int i = 7; i >= 1; --i) We[i] = We[i - 1];
            }
            {
                const bf16x8 Bc = Bn; Wo[0] = An;
                An = hy_ldA(lds, fa + 32 * (2 * u + 2)); Bn = *(const LAS bf16x8*)(lds + fb + 32 * (2 * u + 2));
#pragma unroll
                for (int i = 0; i < 8; ++i) acc[i] = HY_MFMA(Wo[i], Bc, acc[i]);
#pragma unroll
                for (int i = 7; i >= 1; --i) Wo[i] = Wo[i - 1];
            }
        }
        fa += 512; fb += 512;
    }
}
__device__ __forceinline__ void hy_conv_ctx(LAS unsigned char* lds, f32x16 (&acc)[1], int wave, int lane) {
    asm volatile("" : "+v"(lane));
    const int r = lane & 31, h = lane >> 5, odd = (r + 1) & 1;
    const unsigned LA = HY_F0 + odd * (HY_F1 - HY_F0) + 2 * (255 - r + 8 * h - odd) - 64 * wave;
    const unsigned LB = r * HY_ROWC + 16 * h;
#pragma unroll
    for (int e = 0; e < 16; ++e) acc[0][e] = 0.f;
#pragma unroll
    for (int k = 0; k < 16; ++k) { const bf16x8 A = hy_ldA(lds, LA + 32 * k); const bf16x8 B = *(const LAS bf16x8*)(lds + LB + 32 * k); acc[0] = HY_MFMA(A, B, acc[0]); }
}
__device__ __forceinline__ void phase_hy_mfma(const Ctx& C, int layer) {
    const bf16* HT = WSP(bf16, WS_HYT); bf16* HO = WSP(bf16, WS_HYOT);
    const bool last = layer == DEPTH - 1;
    LAS unsigned char* lds = C.lds;
    const float* cw = C.in[I_HCW] + (size_t)layer * 3 * 768; const float* cb = C.in[I_HCB] + (size_t)layer * 768;
    for (int c = C.bid; c < 256; c += C.G) {
        float w[3][4];
#pragma unroll
        for (int p = 0; p < 3; ++p) { w[p][0] = cw[256 * p + c]; w[p][1] = cw[768 + 256 * p + c]; w[p][2] = cw[1536 + 256 * p + c]; w[p][3] = cb[256 * p + c]; }
        __syncthreads();
        {
            f32x16 acc[8];
            hy_load_filter(lds, WSP(bf16, WS_FILTB) + ((size_t)layer * 512 + c) * 4096, 4096, C.tid);
            hy_load_rows<2048, HY_ROW>(lds, HT + (size_t)c * TT, w[0][0], w[0][1], w[0][2], w[0][3], C.tid);
            __syncthreads();
            hy_conv_lat(lds, acc, C.wave, C.lane);
            __syncthreads();
            hy_load_filter(lds, WSP(bf16, WS_FILTB) + ((size_t)layer * 512 + 256 + c) * 4096, 4096, C.tid);
            hy_load_rows<2048, HY_ROW>(lds, HT + (size_t)(256 + c) * TT, w[1][0], w[1][1], w[1][2], w[1][3], C.tid);
            __syncthreads();
            hy_mul_inplace<8, HY_ROW>(lds, acc, C.wave, C.lane);
            __syncthreads();
            hy_conv_lat(lds, acc, C.wave, C.lane);
            __syncthreads();
            hy_load_rows<2048, HY_ROW>(lds, HT + (size_t)(512 + c) * TT, w[2][0], w[2][1], w[2][2], w[2][3], C.tid);
            __syncthreads();
            hy_mul_inplace<8, HY_ROW>(lds, acc, C.wave, C.lane);
            __syncthreads();
            hy_store_rows<2048, HY_ROW>(lds, HO + (size_t)c * TT, C.tid);
        }
        if (!last) {
            __syncthreads();
            f32x16 acc[1];
            hy_load_filter(lds, WSP(bf16, WS_FILTCB) + ((size_t)layer * 512 + c) * 512, 512, C.tid);
            hy_load_rows<256, HY_ROWC>(lds, HT + (size_t)c * TT + TLAT, w[0][0], w[0][1], w[0][2], w[0][3], C.tid);
            __syncthreads();
            hy_conv_ctx(lds, acc, C.wave, C.lane);
            __syncthreads();
            hy_load_filter(lds, WSP(bf16, WS_FILTCB) + ((size_t)layer * 512 + 256 + c) * 512, 512, C.tid);
            hy_load_rows<256, HY_ROWC>(lds, HT + (size_t)(256 + c) * TT + TLAT, w[1][0], w[1][1], w[1][2], w[1][3], C.tid);
            __syncthreads();
            hy_mul_inplace<1, HY_ROWC>(lds, acc, C.wave, C.lane);
            __syncthreads();
            hy_conv_ctx(lds, acc, C.wave, C.lane);
            __syncthreads();
            hy_load_rows<256, HY_ROWC>(lds, HT + (size_t)(512 + c) * TT + TLAT, w[2][0], w[2][1], w[2][2], w[2][3], C.tid);
            __syncthreads();
            hy_mul_inplace<1, HY_ROWC>(lds, acc, C.wave, C.lane);
            __syncthreads();
            hy_store_rows<256, HY_ROWC>(lds, HO + (size_t)c * TT + TLAT, C.tid);
        }
    }
    __syncthreads();
}

__device__ __forceinline__ void phase_merge(const Ctx& C, int layer) {
    const bf16* AO = WSP(bf16, WS_ATT); const bf16* SY = WSP(bf16, WS_SSDY); const bf16* HO = WSP(bf16, WS_HYOT); const bf16* P = WSP(bf16, WS_PROJ);
    bf16* Y = WSP(bf16, WS_A);
    const float* g_att = C.in[I_ATTON] + layer * 512; const float* g_ssd = C.in[I_SNORM] + layer * 256; const float* g_hy = C.in[I_HON] + layer * 256;
    const int nrows = (layer == DEPTH - 1) ? TLAT : TT;
    constexpr int RS = 66;
    LAS unsigned char* lds = C.lds;
    const int lane = C.lane;
    float ga[8], gs[4], gh[4];
#pragma unroll
    for (int e = 0; e < 8; ++e) ga[e] = g_att[8 * lane + e];
#pragma unroll
    for (int e = 0; e < 4; ++e) { gs[e] = g_ssd[4 * lane + e]; gh[e] = g_hy[4 * lane + e]; }
    for (int tile = C.bid; tile < nrows / 32; tile += C.G) {
        const int tok0 = 32 * tile;
        __syncthreads();
        {
            v4u hv[2];
#pragma unroll
            for (int j = 0; j < 2; ++j) { const int q = C.tid + NTHR * j, c = q >> 2, ch = q & 3; hv[j] = *(const v4u*)(HO + (size_t)c * TT + tok0 + 8 * ch); }
#pragma unroll
            for (int j = 0; j < 2; ++j) { const int q = C.tid + NTHR * j, c = q >> 2, ch = q & 3; LAS unsigned* d = (LAS unsigned*)(lds + c * RS + 16 * ch + (c & 1) * 2);
                (void)d; LAS bf16* d2 = (LAS bf16*)(lds + c * RS + 16 * ch); const unsigned w[4] = {hv[j].x, hv[j].y, hv[j].z, hv[j].w};
#pragma unroll
                for (int e = 0; e < 8; ++e) d2[e] = (bf16)((e & 1) ? (w[e >> 1] >> 16) : (w[e >> 1] & 0xffffu)); }
        }
        __syncthreads();
#pragma unroll
        for (int i = 0; i < 4; ++i) { const int tl = 4 * C.wave + i; const int m = tok0 + tl;
            { const v4u w = *((const v4u*)(AO + (size_t)m * 512) + lane);
              float v[8] = {bflo(w.x), bfhi(w.x), bflo(w.y), bfhi(w.y), bflo(w.z), bfhi(w.z), bflo(w.w), bfhi(w.w)}; float ss = 0.f;
#pragma unroll
              for (int e = 0; e < 8; ++e) ss += v[e] * v[e];
              const float rstd = rsqrtf(wave_sum(ss) * (1.0f / 512.0f) + EPS);
              v4u o; o.x = pk2(v[0] * rstd * ga[0], v[1] * rstd * ga[1]); o.y = pk2(v[2] * rstd * ga[2], v[3] * rstd * ga[3]); o.z = pk2(v[4] * rstd * ga[4], v[5] * rstd * ga[5]); o.w = pk2(v[6] * rstd * ga[6], v[7] * rstd * ga[7]);
              *((v4u*)(Y + (size_t)m * D) + lane) = o; }
            { const v2u w0 = *((const v2u*)(SY + (size_t)m * 256) + lane), w1 = *((const v2u*)(SY + ((size_t)TT + m) * 256) + lane), wz = *((const v2u*)(P + (size_t)m * PW + PC_Z) + lane);
              float v[4] = {bflo(w0.x) + bflo(w1.x), bfhi(w0.x) + bfhi(w1.x), bflo(w0.y) + bflo(w1.y), bfhi(w0.y) + bfhi(w1.y)};
              const float z[4] = {bflo(wz.x), bfhi(wz.x), bflo(wz.y), bfhi(wz.y)}; float ss = 0.f;
#pragma unroll
              for (int e = 0; e < 4; ++e) { v[e] *= silu(z[e]); ss += v[e] * v[e]; }
              const float rstd = rsqrtf(wave_sum(ss) * (1.0f / 256.0f) + EPS);
              v2u o; o.x = pk2(v[0] * rstd * gs[0], v[1] * rstd * gs[1]); o.y = pk2(v[2] * rstd * gs[2], v[3] * rstd * gs[3]);
              *((v2u*)(Y + (size_t)m * D + 512) + lane) = o; }
            { float v[4]; float ss = 0.f;
#pragma unroll
              for (int e = 0; e < 4; ++e) { v[e] = bf2f(*(const LAS bf16*)(lds + (4 * lane + e) * RS + 2 * tl)); ss += v[e] * v[e]; }
              ss += shx(ss, 1, lane); ss += shx(ss, 2, lane); ss += shx(ss, 4, lane); ss += shx(ss, 8, lane);
              const float rstd = rsqrtf(ss * (1.0f / 64.0f) + EPS);
              v2u o; o.x = pk2(v[0] * rstd * gh[0], v[1] * rstd * gh[1]); o.y = pk2(v[2] * rstd * gh[2], v[3] * rstd * gh[3]);
              *((v2u*)(Y + (size_t)m * D + 768) + lane) = o; }
        }
    }
    __syncthreads();
}

constexpr int NPHASES = 1 << 20;
__global__ void __launch_bounds__(NTHR, 2) mega_fwd(Args args) {
    extern __shared__ __attribute__((aligned(16))) unsigned char lds_raw[];
    Ctx C0; C0.in = (const float* const CAS*)__builtin_amdgcn_kernarg_segment_ptr();     C0.out = args.out; C0.ws = args.ws; C0.lds = (LAS unsigned char*)lds_raw;
    C0.tid = threadIdx.x; C0.lane = C0.tid & 63; C0.wave = __builtin_amdgcn_readfirstlane(C0.tid >> 6); C0.bid = blockIdx.x; C0.G = gridDim.x; C0.dry = args.pad1;
    const Ctx& C = C0;
    volatile LAS unsigned* MISC = (volatile LAS unsigned*)(C.lds + MISC_OFF);
    if (C.tid < 64) MISC[C.tid] = 0u;
    __syncthreads();
    const int lo = args.ph_lo, hi = args.ph_hi;
    const bool multi = (hi - lo) > 1;
    XcdBarrier bar; bar.bar = (unsigned*)(C.ws + WS_CTL) + CW_BAR + args.pad0 * XCD_BAR_WORDS; bar.x = 0; bar.st = MISC + 8;
    if (multi) bar = xcd_barrier_post((unsigned*)(C.ws + WS_CTL) + CW_BAR + args.pad0 * XCD_BAR_WORDS, MISC + 8);
    bar.wv = C0.wave;
    int ph = 0;
#if defined(PROBE_SLEEP_US)
    if (lo == 0) { const unsigned long long t0 = __builtin_amdgcn_s_memrealtime(); while (__builtin_amdgcn_s_memrealtime() - t0 < 100ull * PROBE_SLEEP_US) __builtin_amdgcn_s_sleep(32); }
#endif
#ifndef PHMASK
#define PHMASK 0xffffffffu
#endif
#define PHM(i) ((PHMASK >> (i)) & 1u)
#ifndef REPMASK
#define REPMASK 0u
#endif
#define REP(i, call) do { call; if ((REPMASK >> (i)) & 1u) { __syncthreads(); call; } } while (0)
#define PH_BEGIN if (ph >= lo && ph < hi) { Ctx C = C0; { unsigned long long _b = (unsigned long long)C0.out, _c = (unsigned long long)C0.ws, _a = (unsigned long long)C0.in; int _t; \
        asm volatile("v_mbcnt_lo_u32_b32 %0, -1, 0\n\tv_mbcnt_hi_u32_b32 %0, -1, %0" : "=v"(_t)); asm volatile("" : "+s"(_b), "+s"(_c), "+s"(_a)); C.in = (const float* const CAS*)_a; \
        C.out = (float*)(GAS float*)_b; C.ws = (unsigned char*)(GAS unsigned char*)_c; C.lane = _t; C.tid = C0.wave * 64 + _t; C.wave = C0.wave; }
#define PH_END } if (ph >= lo && ph + 1 < hi) xcd_barrier(bar); ++ph;

    PH_BEGIN if (PHM(0)) phase_siluc(C); PH_END
    PH_BEGIN if (PHM(0)) { phase_setup(C);
#if defined(PROBE_SETUP_ONLY)
        if (!C.dry)
#endif
        phase_pre(C, 0); } PH_END
#if defined(PROBE_BARRIERS)
    for (int i = 0; i < PROBE_BARRIERS; ++i) xcd_barrier(bar);
#endif
    for (int layer = 0; layer < DEPTH; ++layer) {
        const bool last = layer == DEPTH - 1; const bool moe = layer & 1;
        PH_BEGIN if (PHM(2)) { phase_norm(C, layer, 0); if (layer > 0) phase_pre(C, layer); } PH_END
        PH_BEGIN if (PHM(3)) { pg8::Gemm g{WSP(bf16, WS_A), WSP(bf16, WS_WIN), TT, PW, D}; pg8::ProjOrder S; S.init(TT, C.G, C.bid, layer == DEPTH - 1);
                   pg8::EpiProj E{WSP(bf16, WS_PROJ), WSP(bf16, WS_HYT), TT, C.in[I_QNORM] + layer * 64, C.in[I_KNORM] + layer * 64, WSP(float, WS_ROPE), WSP(float, WS_ROPE) + 32 * 32};
                   pg8::gemm_phase<pg8::EpiProj, pg8::ProjOrder, PG8_ALIGN, PG8_SP2>(C.lds, g, S, E, C.tid); } PH_END
        PH_BEGIN {
#pragma unroll 1
            for (int k = 0; k < 3; ++k) { const int w = (C.bid & 1) ? 2 - k : k;
#if defined(PROBE_SUB)
                if (C.dry && w != PROBE_SUB) continue;
#endif
                if (w == 0) phase_att_mfma(C, layer); else if (w == 1) phase_ssd_mfma(C, layer); else phase_hy_mfma(C, layer); } } PH_END
        PH_BEGIN if (PHM(9)) REP(9, phase_merge(C, layer)); PH_END
        PH_BEGIN if (PHM(10)) { const int M = last ? TLAT : TT; pg8::Gemm g{WSP(bf16, WS_A), WSP(bf16, WS_WOUT), M, D, D}; pg8::StaticOrder S; S.init(M, D, C.G, C.bid);
                   pg8::EpiResid E{layer == 0 ? (const void*)C.in[I_X] : (const void*)C.out, layer == 0 ? (const void*)C.in[I_CTX] : (const void*)WSP(bf16, WS_XC), (void*)C.out, (void*)WSP(bf16, WS_XC), layer == 0 ? 1 : 0, 0,
                                      WSP(float, WS_MOD) + (size_t)layer * 33 * 6144 + 2 * 1024, nullptr, nullptr, 0, C.dry};
                   pg8::gemm_phase<pg8::EpiResid, pg8::StaticOrder, PG8_ALIGN, PG8_SP2>(C.lds, g, S, E, C.tid); } PH_END
        PH_BEGIN if (PHM(11)) phase_norm(C, layer, 1); PH_END
        const int nslot = moe ? 2 : 1;
        for (int slot = 0; slot < nslot; ++slot) {
            if (moe && slot == 0) { PH_BEGIN if (PHM(14)) phase_moe_maps(C, layer); PH_END }
            PH_BEGIN if (PHM(12)) for (int rep = 0; rep < 1 + (int)((REPMASK >> 12) & 1u); ++rep) { pg8::MoeOrder S; int off[9];
                   if (moe) moe_offsets(C, layer, slot, off); else { off[0] = 0;
#pragma unroll
                       for (int e = 1; e < 9; ++e) off[e] = last ? TLAT : TT; }
#pragma unroll
                   for (int e = 0; e < 9; ++e) S.ts[e] = off[e] >> 8;
                   S.estride = (size_t)2 * FF * D * 2; S.init(off[8], 2 * FF, C.G, C.bid); S.goff = moe ? (slot ? WSP(unsigned, WS_GOFF1) : WSP(unsigned, WS_GOFF)) : nullptr;
                   pg8::Gemm g{WSP(bf16, WS_A), WSP(bf16, WS_F1), off[8], 2 * FF, D};
                   pg8::EpiSwiglu E{WSP(bf16, WS_HID), FF};
                   pg8::gemm_phase<pg8::EpiSwiglu, pg8::MoeOrder, PG8_ALIGN, PG8_SP2, true>(C.lds, g, S, E, C.tid); } PH_END
            PH_BEGIN if (PHM(13)) { pg8::MoeOrder S; int off[9];
                   if (moe) moe_offsets(C, layer, slot, off); else { off[0] = 0;
#pragma unroll
                       for (int e = 1; e < 9; ++e) off[e] = last ? TLAT : TT; }
#pragma unroll
                   for (int e = 0; e < 9; ++e) S.ts[e] = off[e] >> 8;
                   S.estride = (size_t)D * FF * 2; S.init(off[8], D, C.G, C.bid); S.goff = nullptr;
                   pg8::Gemm g{WSP(bf16, WS_HID), WSP(bf16, WS_F2), off[8], D, FF};
                   const bool fin0 = last && slot == 0, fin1 = last && slot == 1;
                   pg8::EpiResid E{fin1 ? (const void*)WSP(bf16, WS_XR) : (const void*)C.out, (const void*)WSP(bf16, WS_XC), fin0 ? (void*)WSP(bf16, WS_XR) : (void*)C.out, (void*)WSP(bf16, WS_XC), 0, fin1 ? 1 : 0,
                                   WSP(float, WS_MOD) + (size_t)layer * 33 * 6144 + 5 * 1024, moe ? (slot ? WSP(int, WS_ROWTOK1) : WSP(int, WS_ROWTOK)) : nullptr, moe ? (slot ? WSP(float, WS_ROWW1) : WSP(float, WS_ROWW)) : nullptr, 1, C.dry};
                   pg8::gemm_phase<pg8::EpiResid, pg8::MoeOrder, PG8_ALIGN, PG8_SP2>(C.lds, g, S, E, C.tid);
                   } PH_END
        }
    }
#undef PH_BEGIN
#undef PH_END
}

#ifndef MK_ONE_LAUNCH
#define MK_ONE_LAUNCH 1
#endif
extern "C" void kernel_launch(void* const* d_in, const int* in_sizes, int n_in, void* d_out, int out_size, void* d_ws, size_t ws_size, hipStream_t stream) {
    static int grid = 0;
    if (grid == 0) {
        if (n_in != 38 || out_size != TLAT * D || ws_size < WS_END) { fprintf(stderr, "kernel_launch: unexpected shapes (n_in %d, out %d, ws %zu)\n", n_in, out_size, ws_size); grid = -1; return; }
        int dev = 0, cus = 0, per_cu = 0;
        if (hipGetDevice(&dev) != hipSuccess || hipDeviceGetAttribute(&cus, hipDeviceAttributeMultiprocessorCount, dev) != hipSuccess) { grid = -1; return; }
        if (hipFuncSetAttribute((const void*)mega_fwd, hipFuncAttributeMaxDynamicSharedMemorySize, LDS_BYTES) != hipSuccess) { fprintf(stderr, "kernel_launch: hipFuncSetAttribute failed\n"); grid = -1; return; }
        if (hipOccupancyMaxActiveBlocksPerMultiprocessor(&per_cu, (const void*)mega_fwd, NTHR, LDS_BYTES) != hipSuccess || per_cu < 1) { fprintf(stderr, "kernel_launch: occupancy query says %d\n", per_cu); (void)hipGetLastError(); grid = -1; return; }
        grid = cus;
    }
    if (grid < 0) return;
    (void)hipMemsetAsync((char*)d_ws + WS_CTL, 0, CTL_ZERO_BYTES, stream);
    Args a{};
    for (int i = 0; i < 38; ++i) a.in[i] = (const float*)d_in[i];
    a.out = (float*)d_out; a.ws = (unsigned char*)d_ws;
#if defined(PROBE_PHASE)
#ifndef PROBE_END
#define PROBE_END (PROBE_PHASE + 1)
#endif
    a.ph_lo = 0; a.ph_hi = PROBE_END; a.pad0 = 0; hipLaunchKernelGGL(mega_fwd, dim3(grid), dim3(NTHR), LDS_BYTES, stream, a);
#ifndef PROBE_REP
#define PROBE_REP 1
#endif
    for (int rep = 0; rep < PROBE_REP; ++rep) { a.ph_lo = PROBE_PHASE; a.ph_hi = PROBE_END; a.pad0 = 1; a.pad1 = 1; hipLaunchKernelGGL(mega_fwd, dim3(grid), dim3(NTHR), LDS_BYTES, stream, a); }
    a.ph_lo = PROBE_END; a.ph_hi = NPHASES; a.pad0 = 2; a.pad1 = 0; hipLaunchKernelGGL(mega_fwd, dim3(grid), dim3(NTHR), LDS_BYTES, stream, a);
#elif MK_ONE_LAUNCH
    a.ph_lo = 0; a.ph_hi = NPHASES;
    hipLaunchKernelGGL(mega_fwd, dim3(grid), dim3(NTHR), LDS_BYTES, stream, a);
#else
#error multi-launch build removed
#endif
}
```

```cpp
#include <hip/hip_runtime.h>
#include <cstdio>
#include <cstdint>
__device__ __forceinline__ int lane_now() { int l; asm volatile("v_mbcnt_lo_u32_b32 %0, -1, 0\n\tv_mbcnt_hi_u32_b32 %0, -1, %0" : "=v"(l)); return l; }
__device__ __forceinline__ float shx(float v, int o, int lane) { return __builtin_bit_cast(float, __builtin_amdgcn_ds_bpermute((lane ^ o) << 2, __builtin_bit_cast(int, v))); }
__device__ __forceinline__ float shup(float v, int o, int lane) { return __builtin_bit_cast(float, __builtin_amdgcn_ds_bpermute(((lane - o) & 63) << 2, __builtin_bit_cast(int, v))); }
namespace pg8 {
#define PG8_LAS __attribute__((address_space(3)))
typedef unsigned short bf16_t;
typedef short bf16x8 __attribute__((ext_vector_type(8)));
typedef float f32x4 __attribute__((ext_vector_type(4)));
typedef unsigned u32x4 __attribute__((ext_vector_type(4)));
constexpr int BM = 256, BK = 64, HALF = 128, HTB = HALF * BK * 2  , STAGE_BYTES = 8 * HTB, NXCD = 8, WGM = 8;

__host__ __device__ __forceinline__ int lds_byte(int r, int c) { const int st = (r >> 4) * 2 + (c >> 5), rr = r & 15, cc = c & 31, ob = rr * 64 + cc * 2; return st * 1024 + (ob ^ (((ob >> 9) & 1) << 5)); }
__host__ __device__ __forceinline__ void stage_rc(int b, int& R, int& C) { const int st = b / 1024, sb = b % 1024, swz = sb ^ (((sb >> 9) & 1) << 5); R = (st >> 1) * 16 + swz / 64; C = (st & 1) * 32 + (swz % 64) / 2; }
__host__ __device__ __forceinline__ int perm32(int rho) { const int n = rho >> 4, i = rho & 15; return 8 * (i >> 2) + 4 * n + (i & 3); }

struct Unit { int pm, pn; };
struct Gemm { const bf16_t* A; const bf16_t* Bt; int M, N, K; };

struct StaticOrder {
    int nM, nN, nwg, G, c;
    __host__ __device__ void init(int M, int N, int G_, int c_) { nM = M / BM; nN = N / BM; nwg = nM * nN; G = G_; c = c_; }
    __host__ __device__ bool next(int i, Unit& u) const {
        const long L = (long)i * G + c; if (L >= nwg) return false;
        int wgid = (int)L; { const int q = nwg / NXCD, r = nwg % NXCD, xcd = wgid % NXCD, off = wgid / NXCD; wgid = (xcd < r ? xcd * (q + 1) : r * (q + 1) + (xcd - r) * q) + off; }
        const int nig = WGM * nN, gid = wgid / nig, fm = gid * WGM, gsz = (nM - fm) < WGM ? (nM - fm) : WGM;
        u.pm = fm + ((wgid % nig) % gsz); u.pn = (wgid % nig) / gsz; return true;
    }
    __device__ __forceinline__ void a_ready(const Unit&) const {}
    __device__ __forceinline__ void done(const Unit&) const {}
    __device__ __forceinline__ const char* b_base(const Gemm& g, const Unit& u, size_t tstep) const { return (const char*)g.Bt + (size_t)u.pn * tstep; }
    __device__ __forceinline__ const char* a_base(const Gemm& g, const Unit& u, size_t tstep) const { return (const char*)g.A + (size_t)u.pm * tstep; }
};
struct ProjOrder {
    StaticOrder a; int nA, nC, nB, ctxpm;
    __device__ __forceinline__ void init(int M, int G_, int c_, bool ctx_kv_only) {
        if (ctx_kv_only) { a.init(M - 8192, 1536, G_, c_); nA = a.nwg; ctxpm = (M - 8192) / BM; nC = 3 * 32; nB = 3 * ctxpm; }
        else { a.init(M, 1536, G_, c_); nA = a.nwg; ctxpm = 0; nC = 0; nB = 3 * (M / BM); } }
    __device__ __forceinline__ bool next(int i, Unit& u) const { const long L = (long)i * a.G + a.c; if (L < nA) return a.next(i, u);
        int l2 = (int)(L - nA);
        if (l2 < nC) { const int j = l2 % 3; u.pm = ctxpm + l2 / 3; u.pn = j == 0 ? 2 : 3 + j; return true; }
        l2 -= nC; if (l2 >= nB) return false; u.pm = l2 % 3; u.pn = 1024 + l2 / 3; return true; }
    __device__ __forceinline__ void a_ready(const Unit&) const {}
    __device__ __forceinline__ void done(const Unit&) const {}
    __device__ __forceinline__ const char* a_base(const Gemm& g, const Unit& u, size_t tstep) const { return u.pn < 1024 ? (const char*)g.A + (size_t)u.pm * tstep : (const char*)g.Bt + (size_t)(6 + u.pm) * tstep; }
    __device__ __forceinline__ const char* b_base(const Gemm& g, const Unit& u, size_t tstep) const { return u.pn < 1024 ? (const char*)g.Bt + (size_t)u.pn * tstep : (const char*)g.A + (size_t)(u.pn - 1024) * tstep; }
};
struct MoeOrder : StaticOrder {
    int ts[9]; size_t estride; const unsigned* goff;
    __device__ __forceinline__ const char* b_base(const Gemm& g, const Unit& u, size_t tstep) const { int e = 0;
#pragma unroll
        for (int j = 1; j < 8; ++j) e += (u.pm >= ts[j]) ? 1 : 0;
        return (const char*)g.Bt + (size_t)e * estride + (size_t)u.pn * tstep; }
};


__device__ __forceinline__ unsigned cvt_pk_bf16(float lo, float hi) { unsigned r; asm volatile("v_cvt_pk_bf16_f32 %0, %1, %2" : "=v"(r) : "v"(lo), "v"(hi)); return r; }
__device__ __forceinline__ float silu_f(float v) { return v * __builtin_amdgcn_rcpf(1.0f + __expf(-v)); }

struct EpiStore {
    static constexpr bool PERM = true, AFTER_DRAIN = false;
    bf16_t* O; int ldc;
    __device__ __forceinline__ void operator()(const f32x4 (&acc)[2][2][4][2], const Unit& u, int wr, int wc, int fr, int fq) const {
        const int row0 = u.pm * BM + wr * 64 + fr; const int col0 = u.pn * BM + wc * 32 + 8 * fq;
#pragma unroll
        for (int ai = 0; ai < 2; ++ai)
#pragma unroll
            for (int m = 0; m < 4; ++m) { bf16_t* rowp = O + (size_t)(row0 + ai * HALF + m * 16) * ldc + col0;
#pragma unroll
                for (int bj = 0; bj < 2; ++bj) { const f32x4 v0 = acc[ai][bj][m][0], v1 = acc[ai][bj][m][1];
                    u32x4 w; w.x = cvt_pk_bf16(v0[0], v0[1]); w.y = cvt_pk_bf16(v0[2], v0[3]); w.z = cvt_pk_bf16(v1[0], v1[1]); w.w = cvt_pk_bf16(v1[2], v1[3]);
                    *(u32x4*)(rowp + bj * HALF) = w; } }
    }
};
struct EpiSwiglu {
    static constexpr bool PERM = true, AFTER_DRAIN = false;
    bf16_t* H; int ldh;
    __device__ __forceinline__ void operator()(const f32x4 (&acc)[2][2][4][2], const Unit& u, int wr, int wc, int fr, int fq) const {
        const int row0 = u.pm * BM + wr * 64 + fr; const int hid0 = u.pn * 128 + wc * 32 + 8 * fq;
#pragma unroll
        for (int ai = 0; ai < 2; ++ai)
#pragma unroll
            for (int m = 0; m < 4; ++m) { bf16_t* rowp = H + (size_t)(row0 + ai * HALF + m * 16) * ldh + hid0;
                float h[8];
#pragma unroll
                for (int bj = 0; bj < 2; ++bj)
#pragma unroll
                    for (int e = 0; e < 4; ++e) h[4 * bj + e] = silu_f(acc[ai][bj][m][0][e]) * acc[ai][bj][m][1][e];
                u32x4 w; w.x = cvt_pk_bf16(h[0], h[1]); w.y = cvt_pk_bf16(h[2], h[3]); w.z = cvt_pk_bf16(h[4], h[5]); w.w = cvt_pk_bf16(h[6], h[7]);
                *(u32x4*)rowp = w; }
    }
};
struct EpiResid {
    static constexpr bool PERM = true, AFTER_DRAIN = false;
    const void* slat; const void* sctx; void* dlat; void* dctx; int sf32, df32;
    const float* gate; const int* rowtok;
    const float* cw; int cw_stride;
    int dry;
    typedef unsigned u32x4_t __attribute__((ext_vector_type(4)));
    __device__ __forceinline__ void operator()(const f32x4 (&acc)[2][2][4][2], const Unit& u, int wr, int wc, int fr, int fq) const {
        const int row0 = u.pm * BM + wr * 64 + fr, col0 = u.pn * BM + wc * 32 + 8 * fq;
        unsigned long long sl = (unsigned long long)slat, sx = (unsigned long long)sctx, dl = (unsigned long long)dlat, dx = (unsigned long long)dctx;
        asm volatile("" : "+s"(sl), "+s"(sx), "+s"(dl), "+s"(dx));
        int tok[2][4]; float sc[2][4];
#pragma unroll
        for (int ai = 0; ai < 2; ++ai)
#pragma unroll
            for (int m = 0; m < 4; ++m) { const int row = row0 + ai * HALF + m * 16; tok[ai][m] = rowtok ? rowtok[row] : row; sc[ai][m] = cw ? cw[(size_t)row * cw_stride] : 1.0f; }
        f32x4 gu[2][2];
        if (!rowtok) { const int t0 = u.pm * BM; const float* g = gate + (size_t)(t0 < 65536 ? (t0 >> 11) : 32) * 6144 + col0;
#pragma unroll
            for (int bj = 0; bj < 2; ++bj)
#pragma unroll
                for (int n = 0; n < 2; ++n) gu[bj][n] = *(const f32x4*)(g + bj * HALF + 4 * n); }
#pragma unroll
        for (int ai = 0; ai < 2; ++ai)
#pragma unroll
          for (int mh = 0; mh < 2; ++mh) {
            f32x4 xv[2][2][2]; size_t ro[2]; int mr[2]; unsigned long long sb[2], db[2];
#pragma unroll
            for (int mm = 0; mm < 2; ++mm) { const int m = 2 * mh + mm; const int t = tok[ai][m] < 0 ? 0 : tok[ai][m];
                const bool lt = t < 65536; ro[mm] = (size_t)(lt ? t : t - 65536) * 1024 + col0; mr[mm] = lt ? (t >> 11) : 32; sb[mm] = lt ? sl : sx; db[mm] = lt ? dl : dx;
                if (sf32) { const __attribute__((address_space(1))) float* p = (const __attribute__((address_space(1))) float*)sb[mm] + ro[mm];
#pragma unroll
                    for (int bj = 0; bj < 2; ++bj)
#pragma unroll
                        for (int n = 0; n < 2; ++n) xv[mm][bj][n] = *(const __attribute__((address_space(1))) f32x4*)(p + bj * HALF + 4 * n);
                } else { const __attribute__((address_space(1))) bf16_t* p = (const __attribute__((address_space(1))) bf16_t*)sb[mm] + ro[mm];
#pragma unroll
                    for (int bj = 0; bj < 2; ++bj) { const u32x4_t w = *(const __attribute__((address_space(1))) u32x4_t*)(p + bj * HALF);
                        xv[mm][bj][0] = (f32x4){__builtin_bit_cast(float, w.x << 16), __builtin_bit_cast(float, w.x & 0xffff0000u), __builtin_bit_cast(float, w.y << 16), __builtin_bit_cast(float, w.y & 0xffff0000u)};
                        xv[mm][bj][1] = (f32x4){__builtin_bit_cast(float, w.z << 16), __builtin_bit_cast(float, w.z & 0xffff0000u), __builtin_bit_cast(float, w.w << 16), __builtin_bit_cast(float, w.w & 0xffff0000u)}; } } }
#pragma unroll
            for (int mm = 0; mm < 2; ++mm) { const int m = 2 * mh + mm; const float* g = gate + (size_t)mr[mm] * 6144 + col0; const float s = sc[ai][m];
                if (tok[ai][m] >= 0 && (s != 0.0f || sb[mm] != db[mm])) {
#pragma unroll
                    for (int bj = 0; bj < 2; ++bj) { f32x4 r[2];
#pragma unroll
                        for (int n = 0; n < 2; ++n) { const f32x4 gv = rowtok ? *(const f32x4*)(g + bj * HALF + 4 * n) : gu[bj][n];
                            r[n] = dry ? xv[mm][bj][n] : xv[mm][bj][n] + gv * s * acc[ai][bj][m][n]; }
                        if (df32) { __attribute__((address_space(1))) float* q = (__attribute__((address_space(1))) float*)db[mm] + ro[mm] + bj * HALF;
                            *((__attribute__((address_space(1))) f32x4*)q) = r[0]; *((__attribute__((address_space(1))) f32x4*)(q + 4)) = r[1]; }
                        else { u32x4_t w; w.x = cvt_pk_bf16(r[0].x, r[0].y); w.y = cvt_pk_bf16(r[0].z, r[0].w); w.z = cvt_pk_bf16(r[1].x, r[1].y); w.w = cvt_pk_bf16(r[1].z, r[1].w);
                            *((__attribute__((address_space(1))) u32x4_t*)((__attribute__((address_space(1))) bf16_t*)db[mm] + ro[mm] + bj * HALF)) = w; } } } }
          }
    }
};
struct EpiProj {
    static constexpr bool PERM = true, AFTER_DRAIN = false;
    bf16_t* P; bf16_t* HYT; int ldh; const float* qn; const float* kn; const float* ropeR; const float* ropeC;
    __device__ __forceinline__ void operator()(const f32x4 (&acc)[2][2][4][2], const Unit& u, int wr, int wc, int fr, int fq) const {
        if (u.pn >= 3) {
            bf16_t* O; int ldc, pn;
            if (u.pn >= 1024) { O = HYT; ldc = ldh; pn = u.pn - 1024; } else { O = P; ldc = 1536; pn = u.pn; }
            const int row0 = u.pm * BM + wr * 64 + fr; const int col0 = pn * BM + wc * 32 + 8 * fq;
#pragma unroll
            for (int ai = 0; ai < 2; ++ai)
#pragma unroll
                for (int m = 0; m < 4; ++m) { bf16_t* rowp = O + (size_t)(row0 + ai * HALF + m * 16) * ldc + col0;
#pragma unroll
                    for (int bj = 0; bj < 2; ++bj) { const f32x4 v0 = acc[ai][bj][m][0], v1 = acc[ai][bj][m][1];
                        u32x4 w; w.x = cvt_pk_bf16(v0[0], v0[1]); w.y = cvt_pk_bf16(v0[2], v0[3]); w.z = cvt_pk_bf16(v1[0], v1[1]); w.w = cvt_pk_bf16(v1[2], v1[3]);
                        *(u32x4*)(rowp + bj * HALF) = w; } }
            return;
        }
        const bool isq = u.pn < 2, isk = (u.pn == 2) && (wc < 2);
        const int colbase = u.pn * BM + wc * 64 + 16 * fq;
        const float* gsrc = isq ? qn : kn;
        f32x4 g[2][2];
#pragma unroll
        for (int bj = 0; bj < 2; ++bj)
#pragma unroll
            for (int n = 0; n < 2; ++n) g[bj][n] = *(const f32x4*)(gsrc + 32 * bj + 16 * n + 4 * fq);
        const float scl = isq ? 0.125f * 1.4426950408889634f : 1.0f;
#pragma unroll
        for (int ai = 0; ai < 2; ++ai)
#pragma unroll
            for (int m = 0; m < 4; ++m) { const int row = u.pm * BM + ai * HALF + wr * 64 + m * 16 + fr;
                f32x4 v[2][2];
#pragma unroll
                for (int bj = 0; bj < 2; ++bj)
#pragma unroll
                    for (int n = 0; n < 2; ++n) v[bj][n] = acc[ai][bj][m][n];
                if (isq || isk) {
                    float ss = 0.f;
#pragma unroll
                    for (int bj = 0; bj < 2; ++bj)
#pragma unroll
                        for (int n = 0; n < 2; ++n) ss += (v[bj][n][0] * v[bj][n][0] + v[bj][n][1] * v[bj][n][1]) + (v[bj][n][2] * v[bj][n][2] + v[bj][n][3] * v[bj][n][3]);
                    { const int ln_ = ::lane_now(); ss += ::shx(ss, 16, ln_); ss += ::shx(ss, 32, ln_); }
                    const float rstd = __builtin_amdgcn_rsqf(ss * (1.0f / 64.0f) + 1e-6f);
#pragma unroll
                    for (int bj = 0; bj < 2; ++bj)
#pragma unroll
                        for (int n = 0; n < 2; ++n) v[bj][n] = v[bj][n] * rstd * g[bj][n];
                    if (row < 65536) { const int t = row & 2047;
#pragma unroll
                        for (int bj = 0; bj < 2; ++bj) { const float* tb = (bj == 0 ? ropeR + (t >> 6) * 32 : ropeC + (t & 63) * 32) + 4 * fq;
                            const f32x4 cs = *(const f32x4*)tb, sn = *(const f32x4*)(tb + 16);
                            const f32x4 x1 = v[bj][0], x2 = v[bj][1]; v[bj][0] = x1 * cs - x2 * sn; v[bj][1] = x1 * sn + x2 * cs; } }
#pragma unroll
                    for (int bj = 0; bj < 2; ++bj)
#pragma unroll
                        for (int n = 0; n < 2; ++n) v[bj][n] = v[bj][n] * scl;
                }
                bf16_t* rowp = P + (size_t)row * 1536 + colbase;
#pragma unroll
                for (int bj = 0; bj < 2; ++bj) { u32x4 w; w.x = cvt_pk_bf16(v[bj][0][0], v[bj][0][1]); w.y = cvt_pk_bf16(v[bj][0][2], v[bj][0][3]); w.z = cvt_pk_bf16(v[bj][1][0], v[bj][1][1]); w.w = cvt_pk_bf16(v[bj][1][2], v[bj][1][3]);
                    *(u32x4*)(rowp + 8 * bj) = w; } }
    }
};
template <class Epi, class Sched, bool ALIGN_EPI = false, bool SP2 = false, bool GATHER = false>
__device__ __forceinline__ void gemm_phase(PG8_LAS unsigned char* lds, const Gemm g, const Sched& S, const Epi& E, const int tid) {
    const int wid = __builtin_amdgcn_readfirstlane(tid >> 6), lane = tid & 63, wr = wid >> 2, wc = wid & 3, fr = lane & 15, fq = lane >> 4;
    const int K = g.K, nt = K / BK;
    unsigned voffA[2], voffB[2];
#pragma unroll
    for (int i = 0; i < 2; ++i) { int R, C; stage_rc(tid * 16 + i * 8192, R, C); const int Rb = Epi::PERM ? ((R & ~31) + perm32(R & 31)) : R;
        voffA[i] = (unsigned)(R * K + C) * 2u; voffB[i] = (unsigned)(Rb * K + C) * 2u; }
    const size_t kstep = (size_t)(BK * 2);
    const size_t hstep = (size_t)HALF * K * 2;
    const size_t tstep = 2 * hstep;
    const unsigned ldsw = (unsigned)wid * 1024u;
    const int aoff = lds_byte(wr * 64 + fr, fq * 8), boff = lds_byte(wc * 32 + fr, fq * 8);
#define PG8_SA(b, h) (((b) * 2 + (h)) * HTB)
#define PG8_SB(b, h) ((4 + (b) * 2 + (h)) * HTB)
#define PG8_STAGE(bufoff, gbase, voff) do { _Pragma("unroll") for (int _i = 0; _i < 2; ++_i) \
        __builtin_amdgcn_global_load_lds((const unsigned*)((const char*)(gbase) + (voff)[_i]), (PG8_LAS unsigned*)(lds + (bufoff) + ldsw + _i * 8192), 16, 0, 0); } while (0)
#define PG8_STAGE_A(bufoff, base, h) do { if constexpr (GATHER) { PG8_STAGE(bufoff, base, gcur[h]); } else { PG8_STAGE(bufoff, (base) + ((h) ? hstep : 0), voffA); } } while (0)
#define PG8_GROWS(dst, unit) do { int _R, _C; stage_rc(tid * 16, _R, _C); u32x4 _o; \
        if (S.goff) _o = *(const u32x4*)(S.goff + (size_t)(unit).pm * BM + 4 * _R); else { const unsigned _b = (unsigned)((unit).pm * BM + _R) * (unsigned)(K * 2); const unsigned _s = 64u * (unsigned)(K * 2); _o = (u32x4){_b, _b + _s, _b + 2 * _s, _b + 3 * _s}; } \
        dst[0][0] = _o[0] + (unsigned)_C * 2u; dst[0][1] = _o[1] + (unsigned)_C * 2u; dst[1][0] = _o[2] + (unsigned)_C * 2u; dst[1][1] = _o[3] + (unsigned)_C * 2u; } while (0)
#define PG8_LDA(dst, b, h) do { _Pragma("unroll") for (int m = 0; m < 4; ++m) _Pragma("unroll") for (int k = 0; k < 2; ++k) dst[m][k] = *(const PG8_LAS bf16x8*)(lds + PG8_SA(b, h) + aoff + m * 2048 + k * 1024); } while (0)
#define PG8_LDB(dst, b, h) do { _Pragma("unroll") for (int n = 0; n < 2; ++n) _Pragma("unroll") for (int k = 0; k < 2; ++k) dst[n][k] = *(const PG8_LAS bf16x8*)(lds + PG8_SB(b, h) + boff + n * 2048 + k * 1024); } while (0)
#define PG8_MMA(ai, bj, At, Bt) do { __builtin_amdgcn_s_setprio(1); _Pragma("unroll") for (int m = 0; m < 4; ++m) _Pragma("unroll") for (int n = 0; n < 2; ++n) _Pragma("unroll") for (int k = 0; k < 2; ++k) \
        acc[ai][bj][m][n] = __builtin_amdgcn_mfma_f32_16x16x32_bf16(Bt[n][k], At[m][k], acc[ai][bj][m][n], 0, 0, 0); __builtin_amdgcn_s_setprio(0); } while (0)
#define PG8_WAIT_V(n) asm volatile("s_waitcnt vmcnt(" #n ")" ::: "memory")
#define PG8_WAIT_L(n) asm volatile("s_waitcnt lgkmcnt(" #n ")" ::: "memory")
#define PG8_BAR __builtin_amdgcn_s_barrier()
#define PG8_SCHED __builtin_amdgcn_sched_barrier(0)
    Unit cur, nxt; int ui = 0;
    if (!S.next(0, cur)) return;
    f32x4 acc[2][2][4][2];
#pragma unroll
    for (int a = 0; a < 2; ++a)
#pragma unroll
        for (int b = 0; b < 2; ++b)
#pragma unroll
            for (int m = 0; m < 4; ++m)
#pragma unroll
                for (int n = 0; n < 2; ++n) acc[a][b][m][n] = (f32x4){0.f, 0.f, 0.f, 0.f};
    bf16x8 At[4][2], B0[2][2], B1[2][2];
    const char* cA = GATHER ? (const char*)g.A : S.a_base(g, cur, tstep); const char* cB = S.b_base(g, cur, tstep);
    unsigned gcur[2][2];
    if constexpr (GATHER) { PG8_GROWS(gcur, cur); }
    S.a_ready(cur);
    if constexpr (SP2) {
        PG8_STAGE(PG8_SB(0, 0), cB, voffB); PG8_STAGE(PG8_SB(0, 1), cB + hstep, voffB); PG8_STAGE_A(PG8_SA(0, 0), cA, 0); PG8_STAGE_A(PG8_SA(0, 1), cA, 1);
        if (wr == 1) PG8_BAR;
        PG8_WAIT_V(2); PG8_BAR;
        PG8_STAGE(PG8_SB(1, 0), cB + kstep, voffB); PG8_STAGE_A(PG8_SA(1, 0), cA + kstep, 0); PG8_STAGE(PG8_SB(1, 1), cB + hstep + kstep, voffB);
        PG8_WAIT_V(6); PG8_BAR;
    } else {
        PG8_STAGE(PG8_SB(0, 0), cB, voffB); PG8_STAGE(PG8_SA(0, 0), cA, voffA); PG8_STAGE(PG8_SB(0, 1), cB + hstep, voffB); PG8_STAGE(PG8_SA(0, 1), cA + hstep, voffA);
        if (wr == 1) PG8_BAR;
        PG8_WAIT_V(4); PG8_BAR;
        PG8_STAGE(PG8_SB(1, 0), cB + kstep, voffB); PG8_STAGE(PG8_SA(1, 0), cA + kstep, voffA); PG8_STAGE(PG8_SB(1, 1), cB + hstep + kstep, voffB);
        PG8_WAIT_V(6); PG8_BAR;
    }
    for (;;) {
        const bool has_next = S.next(ui + 1, nxt);
        const char* nA = GATHER ? (const char*)g.A : (has_next ? S.a_base(g, nxt, tstep) : cA); const char* nB = has_next ? S.b_base(g, nxt, tstep) : cB;
        for (int t = 0; t < nt; t += 2) {
            const bool last = (t == nt - 2);
            const char* a1 = cA + (size_t)(t + 1) * kstep;
            const char* a2 = last ? nA : cA + (size_t)(t + 2) * kstep; const char* b2 = last ? nB : cB + (size_t)(t + 2) * kstep;
            const char* a3 = a2 + kstep; const char* b3 = b2 + kstep;
            if (last && has_next) S.a_ready(nxt);
            if constexpr (SP2) {
            PG8_LDB(B0, 0, 0); PG8_LDB(B1, 0, 1); PG8_SCHED; PG8_LDA(At, 0, 0); PG8_STAGE_A(PG8_SA(1, 1), a1, 1);
            if constexpr (GATHER) { if (last && has_next) PG8_GROWS(gcur, nxt); }
            PG8_WAIT_V(8); PG8_WAIT_L(0); PG8_BAR; PG8_MMA(0, 0, At, B0); PG8_MMA(0, 1, At, B1); PG8_BAR; PG8_SCHED;
            PG8_LDA(At, 0, 1); PG8_STAGE(PG8_SB(0, 0), b2, voffB); PG8_STAGE(PG8_SB(0, 1), b2 + hstep, voffB); PG8_STAGE_A(PG8_SA(0, 0), a2, 0);
            PG8_WAIT_V(8); PG8_WAIT_L(0); PG8_BAR; PG8_MMA(1, 0, At, B0); PG8_MMA(1, 1, At, B1); PG8_BAR; PG8_SCHED;
            PG8_LDB(B0, 1, 0); PG8_LDB(B1, 1, 1); PG8_SCHED; PG8_LDA(At, 1, 0); PG8_STAGE_A(PG8_SA(0, 1), a2, 1);
            PG8_WAIT_V(8); PG8_WAIT_L(0); PG8_BAR; PG8_MMA(0, 0, At, B0); PG8_MMA(0, 1, At, B1); PG8_BAR; PG8_SCHED;
            PG8_LDA(At, 1, 1); PG8_STAGE(PG8_SB(1, 0), b3, voffB); PG8_STAGE(PG8_SB(1, 1), b3 + hstep, voffB); PG8_STAGE_A(PG8_SA(1, 0), a3, 0);
            PG8_WAIT_V(8); PG8_WAIT_L(0); PG8_BAR; PG8_MMA(1, 0, At, B0); PG8_MMA(1, 1, At, B1); PG8_BAR; PG8_SCHED;
            } else {
            PG8_LDB(B0, 0, 0); PG8_SCHED; PG8_LDA(At, 0, 0); PG8_STAGE(PG8_SA(1, 1), a1 + hstep, voffA);
            PG8_WAIT_L(8); PG8_BAR; PG8_WAIT_L(0); PG8_MMA(0, 0, At, B0); PG8_BAR; PG8_SCHED;
            PG8_LDB(B1, 0, 1); PG8_STAGE(PG8_SB(0, 0), b2, voffB);
            PG8_BAR; PG8_WAIT_L(0); PG8_MMA(0, 1, At, B1); PG8_BAR;
            PG8_LDA(At, 0, 1); PG8_STAGE(PG8_SA(0, 0), a2, voffA);
            PG8_BAR; PG8_WAIT_L(0); PG8_MMA(1, 0, At, B0); PG8_BAR; PG8_SCHED;
            PG8_STAGE(PG8_SB(0, 1), b2 + hstep, voffB);
            PG8_WAIT_V(6); PG8_BAR; PG8_MMA(1, 1, At, B1); PG8_BAR;
            PG8_LDB(B0, 1, 0); PG8_SCHED; PG8_LDA(At, 1, 0); PG8_STAGE(PG8_SA(0, 1), a2 + hstep, voffA);
            PG8_WAIT_L(8); PG8_BAR; PG8_WAIT_L(0); PG8_MMA(0, 0, At, B0); PG8_BAR; PG8_SCHED;
            PG8_LDB(B1, 1, 1); PG8_STAGE(PG8_SB(1, 0), b3, voffB);
            PG8_BAR; PG8_WAIT_L(0); PG8_MMA(0, 1, At, B1); PG8_BAR;
            PG8_LDA(At, 1, 1); PG8_STAGE(PG8_SA(1, 0), a3, voffA);
            PG8_BAR; PG8_WAIT_L(0); PG8_MMA(1, 0, At, B0); PG8_BAR; PG8_SCHED;
            PG8_STAGE(PG8_SB(1, 1), b3 + hstep, voffB);
            PG8_WAIT_V(6); PG8_BAR; PG8_MMA(1, 1, At, B1); PG8_BAR;
            }
        }
        if constexpr (ALIGN_EPI) { if (wr == 0) PG8_BAR; }
        if constexpr (!Epi::AFTER_DRAIN) { E(acc, cur, wr, wc, fr, fq); S.done(cur); }
        if (!has_next) break;
#pragma unroll
        for (int a = 0; a < 2; ++a)
#pragma unroll
            for (int b = 0; b < 2; ++b)
#pragma unroll
                for (int m = 0; m < 4; ++m)
#pragma unroll
                    for (int n = 0; n < 2; ++n) acc[a][b][m][n] = (f32x4){0.f, 0.f, 0.f, 0.f};
        cur = nxt; cA = nA; cB = nB; ++ui;
        if constexpr (ALIGN_EPI) { if (wr == 1) PG8_BAR; }
    }
    PG8_WAIT_V(0);
    if constexpr (!ALIGN_EPI) { if (wr == 0) PG8_BAR; }
    PG8_BAR;
    if constexpr (Epi::AFTER_DRAIN) { E.fused(acc, cur, wr, wc, fr, fq, lds, wid, lane); S.done(cur); }
#undef PG8_SA
#undef PG8_SB
#undef PG8_STAGE
#undef PG8_STAGE_A
#undef PG8_GROWS
#undef PG8_LDA
#undef PG8_LDB
#undef PG8_MMA
#undef PG8_WAIT_V
#undef PG8_WAIT_L
#undef PG8_BAR
#undef PG8_SCHED
}
}

#ifndef PG8_SP2
#define PG8_SP2 true
#endif
#ifndef PG8_ALIGN
#define PG8_ALIGN true
#endif

constexpr int D = 1024, NB = 32, SEQ = 2048, CTXL = 256, DEPTH = 4;
constexpr int TLAT = NB * SEQ, TCTX = NB * CTXL, TT = TLAT + TCTX;
constexpr int PROJ_W = 2312, PW = 1536, WROWS = 2304;
constexpr int FF = 2816, NEXP = 8;
constexpr float EPS = 1e-6f;
constexpr int PC_Q = 0, PC_K = 512, PC_V = 640, PC_Z = 768, PC_XBC = 1024;

constexpr size_t MiB = 1u << 20;
constexpr size_t WS_CTL = 0, CTL_ZERO_BYTES = 1 * MiB;
constexpr size_t WS_SILUC = 1 * MiB;
constexpr size_t WS_MOD = 2 * MiB;
constexpr size_t WS_DT = 6 * MiB;
constexpr size_t WS_COMB = 9 * MiB;
constexpr size_t WS_FILT = 12 * MiB;
constexpr size_t WS_FILTC = 20 * MiB;
constexpr size_t WS_ROPE = 22 * MiB - 64 * 1024;
constexpr size_t WS_ROWTOK = 21 * MiB;
constexpr size_t WS_ROWW = 21 * MiB + 512 * 1024;
constexpr size_t WS_ROWTOK1 = 12 * MiB, WS_ROWW1 = 12 * MiB + 512 * 1024;
constexpr size_t WS_GOFF = 13 * MiB, WS_GOFF1 = 13 * MiB + 512 * 1024;
constexpr size_t WS_WIN = 22 * MiB;
constexpr size_t WS_WOUT = 27 * MiB;
constexpr size_t WS_F1 = 29 * MiB;
constexpr size_t WS_F2 = 117 * MiB;
constexpr size_t WS_XC = 161 * MiB;
constexpr size_t WS_XR = 805 * MiB;
constexpr size_t WS_A = 193 * MiB;
constexpr size_t WS_PROJ = 337 * MiB;
constexpr size_t WS_HID = 337 * MiB;
constexpr size_t WS_ATT = 661 * MiB;
constexpr size_t WS_SSDY = 733 * MiB;
constexpr size_t WS_HYOT = 805 * MiB;
constexpr size_t WS_HYT = 841 * MiB;
constexpr size_t WS_FILTB = 953 * MiB;
constexpr size_t WS_FILTCB = 969 * MiB;
constexpr size_t WS_AS = 805 * MiB;
constexpr size_t WS_END = 985 * MiB;
constexpr int MROWS = TT + 2048;
static_assert(WS_HID + (size_t)MROWS * FF * 2 <= WS_HYOT && WS_AS + (size_t)MROWS * D * 2 <= WS_FILTB && WS_HYT + (size_t)768 * TT * 2 <= WS_FILTB, "hidden / sorted overlays");
constexpr int CW_BAR = 4096;
constexpr int CW_GCNT = 4096 + 3 * 3456;
constexpr int CW_WQ = 4096 + 3 * 3456 + 256;
constexpr int CW_BB = 16384;

constexpr int NWAVES = 8, NTHR = 512;
constexpr int LDS_BYTES = 155648;
constexpr int MISC_OFF = 151 * 1024;

#define GAS __attribute__((address_space(1)))
#define LAS __attribute__((address_space(3)))
#define CAS __attribute__((address_space(4)))
typedef unsigned short bf16;
typedef unsigned v4u __attribute__((ext_vector_type(4)));
typedef unsigned v2u __attribute__((ext_vector_type(2)));
typedef float f32x4 __attribute__((ext_vector_type(4)));
typedef short bf16x8 __attribute__((ext_vector_type(8)));
typedef float f32x16 __attribute__((ext_vector_type(16)));
#define HY_MFMA(a, b, c) __builtin_amdgcn_mfma_f32_32x32x16_bf16((a), (b), (c), 0, 0, 0)
#define LDS_WAIT() asm volatile("s_waitcnt lgkmcnt(0)" ::: "memory")
__device__ __forceinline__ unsigned f2bf(float f) { unsigned u = __builtin_bit_cast(unsigned, f); return (u + 0x7fffu + ((u >> 16) & 1u)) >> 16; }
__device__ __forceinline__ unsigned pk2(float lo, float hi) { unsigned r; asm("v_cvt_pk_bf16_f32 %0, %1, %2" : "=v"(r) : "v"(lo), "v"(hi)); return r; }
__device__ __forceinline__ float bf2f(unsigned short b) { return __builtin_bit_cast(float, ((unsigned)b) << 16); }
__device__ __forceinline__ float bflo(unsigned w) { return __builtin_bit_cast(float, w << 16); }
__device__ __forceinline__ float bfhi(unsigned w) { return __builtin_bit_cast(float, w & 0xffff0000u); }
__device__ __forceinline__ float wave_sum(float v) {
    const int ln_ = lane_now();
#pragma unroll
    for (int o = 1; o < 64; o <<= 1) v += shx(v, o, ln_);
    return v;
}
__device__ __forceinline__ float silu(float v) { return v / (1.0f + __expf(-v)); }
__device__ __forceinline__ float silu_fast(float v) { return v * __builtin_amdgcn_rcpf(1.0f + __builtin_amdgcn_exp2f(-1.4426950408889634f * v)); }

#define XB_TMO      128
#define XB_XCNT(j)  (256  + 64 * (j))
#define XB_XSUB(j)  (1280 + 64 * (j))
#define XB_XGEN(j)  (2304 + 64 * (j))
#define XB_TOP      3328
#define XB_TOPGEN   3392
#define XCD_BAR_WORDS 3456
#define XB_SPIN_CAP (1u << 20)
__device__ __forceinline__ unsigned xb_ld(unsigned* p)              { return __hip_atomic_load(p, __ATOMIC_RELAXED, __HIP_MEMORY_SCOPE_AGENT); }
__device__ __forceinline__ unsigned xb_add(unsigned* p, unsigned v) { return __hip_atomic_fetch_add(p, v, __ATOMIC_RELAXED, __HIP_MEMORY_SCOPE_AGENT); }
__device__ __forceinline__ unsigned xb_xcc_id() { return (unsigned)__builtin_amdgcn_s_getreg((3 << 11) | 20) & 0xFu; }
#define XB_SPIN(cond, bar) do { unsigned _sp = 0; while (cond) { __builtin_amdgcn_s_sleep(1); \
    if ((++_sp & 255u) == 0u) { if (xb_ld(&(bar)[XB_TMO])) break; if (_sp > XB_SPIN_CAP) { atomicAdd(&(bar)[XB_TMO], 1u); break; } } } } while (0)
struct XcdBarrier { unsigned* bar; unsigned x; volatile LAS unsigned* st; int wv; };
__device__ __forceinline__ XcdBarrier xcd_barrier_post(unsigned* bar, volatile LAS unsigned* st) {
    XcdBarrier b; b.bar = bar; b.x = xb_xcc_id(); b.st = st;
    if (threadIdx.x == 0) (void)xb_add(&bar[XB_XCNT(b.x)], 1u);
    return b;
}
__device__ __forceinline__ void xcd_barrier_complete(unsigned* bar, unsigned x, unsigned& nloc, unsigned& nx) {
    const unsigned G = gridDim.x * gridDim.y * gridDim.z;
    unsigned sum, cnt, mine, sp = 0u;
    for (;;) {
        sum = 0u; cnt = 0u; mine = 0u;
#pragma unroll
        for (unsigned j = 0; j < 16; ++j) { const unsigned c = xb_ld(&bar[XB_XCNT(j)]); sum += c; cnt += (c > 0u) ? 1u : 0u; mine = (j == x) ? c : mine; }
        if (sum == G) break;
        __builtin_amdgcn_s_sleep(1);
        if ((++sp & 255u) == 0u) { if (xb_ld(&bar[XB_TMO])) break; if (sp > XB_SPIN_CAP) { atomicAdd(&bar[XB_TMO], 1u); break; } }
    }
    nloc = mine > 0u ? mine : 1u; nx = cnt > 0u ? cnt : 1u;
}
__device__ __forceinline__ void xcd_barrier(const XcdBarrier& b) {
    asm volatile("s_waitcnt vmcnt(0)" ::: "memory");
    __syncthreads();
    int l0_; asm volatile("v_mbcnt_lo_u32_b32 %0, -1, 0\n\tv_mbcnt_hi_u32_b32 %0, -1, %0" : "=v"(l0_));
    if (b.wv == 0 && l0_ == 0) {
        unsigned* bar = b.bar;
        __builtin_amdgcn_s_waitcnt(0);
        unsigned nloc = b.st[0], nx = b.st[1];
        if (nloc == 0u) { xcd_barrier_complete(bar, b.x, nloc, nx); b.st[0] = nloc; b.st[1] = nx; }
        const unsigned old = xb_add(&bar[XB_XSUB(b.x)], 1u);
        const unsigned gen = old / nloc;
        if (old + 1u == (gen + 1u) * nloc) {
            __builtin_amdgcn_fence(__ATOMIC_RELEASE, "agent");
            asm volatile("s_waitcnt vmcnt(0)" ::: "memory");
            const unsigned og = xb_add(&bar[XB_TOP], 1u);
            const unsigned tg = og / nx;
            if (og + 1u == (tg + 1u) * nx) xb_add(&bar[XB_TOPGEN], 1u);
            else XB_SPIN(xb_ld(&bar[XB_TOPGEN]) == tg, bar);
            __builtin_amdgcn_fence(__ATOMIC_ACQUIRE, "agent");
            xb_add(&bar[XB_XGEN(b.x)], 1u);
            asm volatile("s_waitcnt vmcnt(0)" ::: "memory");
        } else {
            XB_SPIN(xb_ld(&bar[XB_XGEN(b.x)]) == gen, bar);
            __builtin_amdgcn_fence(__ATOMIC_ACQUIRE, "agent");
            asm volatile("s_waitcnt vmcnt(0)" ::: "memory");
        }
    }
    __syncthreads();
}

struct Args { const float* in[38]; float* out; unsigned char* ws; int ph_lo, ph_hi, pad0, pad1; };
enum { I_X = 0, I_C, I_CTX, I_CCTX, I_WADA, I_BADA, I_NORM1, I_NORM2, I_WIN, I_WOUT, I_QNORM, I_KNORM, I_SINKS, I_ATTON, I_SCW, I_SCB, I_SDTB, I_SALOG, I_SD, I_SNORM,
       I_HCW, I_HCB, I_HW1, I_HB1, I_HF1, I_HW2, I_HB2, I_HF2, I_HW3, I_HBIAS, I_HON, I_FG, I_FU, I_FD, I_MR, I_MG, I_MU, I_MD };

struct Ctx {
    const float* const CAS* in; float* out; unsigned char* ws; LAS unsigned char* lds;
    int tid, lane, wave, bid, G, dry;
};
#define WSP(type, off) ((type*)(C.ws + (off)))

__device__ __forceinline__ void phase_siluc(const Ctx& C) {
    float* sc = WSP(float, WS_SILUC);
    for (int i = C.bid * NTHR + C.tid; i < 33 * 1024; i += C.G * NTHR) {
        const int r = i >> 10, k = i & 1023; const float v = (r < 32) ? C.in[I_C][r * 1024 + k] : C.in[I_CCTX][k];
        sc[i] = silu(v);
    }
    float* rp = WSP(float, WS_ROPE);
    for (int i = C.bid * NTHR + C.tid; i < 96 * 16; i += C.G * NTHR) { const int pos = i >> 4, f = i & 15;
        const float inv = powf(10000.0f, -(float)(2 * f) / 32.0f); const float ang = (float)(pos < 32 ? pos : pos - 32) * inv;
        rp[pos * 32 + f] = cosf(ang); rp[pos * 32 + 16 + f] = sinf(ang); }
}

template <class SRC>
__device__ __forceinline__ void conv_item(const SRC& S, int K, int ld, bf16* WT, LAS float* scr, int item, int nblk, int lane) {
    const int kb = item / nblk, nb = item % nblk, k0 = 64 * kb;
    const float* sp; int col; const int myrow = S.row(nb, lane); S(myrow, sp, col);
    float tmp[64];
#pragma unroll
    for (int i = 0; i < 64; ++i) tmp[i] = sp[(size_t)(k0 + i) * ld + col];
#pragma unroll
    for (int i = 0; i < 64; ++i) scr[i * 65 + lane] = tmp[i];
    LDS_WAIT(); asm volatile("" ::: "memory");
    const int c = lane & 7;
#pragma unroll
    for (int j = 0; j < 8; ++j) { const int n = (lane >> 3) + 8 * j; const LAS float* s = scr + (8 * c) * 65 + n;
        v4u o; o.x = pk2(s[0 * 65], s[1 * 65]); o.y = pk2(s[2 * 65], s[3 * 65]); o.z = pk2(s[4 * 65], s[5 * 65]); o.w = pk2(s[6 * 65], s[7 * 65]);
        *(v4u*)(WT + (size_t)S.row(nb, n) * K + k0 + 8 * c) = o; }
    LDS_WAIT(); asm volatile("" ::: "memory");
}
struct SrcWin { const float* w; __device__ __forceinline__ int row(int nb, int l) const { return 64 * nb + l; }
    __device__ __forceinline__ void operator()(int rho, const float*& p, int& col) const { p = w;
    if (rho >= 1536) col = rho + 8; else if (rho >= 768) col = rho; else {
        const int pn = rho >> 8, r = rho & 255, bj = r >> 7, wc = (r >> 5) & 3, fq = (r >> 3) & 3, n = (r >> 2) & 1, e = r & 3;
        col = pn * 256 + wc * 64 + ((pn == 2 && wc >= 2) ? (16 * fq + 8 * bj + 4 * n + e) : (32 * bj + 16 * n + 4 * fq + e)); } } };
struct SrcPlain { const float* w; __device__ __forceinline__ int row(int nb, int l) const { return 64 * nb + l; }
    __device__ __forceinline__ void operator()(int rho, const float*& p, int& col) const { p = w; col = rho; } };
struct SrcGU { const float* g; const float* u;
    __device__ __forceinline__ int row(int nb, int l) const { return 256 * (nb >> 2) + 128 * (l >> 5) + 32 * (nb & 3) + (l & 31); }
    __device__ __forceinline__ void operator()(int rho, const float*& p, int& col) const {
    const int pn = rho >> 8, r = rho & 255, bj = r >> 7, wc = (r >> 5) & 3, fq = (r >> 3) & 3, n = (r >> 2) & 1, e = r & 3;
    p = (const float*)((const char*)g + (long)n * ((const char*)u - (const char*)g)); col = 128 * pn + 32 * wc + 8 * fq + 4 * bj + e; } };

__device__ __forceinline__ void hy_filter_item(const Ctx& C, int layer, int item) {
    const bool lat = item < 64; const int L = lat ? 2048 : 256; const int pos0 = 32 * (lat ? item : item - 64);
    LAS float* z = (LAS float*)C.lds;
    LAS float* h1 = z + 32 * 33;
    LAS float* h2 = h1 + 32 * 64;
    const float* w1 = C.in[I_HW1] + (size_t)layer * 33 * 64; const float* b1 = C.in[I_HB1] + layer * 64; const float* f1 = C.in[I_HF1] + layer * 64;
    const float* w2 = C.in[I_HW2] + (size_t)layer * 64 * 64; const float* b2 = C.in[I_HB2] + layer * 64; const float* f2 = C.in[I_HF2] + layer * 64;
    const float* w3 = C.in[I_HW3] + (size_t)layer * 64 * 1024; const float* hb = C.in[I_HBIAS] + (size_t)layer * 512;
    __syncthreads();
    for (int t = C.tid; t < 32 * 33; t += NTHR) { const int p = t / 33, j = t % 33; const int i = pos0 + p;
        const float tt = (float)i / (float)(L - 1); const float wv = (6.283185307179586f / (float)L) * (float)i;
        float v;
        if (j == 0) v = tt;
        else { const int jj = (j - 1) & 15; const float fr = 1e-4f + (float)jj * ((15.0f - 1e-4f) / 15.0f); const float a = fr * wv; v = (j <= 16) ? cosf(a) : -sinf(a); }
        z[p * 33 + j] = v; }
    __syncthreads();
    {
        const int k = C.tid & 63, p0 = C.tid >> 6;
        { float wc[33];
#pragma unroll
          for (int j = 0; j < 33; ++j) wc[j] = w1[j * 64 + k];
          const float bb = b1[k], ff = f1[k];
#pragma unroll 1
          for (int i = 0; i < 4; ++i) { const int p = p0 + 8 * i; float s = bb;
#pragma unroll
              for (int j = 0; j < 33; ++j) s += z[p * 33 + j] * wc[j];
              h1[p * 64 + k] = sinf(ff * s); } }
        __syncthreads();
        { float wd[64];
#pragma unroll
          for (int j = 0; j < 64; ++j) wd[j] = w2[j * 64 + k];
          const float bb = b2[k], ff = f2[k];
#pragma unroll 1
          for (int i = 0; i < 4; ++i) { const int p = p0 + 8 * i; float s = bb;
#pragma unroll
              for (int j = 0; j < 64; ++j) s += h1[p * 64 + j] * wd[j];
              h2[p * 64 + k] = sinf(ff * s); } }
    }
    __syncthreads();
    const float dmin = -3.0701134573253946f, dmax = -15.350567286626973f;
    bf16* FL = lat ? WSP(bf16, WS_FILTB) + (size_t)layer * 512 * 4096 : WSP(bf16, WS_FILTCB) + (size_t)layer * 512 * 512; const int FS = lat ? 4096 : 512;
    {
        const int o = C.tid;
        float a0[32], a1[32];
#pragma unroll
        for (int p = 0; p < 32; ++p) { a0[p] = 0.f; a1[p] = 0.f; }
#pragma unroll 2
        for (int j0 = 0; j0 < 64; j0 += 4) {
            const float wa = w3[j0 * 1024 + o], wb = w3[(j0 + 1) * 1024 + o], wc_ = w3[(j0 + 2) * 1024 + o], wd_ = w3[(j0 + 3) * 1024 + o];
            const float xa = w3[j0 * 1024 + o + 512], xb = w3[(j0 + 1) * 1024 + o + 512], xc_ = w3[(j0 + 2) * 1024 + o + 512], xd_ = w3[(j0 + 3) * 1024 + o + 512];
#pragma unroll
            for (int p = 0; p < 32; ++p) { const f32x4 hv = *(const LAS f32x4*)(h2 + p * 64 + j0);
                a0[p] += (hv.x * wa + hv.y * wb) + (hv.z * wc_ + hv.w * wd_); a1[p] += (hv.x * xa + hv.y * xb) + (hv.z * xc_ + hv.w * xd_); } }
        const int order = (o >> 8) & 1, c = o & 255;
        const float delta = fabsf(dmin + (float)c * ((dmax - dmin) / 255.0f));
        bf16* fo = FL + ((size_t)order * 256 + c) * FS;
#pragma unroll
        for (int p = 0; p < 32; ++p) { const float dec = expf(-((float)(pos0 + p) / (float)(L - 1)) * delta); a0[p] *= dec; a1[p] *= dec; }
        if (pos0 == 0) a0[0] += hb[order * 256 + c];
        { v4u* d = (v4u*)(fo + (L - 32 - pos0));
#pragma unroll
          for (int q = 0; q < 4; ++q) { v4u w; w.x = pk2(a0[31 - 8 * q], a0[30 - 8 * q]); w.y = pk2(a0[29 - 8 * q], a0[28 - 8 * q]); w.z = pk2(a0[27 - 8 * q], a0[26 - 8 * q]); w.w = pk2(a0[25 - 8 * q], a0[24 - 8 * q]); d[q] = w; } }
        { bf16* b = fo + (L - 1) + pos0;
          if (pos0 > 0) b[0] = (bf16)f2bf(a1[0]);
#pragma unroll
          for (int q = 0; q < 15; ++q) *(unsigned*)(b + 1 + 2 * q) = pk2(a1[1 + 2 * q], a1[2 + 2 * q]);
          b[31] = (bf16)f2bf(a1[31]); }
    }
    __syncthreads();
}

__device__ __forceinline__ void conv_block_load(f32x4 (&v)[16], const float* W, int ld, int k0, int c0, int tid) {
#pragma unroll
    for (int j = 0; j < 16; ++j) { const int kr = (tid >> 6) + 8 * j; v[j] = *(const f32x4*)(W + (size_t)(k0 + kr) * ld + c0 + 4 * (tid & 63)); }
}
constexpr int CB_PITCH = 520;
__device__ __forceinline__ void conv_block_tile(const Ctx& C, const f32x4 (&v)[16]) {
    const int tid = C.tid;
#pragma unroll
    for (int j = 0; j < 16; ++j) { const int kr = (tid >> 6) + 8 * j; v2u o; o.x = pk2(v[j].x, v[j].y); o.y = pk2(v[j].z, v[j].w); *(LAS v2u*)(C.lds + kr * CB_PITCH + 8 * (tid & 63)) = o; }
    __syncthreads();
}
template <class DST>
__device__ __forceinline__ void conv_block_out(const Ctx& C, int K, int k0, int c0, bf16* WT, const DST& dst) {
    const int tid = C.tid, n = tid & 255, half = tid >> 8;
    bf16* orow = WT + (size_t)dst(c0 + n) * K + k0 + 64 * half;
#pragma unroll
    for (int c = 0; c < 8; ++c) { unsigned short e[8];
#pragma unroll
        for (int i = 0; i < 8; ++i) e[i] = *(const LAS unsigned short*)(C.lds + (64 * half + 8 * c + i) * CB_PITCH + 2 * n);
        v4u o; o.x = e[0] | ((unsigned)e[1] << 16); o.y = e[2] | ((unsigned)e[3] << 16); o.z = e[4] | ((unsigned)e[5] << 16); o.w = e[6] | ((unsigned)e[7] << 16);
        *(v4u*)(orow + 8 * c) = o; }
    __syncthreads();
}
struct DstPlain { __device__ __forceinline__ int operator()(int c) const { return c; } };
struct DstGU { int n; __device__ __forceinline__ int operator()(int hid) const { const int pn = hid >> 7, r = hid & 127, wc = r >> 5, fq = (r >> 3) & 3, bj = (r >> 2) & 1, e = r & 3;
    return 256 * pn + 128 * bj + 32 * wc + 8 * fq + 4 * n + e; } };
__device__ __forceinline__ void phase_pre(const Ctx& C, int layer) {
    LAS float* scr = (LAS float*)(C.lds + C.wave * 16640);
    const bool moe = layer & 1; const int j2 = layer >> 1;
    const int ne = moe ? NEXP : 1;
    unsigned* heads = (unsigned*)(C.ws + WS_CTL) + CW_WQ + 8 * C.dry;
    volatile LAS int* bcast = (volatile LAS int*)(C.lds + MISC_OFF + 64);
    __syncthreads();
    {
        const int nit = ne * 264;
        f32x4 v[16];
        int it, itn;
#define CB_DECODE(IT, W_, LD_, K_, K0_, C0_, WT_, NSEL_, ISGU_) do { const int _e = (IT) / 264; int _r = (IT) % 264; const float *wg, *wu, *wd; \
            if (moe) { const size_t o = ((size_t)j2 * NEXP + _e) * (size_t)D * FF; wg = C.in[I_MG] + o; wu = C.in[I_MU] + o; wd = C.in[I_MD] + o; } \
            else { const size_t o = (size_t)j2 * D * FF; wg = C.in[I_FG] + o; wu = C.in[I_FU] + o; wd = C.in[I_FD] + o; } \
            if (_r < 176) { NSEL_ = _r / 88; _r %= 88; ISGU_ = true; W_ = NSEL_ ? wu : wg; LD_ = FF; K_ = D; K0_ = 128 * (_r / 11); C0_ = 256 * (_r % 11); WT_ = WSP(bf16, WS_F1) + (size_t)_e * 2 * FF * D; } \
            else { _r -= 176; NSEL_ = 0; ISGU_ = false; W_ = wd; LD_ = D; K_ = FF; K0_ = 128 * (_r / 4); C0_ = 256 * (_r % 4); WT_ = WSP(bf16, WS_F2) + (size_t)_e * D * FF; } } while (0)
#define CB_POP(DSTV) do { if (C.tid == 0) bcast[0] = (int)__hip_atomic_fetch_add(heads + 4 + layer, 1u, __ATOMIC_RELAXED, __HIP_MEMORY_SCOPE_AGENT); __syncthreads(); DSTV = bcast[0]; __syncthreads(); } while (0)
        CB_POP(it);
        const float* W = nullptr; int ld = 0, K = 0, k0 = 0, c0 = 0, nsel = 0; bool isgu = false; bf16* WT = nullptr;
        if (it < nit) { CB_DECODE(it, W, ld, K, k0, c0, WT, nsel, isgu); conv_block_load(v, W, ld, k0, c0, C.tid); }
        while (it < nit) {
            conv_block_tile(C, v);
            CB_POP(itn);
            const float* Wn = nullptr; int ldn = 0, Kn = 0, k0n = 0, c0n = 0, nseln = 0; bool isgun = false; bf16* WTn = nullptr;
            if (itn < nit) { CB_DECODE(itn, Wn, ldn, Kn, k0n, c0n, WTn, nseln, isgun); conv_block_load(v, Wn, ldn, k0n, c0n, C.tid); }
            if (isgu) { const DstGU d{nsel}; conv_block_out(C, K, k0, c0, WT, d); } else { const DstPlain d{}; conv_block_out(C, K, k0, c0, WT, d); }
            it = itn; W = Wn; ld = ldn; K = Kn; k0 = k0n; c0 = c0n; WT = WTn; nsel = nseln; isgu = isgun;
        }
#undef CB_DECODE
#undef CB_POP
    }
    {
        const SrcWin s_in{C.in[I_WIN] + (size_t)layer * D * PROJ_W};
        const SrcPlain s_out{C.in[I_WOUT] + (size_t)layer * D * D};
        constexpr int I_IN = 16 * (WROWS / 64), I_OUT = 16 * 16;
        for (;;) {
            int it = 0; if (C.lane == 0) it = (int)__hip_atomic_fetch_add(heads + layer, 1u, __ATOMIC_RELAXED, __HIP_MEMORY_SCOPE_AGENT);
            it = __builtin_amdgcn_readfirstlane(it);
            if (it >= I_IN + I_OUT) break;
            if (it < I_IN) conv_item(s_in, D, PROJ_W, WSP(bf16, WS_WIN), scr, it, WROWS / 64, C.lane);
            else conv_item(s_out, D, D, WSP(bf16, WS_WOUT), scr, it - I_IN, 16, C.lane);
        }
    }
    __syncthreads();
}
__device__ __forceinline__ void mod_task(const Ctx& C, int layer, int grp) {
    const float* sc = WSP(float, WS_SILUC); const float* wa = C.in[I_WADA] + (size_t)layer * D * 6144; const float* ba = C.in[I_BADA] + (size_t)layer * 6144;
    float* mod = WSP(float, WS_MOD) + (size_t)layer * 33 * 6144;
    LAS float* part = (LAS float*)C.lds;
    LAS float* SL = (LAS float*)C.lds + C.wave * (33 * 128);
    const int n = grp * 128 + C.lane; float acc[2][33];
    const int k0 = C.wave * 128;
    __syncthreads();
    for (int i = C.lane; i < 33 * 32; i += 64) { const int r = i >> 5, c4 = i & 31; *(LAS f32x4*)(SL + r * 128 + 4 * c4) = *(const f32x4*)(sc + r * 1024 + k0 + 4 * c4); }
#pragma unroll
    for (int r = 0; r < 33; ++r) { acc[0][r] = 0.f; acc[1][r] = 0.f; }
    asm volatile("s_waitcnt vmcnt(0) lgkmcnt(0)" ::: "memory");
    for (int kk = 0; kk < 128; kk += 8) { float w[2][8];
#pragma unroll
        for (int u = 0; u < 8; ++u) { w[0][u] = wa[(size_t)(k0 + kk + u) * 6144 + n]; w[1][u] = wa[(size_t)(k0 + kk + u) * 6144 + n + 64]; }
#pragma unroll
        for (int r = 0; r < 33; ++r) { const f32x4 s0 = *(const LAS f32x4*)(SL + r * 128 + kk), s1 = *(const LAS f32x4*)(SL + r * 128 + kk + 4);
#pragma unroll
            for (int c = 0; c < 2; ++c)
                acc[c][r] += (s0.x * w[c][0] + s0.y * w[c][1]) + (s0.z * w[c][2] + s0.w * w[c][3]) + (s1.x * w[c][4] + s1.y * w[c][5]) + (s1.z * w[c][6] + s1.w * w[c][7]); } }
    __syncthreads();
#pragma unroll
    for (int r = 0; r < 33; ++r) { part[(C.wave * 33 + r) * 128 + C.lane] = acc[0][r]; part[(C.wave * 33 + r) * 128 + 64 + C.lane] = acc[1][r]; }
    __syncthreads();
    for (int o = C.tid; o < 33 * 128; o += NTHR) { const int r = o >> 7, l = o & 127; float s = ba[grp * 128 + l];
#pragma unroll
        for (int w = 0; w < 8; ++w) s += part[(w * 33 + r) * 128 + l];
        mod[(size_t)r * 6144 + grp * 128 + l] = s; }
    __syncthreads();
}
__device__ __forceinline__ void phase_setup(const Ctx& C) {
    for (int t = C.bid; t < 4 * 120; t += C.G) { const int layer = t / 120, r = t % 120;
#if defined(PROBE_SETUP_ONLY)
        if (C.dry && ((PROBE_SETUP_ONLY == 0) != (r < 48))) continue;
#endif
        if (r < 48) mod_task(C, layer, r); else hy_filter_item(C, layer, r - 48); }
    __syncthreads();
}

__device__ __forceinline__ const float* norm_row_ptr_f32(const Ctx& C, int m) { return m < TLAT ? C.in[I_X] + (size_t)m * D : C.in[I_CTX] + (size_t)(m - TLAT) * D; }
__device__ __forceinline__ const bf16* norm_row_ptr_bf(const Ctx& C, int m) { return m < TLAT ? (const bf16*)C.out + (size_t)m * D : WSP(bf16, WS_XC) + (size_t)(m - TLAT) * D; }
__device__ __forceinline__ void phase_norm(const Ctx& C, int layer, int which) {
    LAS int* lcnt = (LAS int*)(C.lds + 32768);
    if (C.tid < 16) lcnt[C.tid] = 0;
    const bool moe = layer & 1; const bool need_extra = (which == 0) || moe;
    __syncthreads();
    const int lane = C.lane;
    f32x4 wlo[4][4], whi[4][4];
#pragma unroll
    for (int j = 0; j < 4; ++j)
#pragma unroll
        for (int e = 0; e < 4; ++e) { const int k = 8 * lane + 512 * (j >> 1) + 4 * (j & 1) + e;
            if (need_extra) {
                if (which == 0) { const float* wp = C.in[I_WIN] + (size_t)layer * D * PROJ_W + (size_t)k * PROJ_W + 1536; wlo[j][e] = *(const f32x4*)wp; whi[j][e] = *(const f32x4*)(wp + 4); }
                else { const float* wp = C.in[I_MR] + (size_t)(layer >> 1) * D * 8 + (size_t)k * 8; wlo[j][e] = *(const f32x4*)wp; whi[j][e] = *(const f32x4*)(wp + 4); }
            } else { wlo[j][e] = (f32x4){0.f, 0.f, 0.f, 0.f}; whi[j][e] = wlo[j][e]; } }
    const float* gn = (which == 0 ? C.in[I_NORM1] : C.in[I_NORM2]) + layer * D;
    const float* mod = WSP(float, WS_MOD) + (size_t)layer * 33 * 6144;
    const int i_sh = which == 0 ? 0 : 3, i_sc = which == 0 ? 1 : 4;
    bf16* O = WSP(bf16, WS_A);
    const int gw = C.bid * NWAVES + C.wave, NGW = C.G * NWAVES;
    const int nrows = (which == 1 && layer == DEPTH - 1) ? TLAT : TT;
    const int rpw = (nrows + NGW - 1) / NGW;
    int m0 = gw * rpw; asm volatile("" : "+s"(m0));
    const int m1 = (m0 + rpw < nrows) ? m0 + rpw : nrows;
    const bool first = which == 0 && layer == 0;
    f32x4 gA[4], gB[4]; int cur_mr = -1;
    f32x4 v[4]; v4u rw[2];
    if (m0 < m1) {
        if (first) { const f32x4* xr = (const f32x4*)norm_row_ptr_f32(C, m0) + 2 * lane;
#pragma unroll
            for (int j = 0; j < 4; ++j) v[j] = xr[128 * (j >> 1) + (j & 1)]; }
        else { const v4u* xr = (const v4u*)norm_row_ptr_bf(C, m0) + lane;
#pragma unroll
            for (int j = 0; j < 2; ++j) rw[j] = xr[64 * j]; } }
    for (int m = m0; m < m1; ++m) {
        const bool lat = m < TLAT; const int mr = lat ? (m >> 11) : 32;
        if (mr != cur_mr) { cur_mr = mr; const float* msh = mod + (size_t)mr * 6144 + i_sh * 1024; const float* msc = mod + (size_t)mr * 6144 + i_sc * 1024;
#pragma unroll
            for (int j = 0; j < 4; ++j) { const int k = 8 * lane + 512 * (j >> 1) + 4 * (j & 1); gA[j] = *(const f32x4*)(gn + k) * (1.0f + *(const f32x4*)(msc + k)); gB[j] = *(const f32x4*)(msh + k); } }
        f32x4 cv[4];
#pragma unroll
        for (int j = 0; j < 4; ++j) { const unsigned a = (j & 1) ? rw[j >> 1].z : rw[j >> 1].x, b = (j & 1) ? rw[j >> 1].w : rw[j >> 1].y; cv[j] = first ? v[j] : (f32x4){bflo(a), bfhi(a), bflo(b), bfhi(b)}; }
        if (m + 1 < m1) {
            if (first) { const f32x4* xr = (const f32x4*)norm_row_ptr_f32(C, m + 1) + 2 * lane;
#pragma unroll
                for (int j = 0; j < 4; ++j) v[j] = xr[128 * (j >> 1) + (j & 1)]; }
            else { const v4u* xr = (const v4u*)norm_row_ptr_bf(C, m + 1) + lane;
#pragma unroll
                for (int j = 0; j < 2; ++j) rw[j] = xr[64 * j]; } }
        float ss = 0.f;
#pragma unroll
        for (int j = 0; j < 4; ++j) ss += (cv[j].x * cv[j].x + cv[j].y * cv[j].y) + (cv[j].z * cv[j].z + cv[j].w * cv[j].w);
        const float rstd = rsqrtf(wave_sum(ss) * (1.0f / D) + EPS);
        f32x4 elo = (f32x4){0.f, 0.f, 0.f, 0.f}, ehi = elo;
        v4u* o16 = (v4u*)(O + (size_t)m * D) + lane; unsigned pw[8];
#pragma unroll
        for (int j = 0; j < 4; ++j) {
            const f32x4 h = cv[j] * rstd * gA[j] + gB[j];
            pw[2 * j] = pk2(h.x, h.y); pw[2 * j + 1] = pk2(h.z, h.w);
            if (j & 1) o16[64 * (j >> 1)] = (v4u){pw[2 * j - 2], pw[2 * j - 1], pw[2 * j], pw[2 * j + 1]};
            if (need_extra) {
#pragma unroll
                for (int e = 0; e < 4; ++e) { elo = elo + h[e] * wlo[j][e]; ehi = ehi + h[e] * whi[j][e]; } }
        }
        if (need_extra) {
            const bool b0 = lane & 1, b1 = lane & 2, b2 = lane & 4;
            float k4[4], k2[2];
#pragma unroll
            for (int j = 0; j < 4; ++j) { const float send = b0 ? elo[j] : ehi[j], keep = b0 ? ehi[j] : elo[j]; k4[j] = keep + shx(send, 1, lane); }
#pragma unroll
            for (int j = 0; j < 2; ++j) { const float send = b1 ? k4[j] : k4[2 + j], keep = b1 ? k4[2 + j] : k4[j]; k2[j] = keep + shx(send, 2, lane); }
            float k1; { const float send = b2 ? k2[0] : k2[1], keep = b2 ? k2[1] : k2[0]; k1 = keep + shx(send, 4, lane); }
            k1 += shx(k1, 8, lane); k1 += shx(k1, 16, lane); k1 += shx(k1, 32, lane);
            if (which == 0) { if (lane < 8) WSP(float, WS_DT)[(size_t)m * 8 + 4 * (lane & 1) + (lane & 2) + ((lane >> 2) & 1)] = k1; }
            else {
                float ex[8]; const int ki = __builtin_bit_cast(int, k1);
                ex[0] = __builtin_bit_cast(float, __builtin_amdgcn_readlane(ki, 0)); ex[1] = __builtin_bit_cast(float, __builtin_amdgcn_readlane(ki, 4));
                ex[2] = __builtin_bit_cast(float, __builtin_amdgcn_readlane(ki, 2)); ex[3] = __builtin_bit_cast(float, __builtin_amdgcn_readlane(ki, 6));
                ex[4] = __builtin_bit_cast(float, __builtin_amdgcn_readlane(ki, 1)); ex[5] = __builtin_bit_cast(float, __builtin_amdgcn_readlane(ki, 5));
                ex[6] = __builtin_bit_cast(float, __builtin_amdgcn_readlane(ki, 3)); ex[7] = __builtin_bit_cast(float, __builtin_amdgcn_readlane(ki, 7));
                int i0 = 0; float v0 = ex[0];
#pragma unroll
                for (int j = 1; j < 8; ++j) if (ex[j] > v0) { v0 = ex[j]; i0 = j; }
                int i1 = -1; float v1 = -3.0e38f;
#pragma unroll
                for (int j = 0; j < 8; ++j) if (j != i0 && ex[j] > v1) { v1 = ex[j]; i1 = j; }
                if (lane == 0) {
                    const float e1 = __expf(v1 - v0); const float w0 = 1.0f / (1.0f + e1), w1 = e1 / (1.0f + e1);
                    const int lp0 = __hip_atomic_fetch_add(lcnt + i0, 1, __ATOMIC_RELAXED, __HIP_MEMORY_SCOPE_WORKGROUP), lp1 = __hip_atomic_fetch_add(lcnt + 8 + i1, 1, __ATOMIC_RELAXED, __HIP_MEMORY_SCOPE_WORKGROUP);
                    int* d = (int*)(WSP(float, WS_COMB) + (size_t)m * 8);
                    *(v4u*)d = (v4u){(unsigned)i0, (unsigned)i1, (unsigned)lp0, (unsigned)lp1}; *(f32x4*)(d + 4) = (f32x4){w0, w1, 0.f, 0.f};
                }
            }
        }
    }
    __syncthreads();
    if (which == 1 && moe && C.tid < 16) {
        unsigned* ctl = (unsigned*)(C.ws + WS_CTL);
        const unsigned base = __hip_atomic_fetch_add(ctl + CW_GCNT + 64 * C.dry + layer * 16 + C.tid, (unsigned)lcnt[C.tid], __ATOMIC_RELAXED, __HIP_MEMORY_SCOPE_AGENT);
        ctl[CW_BB + 4096 * C.dry + C.bid * 16 + C.tid] = base;
    }
    __syncthreads();
}

__device__ __forceinline__ void moe_offsets(const Ctx& C, int layer, int slot, int (&off)[9]) {
    const unsigned* cnt = (const unsigned*)(C.ws + WS_CTL) + CW_GCNT + 64 * C.dry + layer * 16 + slot * 8;
    off[0] = 0;
#pragma unroll
    for (int e = 0; e < 8; ++e) { const int c = (int)__builtin_amdgcn_readfirstlane((int)__hip_atomic_load(cnt + e, __ATOMIC_RELAXED, __HIP_MEMORY_SCOPE_AGENT)); off[e + 1] = off[e] + ((c + 255) & ~255); }
}
__device__ __forceinline__ void phase_moe_maps(const Ctx& C, int layer) {
    const unsigned* ctl = (const unsigned*)(C.ws + WS_CTL);
    const int NGW = C.G * NWAVES;
    const int nrows = (layer == DEPTH - 1) ? TLAT : TT;
    const int rpw = (nrows + NGW - 1) / NGW;
#pragma unroll
    for (int slot = 0; slot < 2; ++slot) {
        int off[9]; moe_offsets(C, layer, slot, off);
        int* rowtok = slot ? WSP(int, WS_ROWTOK1) : WSP(int, WS_ROWTOK); float* roww = slot ? WSP(float, WS_ROWW1) : WSP(float, WS_ROWW);
        unsigned* goff = slot ? WSP(unsigned, WS_GOFF1) : WSP(unsigned, WS_GOFF);
        for (int m = C.bid * NTHR + C.tid; m < nrows; m += C.G * NTHR) {
            const int* rt = (const int*)(WSP(float, WS_COMB) + (size_t)m * 8);
            const int e = rt[slot], lp = rt[2 + slot]; const float w = ((const float*)rt)[4 + slot];
            const int blk = (m / rpw) >> 3;
            int oe = 0;
#pragma unroll
            for (int j = 0; j < 8; ++j) oe = (e == j) ? off[j] : oe;
            const int pos = oe + (int)ctl[CW_BB + 4096 * C.dry + blk * 16 + slot * 8 + e] + lp;
            rowtok[pos] = m; roww[pos] = w; goff[(pos & ~255) + 4 * (pos & 63) + ((pos >> 6) & 3)] = (unsigned)m * 2048u;
        }
        const unsigned* cnt = ctl + CW_GCNT + 64 * C.dry + layer * 16 + slot * 8;
        for (int i = C.bid * NTHR + C.tid; i < 8 * 256; i += C.G * NTHR) { const int e = i >> 8, j = i & 255;
            int oe = 0, on = 0;
#pragma unroll
            for (int k = 0; k < 8; ++k) { oe = (e == k) ? off[k] : oe; on = (e == k) ? off[k + 1] : on; }
            const int r = oe + (int)cnt[e] + j; if (r < on) { rowtok[r] = -1; goff[(r & ~255) + 4 * (r & 63) + ((r >> 6) & 3)] = 0u; } }
    }
}

constexpr int AT_KROW = 144, AT_VROW = 320, AT_KB = 64 * AT_KROW, AT_VB = 64 * AT_VROW, AT_BUF = AT_KB + AT_VB, AT_NBUF = 4;
static_assert(AT_NBUF * AT_BUF <= MISC_OFF, "attention LDS ring");
__device__ __forceinline__ v4u pk8s(float a0, float a1, float a2, float a3, float a4, float a5, float a6, float a7) {
    v4u w; asm("s_nop 0\n\tv_cvt_pk_bf16_f32 %0, %4, %5\n\tv_cvt_pk_bf16_f32 %1, %6, %7\n\tv_cvt_pk_bf16_f32 %2, %8, %9\n\tv_cvt_pk_bf16_f32 %3, %10, %11"
                   : "=&v"(w.x), "=&v"(w.y), "=&v"(w.z), "=&v"(w.w) : "v"(a0), "v"(a1), "v"(a2), "v"(a3), "v"(a4), "v"(a5), "v"(a6), "v"(a7)); return w; }
template <int KT> __device__ __forceinline__ void at_qk(f32x16 (&S)[2], const LAS unsigned char* kb, const bf16x8 (&Qf)[2][4], int r, int h) {
    const LAS unsigned char* kp = kb + (32 * KT + r) * AT_KROW + 16 * h;
    const f32x16 Z = {0.f, 0.f, 0.f, 0.f, 0.f, 0.f, 0.f, 0.f, 0.f, 0.f, 0.f, 0.f, 0.f, 0.f, 0.f, 0.f};
    { const bf16x8 Kf = *(const LAS bf16x8*)kp;
#pragma unroll
      for (int qt = 0; qt < 2; ++qt) S[qt] = HY_MFMA(Kf, Qf[qt][0], Z); }
#pragma unroll
    for (int kk = 1; kk < 4; ++kk) { const bf16x8 Kf = *(const LAS bf16x8*)(kp + 32 * kk);
#pragma unroll
        for (int qt = 0; qt < 2; ++qt) S[qt] = HY_MFMA(Kf, Qf[qt][kk], S[qt]); }
}
template <int KT> __device__ __forceinline__ void at_pv(f32x16 (&O)[2][2], const v4u (&Pp)[2][2], unsigned va) {
#pragma unroll
    for (int s2 = 0; s2 < 2; ++s2) {
        v2u t00, t01, t10, t11;
        asm volatile("ds_read_b64_tr_b16 %0, %1 offset:%2" : "=&v"(t00) : "v"(va), "i"((32 * KT + 16 * s2) * AT_VROW) : "memory");
        asm volatile("ds_read_b64_tr_b16 %0, %1 offset:%2" : "=&v"(t01) : "v"(va), "i"((32 * KT + 16 * s2 + 8) * AT_VROW) : "memory");
        asm volatile("ds_read_b64_tr_b16 %0, %1 offset:%2" : "=&v"(t10) : "v"(va), "i"((32 * KT + 16 * s2) * AT_VROW + 64) : "memory");
        asm volatile("ds_read_b64_tr_b16 %0, %1 offset:%2" : "=&v"(t11) : "v"(va), "i"((32 * KT + 16 * s2 + 8) * AT_VROW + 64) : "memory");
        asm volatile("s_waitcnt lgkmcnt(0)" ::: "memory"); __builtin_amdgcn_sched_barrier(0);
        { v4u w; w.x = t00.x; w.y = t00.y; w.z = t01.x; w.w = t01.y; const bf16x8 Vf = __builtin_bit_cast(bf16x8, w);
#pragma unroll
          for (int qt = 0; qt < 2; ++qt) O[0][qt] = HY_MFMA(Vf, __builtin_bit_cast(bf16x8, Pp[qt][s2]), O[0][qt]); }
        { v4u w; w.x = t10.x; w.y = t10.y; w.z = t11.x; w.w = t11.y; const bf16x8 Vf = __builtin_bit_cast(bf16x8, w);
#pragma unroll
          for (int qt = 0; qt < 2; ++qt) O[1][qt] = HY_MFMA(Vf, __builtin_bit_cast(bf16x8, Pp[qt][s2]), O[1][qt]); }
    }
}
__device__ __forceinline__ void at_sm(f32x16 (&S)[2], v4u (&Pp)[2][2], float (&mrun)[2], float (&lrun)[2], f32x16 (&O)[2][2], bool band, int dl0) {
#pragma unroll
    for (int qt = 0; qt < 2; ++qt) {
        float mx = -1.0e30f;
#pragma unroll
        for (int e = 0; e < 16; ++e) { float t = S[qt][e];
            if (band) { const int dl = dl0 - 32 * qt + (e & 3) + 8 * (e >> 2); if (dl < -128 || dl > 128) t = -1.0e30f; }
            S[qt][e] = t; mx = fmaxf(mx, t); }
        { const auto rr = __builtin_amdgcn_permlane32_swap(__float_as_uint(mx), __float_as_uint(mx), false, false); mx = fmaxf(__uint_as_float(rr[0]), __uint_as_float(rr[1])); }
        const bool up = mx > mrun[qt] + 8.0f;
        const float mnew = up ? mx : mrun[qt];
        float ls = 0.f;
#pragma unroll
        for (int e = 0; e < 16; ++e) { const float p = __builtin_amdgcn_exp2f(S[qt][e] - mnew); S[qt][e] = p; ls += p; }
        if (__builtin_amdgcn_ballot_w64(up) != 0ull) {
            const float alpha = __builtin_amdgcn_exp2f(mrun[qt] - mnew); mrun[qt] = mnew;
            lrun[qt] = lrun[qt] * alpha + ls;
#pragma unroll
            for (int dt = 0; dt < 2; ++dt)
#pragma unroll
                for (int e = 0; e < 16; ++e) O[dt][qt][e] *= alpha;
        } else lrun[qt] += ls;
#pragma unroll
        for (int s2 = 0; s2 < 2; ++s2) Pp[qt][s2] = pk8s(S[qt][8 * s2 + 0], S[qt][8 * s2 + 1], S[qt][8 * s2 + 2], S[qt][8 * s2 + 3], S[qt][8 * s2 + 4], S[qt][8 * s2 + 5], S[qt][8 * s2 + 6], S[qt][8 * s2 + 7]);
    }
}
__device__ __forceinline__ void at_sm_fix(f32x16 (&S)[2], v4u (&Pp)[2][2], float (&lrun)[2], bool band, int dl0) {
#pragma unroll
    for (int qt = 0; qt < 2; ++qt) {
        float ls = 0.f;
#pragma unroll
        for (int e = 0; e < 16; ++e) { float t = S[qt][e];
            if (band) { const int dl = dl0 - 32 * qt + (e & 3) + 8 * (e >> 2); if (dl < -128 || dl > 128) t = -1.0e30f; }
            const float p = __builtin_amdgcn_exp2f(t); S[qt][e] = p; ls += p; }
        if (__builtin_amdgcn_ballot_w64(ls < 0.f) != 0ull) lrun[qt] = 0.f; else lrun[qt] += ls;
#pragma unroll
        for (int s2 = 0; s2 < 2; ++s2) Pp[qt][s2] = pk8s(S[qt][8 * s2 + 0], S[qt][8 * s2 + 1], S[qt][8 * s2 + 2], S[qt][8 * s2 + 3], S[qt][8 * s2 + 4], S[qt][8 * s2 + 5], S[qt][8 * s2 + 6], S[qt][8 * s2 + 7]);
    }
}
template <bool FIX> __device__ __forceinline__ void att_unit(const Ctx& C, const bf16* P, bf16* AO, float sinkl2, int b, int kvh, int qrow0, int qpos0, bool lat) {
    LAS unsigned char* lds = C.lds;
    int lane; asm volatile("v_mbcnt_lo_u32_b32 %0, -1, 0\n\tv_mbcnt_hi_u32_b32 %0, -1, %0" : "=v"(lane));
    const int tid = C.wave * 64 + lane;
    const int r = lane & 31, h = lane >> 5, g = C.wave & 3, qh = C.wave >> 2, hd = kvh * 4 + g;
    bf16x8 Qf[2][4];
#pragma unroll
    for (int qt = 0; qt < 2; ++qt)
#pragma unroll
        for (int kk = 0; kk < 4; ++kk) Qf[qt][kk] = *(const bf16x8*)(P + (size_t)(qrow0 + 64 * qh + 32 * qt + r) * PW + PC_Q + 64 * hd + 16 * kk + 8 * h);
    f32x16 O[2][2];
#pragma unroll
    for (int dt = 0; dt < 2; ++dt)
#pragma unroll
        for (int qt = 0; qt < 2; ++qt)
#pragma unroll
            for (int e = 0; e < 16; ++e) O[dt][qt][e] = 0.f;
    float mrun[2] = {-1.0e30f, -1.0e30f}, lrun[2] = {0.f, 0.f};
    const int T0 = lat ? (qpos0 == 0 ? 2 : 0) : 2, T1 = lat ? (qpos0 == 2048 - 128 ? 8 : 10) : 6;
    const int w0 = lat ? (T0 > qh ? T0 : qh) : 2, w1 = lat ? (T1 - 1 < 8 + qh ? T1 - 1 : 8 + qh) : 5;
    const int lkey = tid >> 3, lch = tid & 7;
    const unsigned vtr = (unsigned)(unsigned long)(lds + AT_KB) + (unsigned)((4 * h + ((lane & 15) >> 2)) * AT_VROW + 2 * (16 * ((lane >> 4) & 1) + 4 * (lane & 3)));
    const bf16* kvbase = P + PC_K + 64 * kvh + 8 * lch;
    v4u kreg, vreg;
#define AT_TILE_ROW(ix) (((ix) >= 2 && (ix) < 6) ? (TLAT + b * 256 + 64 * ((ix) - 2)) : (b * 2048 + qpos0 - 128 + 64 * ((ix) < 2 ? (ix) : (ix) - 4)))
#define AT_KBUF(ix) (lds + ((ix) & 3) * AT_BUF)
#define AT_VBUF(ix) (vtr + (unsigned)(((ix) & 3) * AT_BUF))
    __syncthreads();
    {
        const bf16* s0 = kvbase + (size_t)(AT_TILE_ROW(T0) + lkey) * PW; const bf16* s1 = kvbase + (size_t)(AT_TILE_ROW(T0 + 1) + lkey) * PW;
        kreg = *(const v4u*)s0; vreg = *(const v4u*)(s0 + (PC_V - PC_K)); const v4u k2 = *(const v4u*)s1, v2 = *(const v4u*)(s1 + (PC_V - PC_K));
        LAS unsigned char* kb = AT_KBUF(T0); *(LAS v4u*)(kb + lkey * AT_KROW + lch * 16) = kreg; *(LAS v4u*)(kb + AT_KB + lkey * AT_VROW + lch * 16) = vreg;
        kb = AT_KBUF(T0 + 1); *(LAS v4u*)(kb + lkey * AT_KROW + lch * 16) = k2; *(LAS v4u*)(kb + AT_KB + lkey * AT_VROW + lch * 16) = v2;
    }
    asm volatile("s_waitcnt lgkmcnt(0)" ::: "memory");
    __syncthreads();
    f32x16 S0[2], S1[2]; v4u Pp[2][2];
    if (qh == 0) __builtin_amdgcn_s_setprio(2);
    at_qk<0>(S0, AT_KBUF(w0), Qf, r, h);
    for (int tx = T0; tx < T1; ++tx) {
#if defined(PROBE_ATT_SLEEP)
        if (qh == 1) __builtin_amdgcn_s_sleep(PROBE_ATT_SLEEP);
#endif
        const bool nok = tx + 2 < T1;
        if (nok) { const bf16* src = kvbase + (size_t)(AT_TILE_ROW(tx + 2) + lkey) * PW; kreg = *(const v4u*)src; vreg = *(const v4u*)(src + (PC_V - PC_K)); }
        if (tx >= w0 && tx <= w1) {
            const int bj = tx < 2 ? tx : tx - 4;
            const bool band = lat && (tx < 2 || tx >= 6) && (bj - qh == 0 || bj - qh == 4);
            const int dbase = (-128 + 64 * bj) - 64 * qh + 4 * h - r;
            at_qk<1>(S1, AT_KBUF(tx), Qf, r, h);
            if (tx > w0) at_pv<1>(O, Pp, AT_VBUF(tx - 1));
            if constexpr (FIX) at_sm_fix(S0, Pp, lrun, band, dbase); else at_sm(S0, Pp, mrun, lrun, O, band, dbase);
            if (tx < w1) at_qk<0>(S0, AT_KBUF(tx + 1), Qf, r, h);
            at_pv<0>(O, Pp, AT_VBUF(tx));
            if constexpr (FIX) at_sm_fix(S1, Pp, lrun, band, dbase + 32); else at_sm(S1, Pp, mrun, lrun, O, band, dbase + 32);
        }
        if (nok) {
            LAS unsigned char* kb = AT_KBUF(tx + 2); *(LAS v4u*)(kb + lkey * AT_KROW + lch * 16) = kreg;
            *(LAS v4u*)(kb + AT_KB + lkey * AT_VROW + lch * 16) = vreg;
        }
        asm volatile("s_waitcnt lgkmcnt(0)" ::: "memory");
        __syncthreads();
    }
    at_pv<1>(O, Pp, AT_VBUF(w1));
    __builtin_amdgcn_s_setprio(0);
#undef AT_TILE_ROW
#undef AT_KBUF
#undef AT_VBUF
#pragma unroll
    for (int qt = 0; qt < 2; ++qt) {
        float l = lrun[qt]; { const auto rr = __builtin_amdgcn_permlane32_swap(__float_as_uint(l), __float_as_uint(l), false, false); l = __uint_as_float(rr[0]) + __uint_as_float(rr[1]); } l += __builtin_amdgcn_exp2f(FIX ? sinkl2 : sinkl2 - mrun[qt]);
        const float il = 1.0f / l;
        bf16* orow = AO + (size_t)(qrow0 + 64 * qh + 32 * qt + r) * 512 + 64 * hd + 4 * h;
#pragma unroll
        for (int dt = 0; dt < 2; ++dt)
#pragma unroll
            for (int gq = 0; gq < 4; ++gq) { v2u w; w.x = pk2(O[dt][qt][4 * gq] * il, O[dt][qt][4 * gq + 1] * il); w.y = pk2(O[dt][qt][4 * gq + 2] * il, O[dt][qt][4 * gq + 3] * il);
                *(v2u*)(orow + 32 * dt + 8 * gq) = w; }
    }
}
__device__ __forceinline__ void phase_att_mfma(const Ctx& C, int layer) {
    const bf16* P = WSP(bf16, WS_PROJ); bf16* AO = WSP(bf16, WS_ATT);
    const bool last = layer == DEPTH - 1;
    const int nlat = NB * 2 * 16, nctx = last ? 0 : NB * 2 * 2;
    const int vcu = (C.G % 8 == 0) ? (C.bid % 8) * (C.G / 8) + C.bid / 8 : C.bid;
    int bl; asm volatile("v_mbcnt_lo_u32_b32 %0, -1, 0\n\tv_mbcnt_hi_u32_b32 %0, -1, %0" : "=v"(bl));
    float gq = fabsf(C.in[I_QNORM][layer * 64 + bl]), gk = fabsf(C.in[I_KNORM][layer * 64 + bl]);
#pragma unroll
    for (int o = 1; o < 64; o <<= 1) { gq = fmaxf(gq, shx(gq, o, bl)); gk = fmaxf(gk, shx(gk, o, bl)); }
    const float sbound = __uint_as_float(__builtin_amdgcn_readfirstlane(__float_as_uint(1.02f * 64.0f * gq * gk * 0.125f * 1.4426950408889634f + 1.0f)));
    const bool fix = sbound <= 40.0f;
    for (int u = vcu; u < nlat + nctx; u += C.G) {
        if (u < nlat) { const int b = u >> 5, kvh = (u >> 4) & 1, qb = u & 15;
            const float sk = C.in[I_SINKS][layer * 8 + kvh * 4 + (C.wave & 3)] * 1.4426950408889634f;
            if (fix) att_unit<true>(C, P, AO, sk, b, kvh, b * 2048 + qb * 128, qb * 128, true); else att_unit<false>(C, P, AO, sk, b, kvh, b * 2048 + qb * 128, qb * 128, true); }
        else { const int v = u - nlat; const int b = v >> 2, kvh = (v >> 1) & 1, qb = v & 1;
            const float sk = C.in[I_SINKS][layer * 8 + kvh * 4 + (C.wave & 3)] * 1.4426950408889634f;
            if (fix) att_unit<true>(C, P, AO, sk, b, kvh, TLAT + b * 256 + qb * 128, 0, false); else att_unit<false>(C, P, AO, sk, b, kvh, TLAT + b * 256 + qb * 128, 0, false); }
    }
    __syncthreads();
}

constexpr int SS_XT = 144, SS_BM = 144, SS_BT = 144, SS_CM = 144;
constexpr int SS_OFF_XT = 0, SS_OFF_BM = SS_OFF_XT + 128 * SS_XT, SS_OFF_BT = SS_OFF_BM + 128 * SS_BM, SS_OFF_CM = SS_OFF_BT + 128 * SS_BT, SS_OFF_LA = SS_OFF_CM + 128 * SS_CM,
              SS_OFF_DT = SS_OFF_LA + 512, SS_OFF_CF = SS_OFF_DT + 512, SS_OFF_CW = SS_OFF_CF + 512 + 16, SS_END = SS_OFF_CW + 192 * 16;
static_assert(SS_END <= MISC_OFF, "ssd LDS map");
__device__ __forceinline__ float wave_incl_scan(float v, int lane) {
#pragma unroll
    for (int o = 1; o < 64; o <<= 1) { const float t = shup(v, o, lane); if (lane >= o) v += t; }
    return v;
}
__device__ __forceinline__ bf16x8 ld2x64(const LAS unsigned char* p) { const v2u a = *(const LAS v2u*)p, c = *(const LAS v2u*)(p + 16); v4u w; w.x = a.x; w.y = a.y; w.z = c.x; w.w = c.y; return __builtin_bit_cast(bf16x8, w); }
__device__ __forceinline__ bf16x8 ld2x64c(const LAS unsigned char* p) { const v2u a = *(const LAS v2u*)p, c = *(const LAS v2u*)(p + 8); v4u w; w.x = a.x; w.y = a.y; w.z = c.x; w.w = c.y; return __builtin_bit_cast(bf16x8, w); }
__device__ __forceinline__ bf16x8 pack8(const f32x16& v, int o) { v4u w; w.x = pk2(v[o], v[o + 1]); w.y = pk2(v[o + 2], v[o + 3]); w.z = pk2(v[o + 4], v[o + 5]); w.w = pk2(v[o + 6], v[o + 7]); return __builtin_bit_cast(bf16x8, w); }
#define SS_TR2(a, b, addr, off0, off1) do { asm volatile("ds_read_b64_tr_b16 %0, %1 offset:%2" : "=&v"(a) : "v"(addr), "i"(off0) : "memory"); \
        asm volatile("ds_read_b64_tr_b16 %0, %1 offset:%2" : "=&v"(b) : "v"(addr), "i"(off1) : "memory"); } while (0)
#define SS_TRWAIT() do { asm volatile("s_waitcnt lgkmcnt(0)" ::: "memory"); __builtin_amdgcn_sched_barrier(0); } while (0)
__device__ __forceinline__ bf16x8 ss_frag(v2u a, v2u b) { v4u w; w.x = a.x; w.y = a.y; w.z = b.x; w.w = b.y; return __builtin_bit_cast(bf16x8, w); }
__device__ __forceinline__ void ssd_chunk_geo(int ci, int b, int dir, int& L, int& base, int& cs) {
    const bool sctx = ci < 2; L = sctx ? 256 : 2048; const int nch = sctx ? 2 : 16, cidx = sctx ? ci : ci - 2; base = sctx ? TLAT + b * 256 : b * 2048;
    cs = dir ? (nch - 1 - cidx) * 128 : cidx * 128;
}
constexpr int SS_STG = SS_END, SS_STG_ROW = 25 * 16, SS_STG_END = SS_STG + 7 * 512 * 16;
constexpr int SS_LA_ALL = SS_STG_END, SS_DT_ALL = SS_LA_ALL + 18 * 512, SS_LEND_ALL = SS_DT_ALL + 18 * 512, SS_ALL_END = SS_LEND_ALL + 128;
static_assert(SS_STG % 16 == 0 && SS_ALL_END <= MISC_OFF, "ssd staging");
__device__ __forceinline__ void ssd_stage(const bf16* P, LAS unsigned char* lds, int ci, int b, int hh, int g, int dir, int tid, int wave) {
    int L, base, cs; ssd_chunk_geo(ci, b, dir, L, base, cs);
#pragma unroll
    for (int j = 0; j < 7; ++j) { const int sl = j * 512 + tid; int rho = sl / 25, cg = sl - rho * 25; rho = rho > 129 ? 129 : rho; cg = cg > 23 ? 23 : cg;
        int t = cs - 1 + rho; t = t < 0 ? 0 : (t > L - 1 ? L - 1 : t);
        const int ch = cg < 8 ? 64 * hh + 8 * cg : (cg < 16 ? 256 + 64 * g + 8 * (cg - 8) : 384 + 64 * g + 8 * (cg - 16));
        __builtin_amdgcn_global_load_lds((const unsigned*)(P + (size_t)(base + t) * PW + PC_XBC + ch), (LAS unsigned*)(lds + SS_STG + (j * 512 + wave * 64) * 16), 16, 0, 0); }
}
__device__ __forceinline__ void ssd_unit(const Ctx& C, int layer, int b, int hh, int dir) {
    LAS unsigned char* lds = C.lds;
    int lane = C.lane; asm volatile("" : "+v"(lane));
    int tid = C.tid; asm volatile("" : "+v"(tid));
    const int r = lane & 31, h = lane >> 5, ph = C.wave >> 2, lt = ph ? 3 - (C.wave & 3) : (C.wave & 3), g = hh >> 1;
    const bf16* P = WSP(bf16, WS_PROJ); const float* DTR = WSP(float, WS_DT); bf16* Y = WSP(bf16, WS_SSDY) + (size_t)dir * TT * 256;
    const float a = -expf(C.in[I_SALOG][layer * 8 + dir * 4 + hh]); const float dtb = C.in[I_SDTB][layer * 8 + dir * 4 + hh]; const float dsk = dir == 0 ? C.in[I_SD][layer * 4 + hh] : 0.f;
    __syncthreads();
    if (tid < 192) { const int ch = tid < 64 ? 64 * hh + tid : (tid < 128 ? 256 + 64 * g + (tid - 64) : 384 + 64 * g + (tid - 128));
        const float* cw = C.in[I_SCW] + (size_t)layer * 3 * 512; const float* cb = C.in[I_SCB] + (size_t)layer * 512;
        *(LAS f32x4*)(lds + SS_OFF_CW + tid * 16) = (f32x4){cw[ch], cw[512 + ch], cw[1024 + ch], cb[ch]}; }
    f32x16 Hacc[2];
#pragma unroll
    for (int nt = 0; nt < 2; ++nt)
#pragma unroll
        for (int e = 0; e < 16; ++e) Hacc[nt][e] = 0.f;
    const int lp = tid & 127, cg0 = tid >> 7;
    const unsigned trlane = (unsigned)(((lane & 15) >> 2) * 144 + 2 * (16 * ((lane >> 4) & 1) + 4 * (lane & 3)));
    const unsigned trx4 = (unsigned)(unsigned long)(lds + SS_OFF_XT) + trlane + (unsigned)(4 * h * SS_XT + 64 * ph);
    const unsigned trx8 = (unsigned)(unsigned long)(lds + SS_OFF_XT) + trlane + (unsigned)(8 * h * SS_XT + 64 * ph);
    const unsigned trb8 = (unsigned)(unsigned long)(lds + SS_OFF_BT) + trlane + (unsigned)(8 * h * SS_BT);
    ssd_stage(P, lds, 0, b, hh, g, dir, tid, C.wave);
    for (int cj = C.wave; cj < 18; cj += 8) { int L, base, cs; ssd_chunk_geo(cj, b, dir, L, base, cs);
        const int t0 = dir ? cs + 127 - lane : cs + lane, t1 = dir ? cs + 63 - lane : cs + 64 + lane;
        const float r0 = DTR[(size_t)(base + t0) * 8 + dir * 4 + hh] + dtb, r1 = DTR[(size_t)(base + t1) * 8 + dir * 4 + hh] + dtb;
        const float d0 = r0 > 20.f ? r0 : log1pf(expf(r0)), d1 = r1 > 20.f ? r1 : log1pf(expf(r1));
        const float s0 = wave_incl_scan(d0 * a, lane); const float tot0 = __builtin_bit_cast(float, __builtin_amdgcn_readlane(__builtin_bit_cast(int, s0), 63)); const float s1 = wave_incl_scan(d1 * a, lane) + tot0;
        LAS float* LA = (LAS float*)(lds + SS_LA_ALL) + cj * 128; LAS float* DTs = (LAS float*)(lds + SS_DT_ALL) + cj * 128;
        LA[lane] = s0; LA[64 + lane] = s1; DTs[lane] = d0; DTs[64 + lane] = d1; if (lane == 63) ((LAS float*)(lds + SS_LEND_ALL))[cj] = s1; }
    for (int ci = 0; ci < 18; ++ci) {
        int L, base, cs; ssd_chunk_geo(ci, b, dir, L, base, cs); const bool sctx = ci < 2;
        asm volatile("s_waitcnt vmcnt(0)" ::: "memory");
        __syncthreads();
        {
            const float lend_c = ((const LAS float*)(lds + SS_LEND_ALL))[ci];
            const float coef = ((const LAS float*)(lds + SS_DT_ALL))[ci * 128 + lp] * __expf(lend_c - ((const LAS float*)(lds + SS_LA_ALL))[ci * 128 + lp]);
            const int tt = dir ? cs + 127 - lp : cs + lp; const int rho = tt - cs + 1;
#pragma unroll
            for (int j = 0; j < 6; ++j) { const int cg = cg0 + 4 * j;
                const LAS unsigned char* sp = lds + SS_STG + rho * SS_STG_ROW + cg * 16; const v4u zero = (v4u){0u, 0u, 0u, 0u};
                const v4u r0 = tt > 0 ? *(const LAS v4u*)(sp - SS_STG_ROW) : zero, r1 = *(const LAS v4u*)sp, r2 = tt < L - 1 ? *(const LAS v4u*)(sp + SS_STG_ROW) : zero;
                const unsigned w0[4] = {r0.x, r0.y, r0.z, r0.w}, w1[4] = {r1.x, r1.y, r1.z, r1.w}, w2[4] = {r2.x, r2.y, r2.z, r2.w};
                float v[8];
#pragma unroll
                for (int e = 0; e < 8; ++e) { const f32x4 cw = *(const LAS f32x4*)(lds + SS_OFF_CW + (8 * cg + e) * 16);
                    const float x0 = (e & 1) ? bfhi(w0[e >> 1]) : bflo(w0[e >> 1]), x1 = (e & 1) ? bfhi(w1[e >> 1]) : bflo(w1[e >> 1]), x2 = (e & 1) ? bfhi(w2[e >> 1]) : bflo(w2[e >> 1]);
                    v[e] = silu_fast(cw.x * x0 + cw.y * x1 + cw.z * x2 + cw.w); }
                if (cg < 8) {
                    v4u w; w.x = pk2(v[0], v[1]); w.y = pk2(v[2], v[3]); w.z = pk2(v[4], v[5]); w.w = pk2(v[6], v[7]); *(LAS v4u*)(lds + SS_OFF_XT + lp * SS_XT + 16 * cg) = w;
                } else if (cg < 16) { const int n0 = 8 * (cg - 8);
                    v4u w; w.x = pk2(v[0], v[1]); w.y = pk2(v[2], v[3]); w.z = pk2(v[4], v[5]); w.w = pk2(v[6], v[7]); *(LAS v4u*)(lds + SS_OFF_BM + lp * SS_BM + 2 * n0) = w;
                    v4u ws; ws.x = pk2(v[0] * coef, v[1] * coef); ws.y = pk2(v[2] * coef, v[3] * coef); ws.z = pk2(v[4] * coef, v[5] * coef); ws.w = pk2(v[6] * coef, v[7] * coef); *(LAS v4u*)(lds + SS_OFF_BT + lp * SS_BT + 2 * n0) = ws;
                } else { const int n0 = 8 * (cg - 16);
                    v4u w; w.x = pk2(v[0], v[1]); w.y = pk2(v[2], v[3]); w.z = pk2(v[4], v[5]); w.w = pk2(v[6], v[7]); *(LAS v4u*)(lds + SS_OFF_CM + lp * SS_CM + 2 * n0) = w; }
            }
        }
        asm volatile("s_waitcnt lgkmcnt(0)" ::: "memory");
        __syncthreads();
        if (ci + 1 < 18) ssd_stage(P, lds, ci + 1, b, hh, g, dir, tid, C.wave);
        {
            const LAS float* LA = (const LAS float*)(lds + SS_LA_ALL) + ci * 128; const LAS float* DTs = (const LAS float*)(lds + SS_DT_ALL) + ci * 128;
            const float la_l = LA[32 * lt + r]; const float lend = ((const LAS float*)(lds + SS_LEND_ALL))[ci];
            f32x16 Yo, Yd;
#pragma unroll
            for (int e = 0; e < 16; ++e) { Yo[e] = 0.f; Yd[e] = 0.f; }
#pragma unroll
            for (int nt = 0; nt < 2; ++nt)
#pragma unroll
                for (int s2 = 0; s2 < 2; ++s2) { const bf16x8 A = pack8(Hacc[nt], 8 * s2);
                    const bf16x8 Bf = ld2x64(lds + SS_OFF_CM + (32 * lt + r) * SS_CM + 2 * (32 * nt + 16 * s2 + 4 * h));
                    Yo = HY_MFMA(A, Bf, Yo); }
            for (int st = 0; st <= lt; ++st) {
                f32x16 S;
#pragma unroll
                for (int e = 0; e < 16; ++e) S[e] = 0.f;
#pragma unroll
                for (int kk = 0; kk < 4; ++kk) { const bf16x8 A = *(const LAS bf16x8*)(lds + SS_OFF_BM + (32 * st + r) * SS_BM + 32 * kk + 16 * h);
                    const bf16x8 Bf = *(const LAS bf16x8*)(lds + SS_OFF_CM + (32 * lt + r) * SS_CM + 32 * kk + 16 * h);
                    S = HY_MFMA(A, Bf, S); }
#pragma unroll
                for (int gq = 0; gq < 4; ++gq) { const int s0 = 32 * st + 8 * gq + 4 * h;
                    const f32x4 las = *(const LAS f32x4*)(LA + s0), dts = *(const LAS f32x4*)(DTs + s0);
#pragma unroll
                    for (int e = 0; e < 4; ++e) { float gv = S[4 * gq + e] * __expf(la_l - las[e]) * dts[e];
                        if (st == lt) { const int sl = 8 * gq + 4 * h + e; if (sl > r) gv = 0.f; if (sl == r) gv += dsk; }
                        S[4 * gq + e] = gv; } }
                {
                    const unsigned xa = trx4 + (unsigned)(st * 32 * SS_XT); v2u a0, a1, c0, c1;
                    SS_TR2(a0, a1, xa, 0, 8 * SS_XT); SS_TR2(c0, c1, xa, 16 * SS_XT, 24 * SS_XT); SS_TRWAIT();
                    Yd = HY_MFMA(ss_frag(a0, a1), pack8(S, 0), Yd); Yd = HY_MFMA(ss_frag(c0, c1), pack8(S, 8), Yd); }
            }
            { const int lq = 32 * lt + r; const int tq = dir ? cs + 127 - lq : cs + lq; const float el = __expf(la_l);
              bf16* orow = Y + (size_t)(base + tq) * 256 + 64 * hh + 32 * ph + 4 * h;
              if (!sctx || layer != DEPTH - 1) {
#pragma unroll
                for (int gq = 0; gq < 4; ++gq) { v2u w; w.x = pk2(Yd[4 * gq] + el * Yo[4 * gq], Yd[4 * gq + 1] + el * Yo[4 * gq + 1]); w.y = pk2(Yd[4 * gq + 2] + el * Yo[4 * gq + 2], Yd[4 * gq + 3] + el * Yo[4 * gq + 3]);
                    *(v2u*)(orow + 8 * gq) = w; } } }
            { const float ea = __expf(lend);
#pragma unroll
              for (int nt = 0; nt < 2; ++nt)
#pragma unroll
                for (int e = 0; e < 16; ++e) Hacc[nt][e] *= ea;
#pragma unroll
              for (int kh = 0; kh < 2; ++kh) {
                v2u ax[4][2], a0[4][2], a1[4][2];
#pragma unroll
                for (int kk = 0; kk < 4; ++kk) { const int k = 4 * kh + kk;
                    SS_TR2(ax[kk][0], ax[kk][1], trx8, 16 * k * SS_XT, (16 * k + 4) * SS_XT);
                    SS_TR2(a0[kk][0], a0[kk][1], trb8, 16 * k * SS_BT, (16 * k + 4) * SS_BT);
                    SS_TR2(a1[kk][0], a1[kk][1], trb8, 16 * k * SS_BT + 64, (16 * k + 4) * SS_BT + 64); }
                SS_TRWAIT();
#pragma unroll
                for (int kk = 0; kk < 4; ++kk) { const bf16x8 Bf = ss_frag(ax[kk][0], ax[kk][1]);
                    Hacc[0] = HY_MFMA(ss_frag(a0[kk][0], a0[kk][1]), Bf, Hacc[0]); Hacc[1] = HY_MFMA(ss_frag(a1[kk][0], a1[kk][1]), Bf, Hacc[1]); } } }
        }
    }
}
__device__ __forceinline__ void phase_ssd_mfma(const Ctx& C, int layer) {
    for (int u = C.bid; u < NB * 4 * 2; u += C.G) ssd_unit(C, layer, u >> 3, (u >> 1) & 3, u & 1);
    __syncthreads();
}

constexpr int HY_ROW = 4112, HY_ROWC = 528;
constexpr int HY_F0 = 32 * HY_ROW, HY_F1 = HY_F0 + 8192 + 64, HY_LDS_END = HY_F1 + 8192;
static_assert(HY_LDS_END <= MISC_OFF, "hyena LDS map");
__device__ __forceinline__ bf16x8 hy_ldA(LAS unsigned char* lds, unsigned addr) {
    const LAS unsigned* p = (const LAS unsigned*)(lds + addr); v4u w; w.x = p[0]; w.y = p[1]; w.z = p[2]; w.w = p[3]; return __builtin_bit_cast(bf16x8, w);
}
__device__ __forceinline__ void hy_load_filter(LAS unsigned char* lds, const bf16* R, int n, int tid) {
    asm volatile("" : "+v"(tid));
    for (int q = tid; q < n / 8; q += NTHR) { v4u v = *((const v4u*)R + q); const unsigned nxt = (q < n / 8 - 1) ? (unsigned)R[8 * q + 8] : 0u;
        if (q == n / 8 - 1) v.w &= 0xffffu;
        *(LAS v4u*)(lds + HY_F0 + 16 * q) = v;
        v4u s; s.x = (v.x >> 16) | (v.y << 16); s.y = (v.y >> 16) | (v.z << 16); s.z = (v.z >> 16) | (v.w << 16); s.w = (v.w >> 16) | (nxt << 16);
        *(LAS v4u*)(lds + HY_F1 + 16 * q) = s; }
}
template <int L, int ROW>
__device__ __forceinline__ void hy_load_rows(LAS unsigned char* lds, const bf16* src, float w0, float w1, float w2, float bias, int tid) {
    asm volatile("" : "+v"(tid));
    constexpr int CPR = L / 8, NCH = 32 * CPR, PER = NCH / NTHR, HP = PER > 8 ? 8 : PER;
#pragma unroll
    for (int j0 = 0; j0 < PER; j0 += HP) {
        v4u v[HP]; unsigned short pv[HP], nx[HP];
#pragma unroll
        for (int j = 0; j < HP; ++j) { const int q = tid + NTHR * (j0 + j), ch = q % CPR; v[j] = *((const v4u*)src + q);
            pv[j] = ch > 0 ? src[(size_t)q * 8 - 1] : (unsigned short)0; nx[j] = ch < CPR - 1 ? src[(size_t)q * 8 + 8] : (unsigned short)0; }
#pragma unroll
        for (int j = 0; j < HP; ++j) { const int q = tid + NTHR * (j0 + j), b = q / CPR, ch = q % CPR;
            float x[10]; x[0] = bf2f(pv[j]); x[9] = bf2f(nx[j]);
            x[1] = bflo(v[j].x); x[2] = bfhi(v[j].x); x[3] = bflo(v[j].y); x[4] = bfhi(v[j].y); x[5] = bflo(v[j].z); x[6] = bfhi(v[j].z); x[7] = bflo(v[j].w); x[8] = bfhi(v[j].w);
            float y[8];
#pragma unroll
            for (int e = 0; e < 8; ++e) y[e] = w0 * x[e] + w1 * x[e + 1] + w2 * x[e + 2] + bias;
            v4u o; o.x = pk2(y[0], y[1]); o.y = pk2(y[2], y[3]); o.z = pk2(y[4], y[5]); o.w = pk2(y[6], y[7]);
            *(LAS v4u*)(lds + b * ROW + ch * 16) = o; }
    }
}
template <int L, int ROW>
__device__ __forceinline__ void hy_store_rows(LAS unsigned char* lds, bf16* dst, int tid) {
    asm volatile("" : "+v"(tid));
    constexpr int CPR = L / 8, NCH = 32 * CPR, PER = NCH / NTHR;
#pragma unroll
    for (int j = 0; j < PER; ++j) { const int q = tid + NTHR * j, b = q / CPR, ch = q % CPR; *((v4u*)dst + q) = *(const LAS v4u*)(lds + b * ROW + ch * 16); }
}
template <int NTILE, int ROW>
__device__ __forceinline__ void hy_mul_inplace(LAS unsigned char* lds, const f32x16 (&acc)[NTILE], int wave, int lane) {
    asm volatile("" : "+v"(lane));
    const int r = lane & 31, h = lane >> 5;
#pragma unroll
    for (int i = 0; i < NTILE; ++i)
#pragma unroll
        for (int g = 0; g < 4; ++g) { const int t = 32 * NTILE * wave + 32 * i + 8 * g + 4 * h;
            LAS v2u* p = (LAS v2u*)(lds + r * ROW + 2 * t); const v2u x = *p;
            v2u o; o.x = pk2(bflo(x.x) * acc[i][4 * g + 0], bfhi(x.x) * acc[i][4 * g + 1]); o.y = pk2(bflo(x.y) * acc[i][4 * g + 2], bfhi(x.y) * acc[i][4 * g + 3]); *p = o; }
}
__device__ __forceinline__ void hy_conv_lat(LAS unsigned char* lds, f32x16 (&acc)[8], int wave, int lane_in) {
    int lane = lane_in; asm volatile("" : "+v"(lane));
    const int r = lane & 31, h = lane >> 5, odd = (r + 1) & 1;
    const unsigned LA7 = HY_F0 + odd * (HY_F1 - HY_F0) + 2 * (2047 - r + 8 * h - odd) - 512 * wave - 448;
    const unsigned LB = r * HY_ROW + 16 * h;
#pragma unroll
    for (int i = 0; i < 8; ++i)
#pragma unroll
        for (int e = 0; e < 16; ++e) acc[i][e] = 0.f;
    bf16x8 We[8], Wo[8];
#pragma unroll
    for (int i = 1; i < 8; ++i) { We[i] = hy_ldA(lds, LA7 + 64 * (7 - i)); Wo[i] = hy_ldA(lds, LA7 + 64 * (7 - i) + 32); }
    unsigned fa = LA7 + 448, fb = LB;
    bf16x8 An = hy_ldA(lds, fa), Bn = *(const LAS bf16x8*)(lds + fb);
#pragma unroll 1
    for (int kb = 0; kb < 8; ++kb) {
#pragma unroll
        for (int u = 0; u < 8; ++u) {
            {
                const bf16x8 Bc = Bn; We[0] = An;
                An = hy_ldA(lds, fa + 32 * (2 * u + 1)); Bn = *(const LAS bf16x8*)(lds + fb + 32 * (2 * u + 1));
#pragma unroll
                for (int i = 0; i < 8; ++i) acc[i] = HY_MFMA(We[i], Bc, acc[i]);
#pragma unroll
                for (int i = 7; i >= 1; --i) We[i] = We[i - 1];
            }
            {
                const bf16x8 Bc = Bn; Wo[0] = An;
                An = hy_ldA(lds, fa + 32 * (2 * u + 2)); Bn = *(const LAS bf16x8*)(lds + fb + 32 * (2 * u + 2));
#pragma unroll
                for (int i = 0; i < 8; ++i) acc[i] = HY_MFMA(Wo[i], Bc, acc[i]);
#pragma unroll
                for (int i = 7; i >= 1; --i) Wo[i] = Wo[i - 1];
            }
        }
        fa += 512; fb += 512;
    }
}
__device__ __forceinline__ void hy_conv_ctx(LAS unsigned char* lds, f32x16 (&acc)[1], int wave, int lane) {
    asm volatile("" : "+v"(lane));
    const int r = lane & 31, h = lane >> 5, odd = (r + 1) & 1;
    const unsigned LA = HY_F0 + odd * (HY_F1 - HY_F0) + 2 * (255 - r + 8 * h - odd) - 64 * wave;
    const unsigned LB = r * HY_ROWC + 16 * h;
#pragma unroll
    for (int e = 0; e < 16; ++e) acc[0][e] = 0.f;
#pragma unroll
    for (int k = 0; k < 16; ++k) { const bf16x8 A = hy_ldA(lds, LA + 32 * k); const bf16x8 B = *(const LAS bf16x8*)(lds + LB + 32 * k); acc[0] = HY_MFMA(A, B, acc[0]); }
}
__device__ __forceinline__ void phase_hy_mfma(const Ctx& C, int layer) {
    const bf16* HT = WSP(bf16, WS_HYT); bf16* HO = WSP(bf16, WS_HYOT);
    const bool last = layer == DEPTH - 1;
    LAS unsigned char* lds = C.lds;
    const float* cw = C.in[I_HCW] + (size_t)layer * 3 * 768; const float* cb = C.in[I_HCB] + (size_t)layer * 768;
    for (int c = C.bid; c < 256; c += C.G) {
        float w[3][4];
#pragma unroll
        for (int p = 0; p < 3; ++p) { w[p][0] = cw[256 * p + c]; w[p][1] = cw[768 + 256 * p + c]; w[p][2] = cw[1536 + 256 * p + c]; w[p][3] = cb[256 * p + c]; }
        __syncthreads();
        {
            f32x16 acc[8];
            hy_load_filter(lds, WSP(bf16, WS_FILTB) + ((size_t)layer * 512 + c) * 4096, 4096, C.tid);
            hy_load_rows<2048, HY_ROW>(lds, HT + (size_t)c * TT, w[0][0], w[0][1], w[0][2], w[0][3], C.tid);
            __syncthreads();
            hy_conv_lat(lds, acc, C.wave, C.lane);
            __syncthreads();
            hy_load_filter(lds, WSP(bf16, WS_FILTB) + ((size_t)layer * 512 + 256 + c) * 4096, 4096, C.tid);
            hy_load_rows<2048, HY_ROW>(lds, HT + (size_t)(256 + c) * TT, w[1][0], w[1][1], w[1][2], w[1][3], C.tid);
            __syncthreads();
            hy_mul_inplace<8, HY_ROW>(lds, acc, C.wave, C.lane);
            __syncthreads();
            hy_conv_lat(lds, acc, C.wave, C.lane);
            __syncthreads();
            hy_load_rows<2048, HY_ROW>(lds, HT + (size_t)(512 + c) * TT, w[2][0], w[2][1], w[2][2], w[2][3], C.tid);
            __syncthreads();
            hy_mul_inplace<8, HY_ROW>(lds, acc, C.wave, C.lane);
            __syncthreads();
            hy_store_rows<2048, HY_ROW>(lds, HO + (size_t)c * TT, C.tid);
        }
        if (!last) {
            __syncthreads();
            f32x16 acc[1];
            hy_load_filter(lds, WSP(bf16, WS_FILTCB) + ((size_t)layer * 512 + c) * 512, 512, C.tid);
            hy_load_rows<256, HY_ROWC>(lds, HT + (size_t)c * TT + TLAT, w[0][0], w[0][1], w[0][2], w[0][3], C.tid);
            __syncthreads();
            hy_conv_ctx(lds, acc, C.wave, C.lane);
            __syncthreads();
            hy_load_filter(lds, WSP(bf16, WS_FILTCB) + ((size_t)layer * 512 + 256 + c) * 512, 512, C.tid);
            hy_load_rows<256, HY_ROWC>(lds, HT + (size_t)(256 + c) * TT + TLAT, w[1][0], w[1][1], w[1][2], w[1][3], C.tid);
            __syncthreads();
            hy_mul_inplace<1, HY_ROWC>(lds, acc, C.wave, C.lane);
            __syncthreads();
            hy_conv_ctx(lds, acc, C.wave, C.lane);
            __syncthreads();
            hy_load_rows<256, HY_ROWC>(lds, HT + (size_t)(512 + c) * TT + TLAT, w[2][0], w[2][1], w[2][2], w[2][3], C.tid);
            __syncthreads();
            hy_mul_inplace<1, HY_ROWC>(lds, acc, C.wave, C.lane);
            __syncthreads();
            hy_store_rows<256, HY_ROWC>(lds, HO + (size_t)c * TT + TLAT, C.tid);
        }
    }
    __syncthreads();
}

__device__ __forceinline__ void phase_merge(const Ctx& C, int layer) {
    const bf16* AO = WSP(bf16, WS_ATT); const bf16* SY = WSP(bf16, WS_SSDY); const bf16* HO = WSP(bf16, WS_HYOT); const bf16* P = WSP(bf16, WS_PROJ);
    bf16* Y = WSP(bf16, WS_A);
    const float* g_att = C.in[I_ATTON] + layer * 512; const float* g_ssd = C.in[I_SNORM] + layer * 256; const float* g_hy = C.in[I_HON] + layer * 256;
    const int nrows = (layer == DEPTH - 1) ? TLAT : TT;
    constexpr int RS = 66;
    LAS unsigned char* lds = C.lds;
    const int lane = C.lane;
    float ga[8], gs[4], gh[4];
#pragma unroll
    for (int e = 0; e < 8; ++e) ga[e] = g_att[8 * lane + e];
#pragma unroll
    for (int e = 0; e < 4; ++e) { gs[e] = g_ssd[4 * lane + e]; gh[e] = g_hy[4 * lane + e]; }
    for (int tile = C.bid; tile < nrows / 32; tile += C.G) {
        const int tok0 = 32 * tile;
        __syncthreads();
        {
            v4u hv[2];
#pragma unroll
            for (int j = 0; j < 2; ++j) { const int q = C.tid + NTHR * j, c = q >> 2, ch = q & 3; hv[j] = *(const v4u*)(HO + (size_t)c * TT + tok0 + 8 * ch); }
#pragma unroll
            for (int j = 0; j < 2; ++j) { const int q = C.tid + NTHR * j, c = q >> 2, ch = q & 3; LAS unsigned* d = (LAS unsigned*)(lds + c * RS + 16 * ch + (c & 1) * 2);
                (void)d; LAS bf16* d2 = (LAS bf16*)(lds + c * RS + 16 * ch); const unsigned w[4] = {hv[j].x, hv[j].y, hv[j].z, hv[j].w};
#pragma unroll
                for (int e = 0; e < 8; ++e) d2[e] = (bf16)((e & 1) ? (w[e >> 1] >> 16) : (w[e >> 1] & 0xffffu)); }
        }
        __syncthreads();
#pragma unroll
        for (int i = 0; i < 4; ++i) { const int tl = 4 * C.wave + i; const int m = tok0 + tl;
            { const v4u w = *((const v4u*)(AO + (size_t)m * 512) + lane);
              float v[8] = {bflo(w.x), bfhi(w.x), bflo(w.y), bfhi(w.y), bflo(w.z), bfhi(w.z), bflo(w.w), bfhi(w.w)}; float ss = 0.f;
#pragma unroll
              for (int e = 0; e < 8; ++e) ss += v[e] * v[e];
              const float rstd = rsqrtf(wave_sum(ss) * (1.0f / 512.0f) + EPS);
              v4u o; o.x = pk2(v[0] * rstd * ga[0], v[1] * rstd * ga[1]); o.y = pk2(v[2] * rstd * ga[2], v[3] * rstd * ga[3]); o.z = pk2(v[4] * rstd * ga[4], v[5] * rstd * ga[5]); o.w = pk2(v[6] * rstd * ga[6], v[7] * rstd * ga[7]);
              *((v4u*)(Y + (size_t)m * D) + lane) = o; }
            { const v2u w0 = *((const v2u*)(SY + (size_t)m * 256) + lane), w1 = *((const v2u*)(SY + ((size_t)TT + m) * 256) + lane), wz = *((const v2u*)(P + (size_t)m * PW + PC_Z) + lane);
              float v[4] = {bflo(w0.x) + bflo(w1.x), bfhi(w0.x) + bfhi(w1.x), bflo(w0.y) + bflo(w1.y), bfhi(w0.y) + bfhi(w1.y)};
              const float z[4] = {bflo(wz.x), bfhi(wz.x), bflo(wz.y), bfhi(wz.y)}; float ss = 0.f;
#pragma unroll
              for (int e = 0; e < 4; ++e) { v[e] *= silu(z[e]); ss += v[e] * v[e]; }
              const float rstd = rsqrtf(wave_sum(ss) * (1.0f / 256.0f) + EPS);
              v2u o; o.x = pk2(v[0] * rstd * gs[0], v[1] * rstd * gs[1]); o.y = pk2(v[2] * rstd * gs[2], v[3] * rstd * gs[3]);
              *((v2u*)(Y + (size_t)m * D + 512) + lane) = o; }
            { float v[4]; float ss = 0.f;
#pragma unroll
              for (int e = 0; e < 4; ++e) { v[e] = bf2f(*(const LAS bf16*)(lds + (4 * lane + e) * RS + 2 * tl)); ss += v[e] * v[e]; }
              ss += shx(ss, 1, lane); ss += shx(ss, 2, lane); ss += shx(ss, 4, lane); ss += shx(ss, 8, lane);
              const float rstd = rsqrtf(ss * (1.0f / 64.0f) + EPS);
              v2u o; o.x = pk2(v[0] * rstd * gh[0], v[1] * rstd * gh[1]); o.y = pk2(v[2] * rstd * gh[2], v[3] * rstd * gh[3]);
              *((v2u*)(Y + (size_t)m * D + 768) + lane) = o; }
        }
    }
    __syncthreads();
}

constexpr int NPHASES = 1 << 20;
__global__ void __launch_bounds__(NTHR, 2) mega_fwd(Args args) {
    extern __shared__ __attribute__((aligned(16))) unsigned char lds_raw[];
    Ctx C0; C0.in = (const float* const CAS*)__builtin_amdgcn_kernarg_segment_ptr();     C0.out = args.out; C0.ws = args.ws; C0.lds = (LAS unsigned char*)lds_raw;
    C0.tid = threadIdx.x; C0.lane = C0.tid & 63; C0.wave = __builtin_amdgcn_readfirstlane(C0.tid >> 6); C0.bid = blockIdx.x; C0.G = gridDim.x; C0.dry = args.pad1;
    const Ctx& C = C0;
    volatile LAS unsigned* MISC = (volatile LAS unsigned*)(C.lds + MISC_OFF);
    if (C.tid < 64) MISC[C.tid] = 0u;
    __syncthreads();
    const int lo = args.ph_lo, hi = args.ph_hi;
    const bool multi = (hi - lo) > 1;
    XcdBarrier bar; bar.bar = (unsigned*)(C.ws + WS_CTL) + CW_BAR + args.pad0 * XCD_BAR_WORDS; bar.x = 0; bar.st = MISC + 8;
    if (multi) bar = xcd_barrier_post((unsigned*)(C.ws + WS_CTL) + CW_BAR + args.pad0 * XCD_BAR_WORDS, MISC + 8);
    bar.wv = C0.wave;
    int ph = 0;
#if defined(PROBE_SLEEP_US)
    if (lo == 0) { const unsigned long long t0 = __builtin_amdgcn_s_memrealtime(); while (__builtin_amdgcn_s_memrealtime() - t0 < 100ull * PROBE_SLEEP_US) __builtin_amdgcn_s_sleep(32); }
#endif
#ifndef PHMASK
#define PHMASK 0xffffffffu
#endif
#define PHM(i) ((PHMASK >> (i)) & 1u)
#ifndef REPMASK
#define REPMASK 0u
#endif
#define REP(i, call) do { call; if ((REPMASK >> (i)) & 1u) { __syncthreads(); call; } } while (0)
#define PH_BEGIN if (ph >= lo && ph < hi) { Ctx C = C0; { unsigned long long _b = (unsigned long long)C0.out, _c = (unsigned long long)C0.ws, _a = (unsigned long long)C0.in; int _t; \
        asm volatile("v_mbcnt_lo_u32_b32 %0, -1, 0\n\tv_mbcnt_hi_u32_b32 %0, -1, %0" : "=v"(_t)); asm volatile("" : "+s"(_b), "+s"(_c), "+s"(_a)); C.in = (const float* const CAS*)_a; \
        C.out = (float*)(GAS float*)_b; C.ws = (unsigned char*)(GAS unsigned char*)_c; C.lane = _t; C.tid = C0.wave * 64 + _t; C.wave = C0.wave; }
#define PH_END } if (ph >= lo && ph + 1 < hi) xcd_barrier(bar); ++ph;

    PH_BEGIN if (PHM(0)) phase_siluc(C); PH_END
    PH_BEGIN if (PHM(0)) { phase_setup(C);
#if defined(PROBE_SETUP_ONLY)
        if (!C.dry)
#endif
        phase_pre(C, 0); } PH_END
#if defined(PROBE_BARRIERS)
    for (int i = 0; i < PROBE_BARRIERS; ++i) xcd_barrier(bar);
#endif
    for (int layer = 0; layer < DEPTH; ++layer) {
        const bool last = layer == DEPTH - 1; const bool moe = layer & 1;
        PH_BEGIN if (PHM(2)) { phase_norm(C, layer, 0); if (layer > 0) phase_pre(C, layer); } PH_END
        PH_BEGIN if (PHM(3)) { pg8::Gemm g{WSP(bf16, WS_A), WSP(bf16, WS_WIN), TT, PW, D}; pg8::ProjOrder S; S.init(TT, C.G, C.bid, layer == DEPTH - 1);
                   pg8::EpiProj E{WSP(bf16, WS_PROJ), WSP(bf16, WS_HYT), TT, C.in[I_QNORM] + layer * 64, C.in[I_KNORM] + layer * 64, WSP(float, WS_ROPE), WSP(float, WS_ROPE) + 32 * 32};
                   pg8::gemm_phase<pg8::EpiProj, pg8::ProjOrder, PG8_ALIGN, PG8_SP2>(C.lds, g, S, E, C.tid); } PH_END
        PH_BEGIN {
#pragma unroll 1
            for (int k = 0; k < 3; ++k) { const int w = (C.bid & 1) ? 2 - k : k;
#if defined(PROBE_SUB)
                if (C.dry && w != PROBE_SUB) continue;
#endif
                if (w == 0) phase_att_mfma(C, layer); else if (w == 1) phase_ssd_mfma(C, layer); else phase_hy_mfma(C, layer); } } PH_END
        PH_BEGIN if (PHM(9)) REP(9, phase_merge(C, layer)); PH_END
        PH_BEGIN if (PHM(10)) { const int M = last ? TLAT : TT; pg8::Gemm g{WSP(bf16, WS_A), WSP(bf16, WS_WOUT), M, D, D}; pg8::StaticOrder S; S.init(M, D, C.G, C.bid);
                   pg8::EpiResid E{layer == 0 ? (const void*)C.in[I_X] : (const void*)C.out, layer == 0 ? (const void*)C.in[I_CTX] : (const void*)WSP(bf16, WS_XC), (void*)C.out, (void*)WSP(bf16, WS_XC), layer == 0 ? 1 : 0, 0,
                                      WSP(float, WS_MOD) + (size_t)layer * 33 * 6144 + 2 * 1024, nullptr, nullptr, 0, C.dry};
                   pg8::gemm_phase<pg8::EpiResid, pg8::StaticOrder, PG8_ALIGN, PG8_SP2>(C.lds, g, S, E, C.tid); } PH_END
        PH_BEGIN if (PHM(11)) phase_norm(C, layer, 1); PH_END
        const int nslot = moe ? 2 : 1;
        for (int slot = 0; slot < nslot; ++slot) {
            if (moe && slot == 0) { PH_BEGIN if (PHM(14)) phase_moe_maps(C, layer); PH_END }
            PH_BEGIN if (PHM(12)) for (int rep = 0; rep < 1 + (int)((REPMASK >> 12) & 1u); ++rep) { pg8::MoeOrder S; int off[9];
                   if (moe) moe_offsets(C, layer, slot, off); else { off[0] = 0;
#pragma unroll
                       for (int e = 1; e < 9; ++e) off[e] = last ? TLAT : TT; }
#pragma unroll
                   for (int e = 0; e < 9; ++e) S.ts[e] = off[e] >> 8;
                   S.estride = (size_t)2 * FF * D * 2; S.init(off[8], 2 * FF, C.G, C.bid); S.goff = moe ? (slot ? WSP(unsigned, WS_GOFF1) : WSP(unsigned, WS_GOFF)) : nullptr;
                   pg8::Gemm g{WSP(bf16, WS_A), WSP(bf16, WS_F1), off[8], 2 * FF, D};
                   pg8::EpiSwiglu E{WSP(bf16, WS_HID), FF};
                   pg8::gemm_phase<pg8::EpiSwiglu, pg8::MoeOrder, PG8_ALIGN, PG8_SP2, true>(C.lds, g, S, E, C.tid); } PH_END
            PH_BEGIN if (PHM(13)) { pg8::MoeOrder S; int off[9];
                   if (moe) moe_offsets(C, layer, slot, off); else { off[0] = 0;
#pragma unroll
                       for (int e = 1; e < 9; ++e) off[e] = last ? TLAT : TT; }
#pragma unroll
                   for (int e = 0; e < 9; ++e) S.ts[e] = off[e] >> 8;
                   S.estride = (size_t)D * FF * 2; S.init(off[8], D, C.G, C.bid); S.goff = nullptr;
                   pg8::Gemm g{WSP(bf16, WS_HID), WSP(bf16, WS_F2), off[8], D, FF};
                   const bool fin0 = last && slot == 0, fin1 = last && slot == 1;
                   pg8::EpiResid E{fin1 ? (const void*)WSP(bf16, WS_XR) : (const void*)C.out, (const void*)WSP(bf16, WS_XC), fin0 ? (void*)WSP(bf16, WS_XR) : (void*)C.out, (void*)WSP(bf16, WS_XC), 0, fin1 ? 1 : 0,
                                   WSP(float, WS_MOD) + (size_t)layer * 33 * 6144 + 5 * 1024, moe ? (slot ? WSP(int, WS_ROWTOK1) : WSP(int, WS_ROWTOK)) : nullptr, moe ? (slot ? WSP(float, WS_ROWW1) : WSP(float, WS_ROWW)) : nullptr, 1, C.dry};
                   pg8::gemm_phase<pg8::EpiResid, pg8::MoeOrder, PG8_ALIGN, PG8_SP2>(C.lds, g, S, E, C.tid);
                   } PH_END
        }
    }
#undef PH_BEGIN
#undef PH_END
}

#ifndef MK_ONE_LAUNCH
#define MK_ONE_LAUNCH 1
#endif
extern "C" void kernel_launch(void* const* d_in, const int* in_sizes, int n_in, void* d_out, int out_size, void* d_ws, size_t ws_size, hipStream_t stream) {
    static int grid = 0;
    if (grid == 0) {
        if (n_in != 38 || out_size != TLAT * D || ws_size < WS_END) { fprintf(stderr, "kernel_launch: unexpected shapes (n_in %d, out %d, ws %zu)\n", n_in, out_size, ws_size); grid = -1; return; }
        int dev = 0, cus = 0, per_cu = 0;
        if (hipGetDevice(&dev) != hipSuccess || hipDeviceGetAttribute(&cus, hipDeviceAttributeMultiprocessorCount, dev) != hipSuccess) { grid = -1; return; }
        if (hipFuncSetAttribute((const void*)mega_fwd, hipFuncAttributeMaxDynamicSharedMemorySize, LDS_BYTES) != hipSuccess) { fprintf(stderr, "kernel_launch: hipFuncSetAttribute failed\n"); grid = -1; return; }
        if (hipOccupancyMaxActiveBlocksPerMultiprocessor(&per_cu, (const void*)mega_fwd, NTHR, LDS_BYTES) != hipSuccess || per_cu < 1) { fprintf(stderr, "kernel_launch: occupancy query says %d\n", per_cu); (void)hipGetLastError(); grid = -1; return; }
        grid = cus;
    }
    if (grid < 0) return;
    (void)hipMemsetAsync((char*)d_ws + WS_CTL, 0, CTL_ZERO_BYTES, stream);
    Args a{};
    for (int i = 0; i < 38; ++i) a.in[i] = (const float*)d_in[i];
    a.out = (float*)d_out; a.ws = (unsigned char*)d_ws;
#if defined(PROBE_PHASE)
#ifndef PROBE_END
#define PROBE_END (PROBE_PHASE + 1)
#endif
    a.ph_lo = 0; a.ph_hi = PROBE_END; a.pad0 = 0; hipLaunchKernelGGL(mega_fwd, dim3(grid), dim3(NTHR), LDS_BYTES, stream, a);
#ifndef PROBE_REP
#define PROBE_REP 1
#endif
    for (int rep = 0; rep < PROBE_REP; ++rep) { a.ph_lo = PROBE_PHASE; a.ph_hi = PROBE_END; a.pad0 = 1; a.pad1 = 1; hipLaunchKernelGGL(mega_fwd, dim3(grid), dim3(NTHR), LDS_BYTES, stream, a); }
    a.ph_lo = PROBE_END; a.ph_hi = NPHASES; a.pad0 = 2; a.pad1 = 0; hipLaunchKernelGGL(mega_fwd, dim3(grid), dim3(NTHR), LDS_BYTES, stream, a);
#elif MK_ONE_LAUNCH
    a.ph_lo = 0; a.ph_hi = NPHASES;
    hipLaunchKernelGGL(mega_fwd, dim3(grid), dim3(NTHR), LDS_BYTES, stream, a);
#else
#error multi-launch build removed
#endif
}
```

```cpp
#include <hip/hip_runtime.h>
#include <cstdio>
#include <cstdint>
__device__ __forceinline__ int lane_now() { int l; asm volatile("v_mbcnt_lo_u32_b32 %0, -1, 0\n\tv_mbcnt_hi_u32_b32 %0, -1, %0" : "=v"(l)); return l; }
__device__ __forceinline__ float shx(float v, int o, int lane) { return __builtin_bit_cast(float, __builtin_amdgcn_ds_bpermute((lane ^ o) << 2, __builtin_bit_cast(int, v))); }
__device__ __forceinline__ float shup(float v, int o, int lane) { return __builtin_bit_cast(float, __builtin_amdgcn_ds_bpermute(((lane - o) & 63) << 2, __builtin_bit_cast(int, v))); }
namespace pg8 {
#define PG8_LAS __attribute__((address_space(3)))
typedef unsigned short bf16_t;
typedef short bf16x8 __attribute__((ext_vector_type(8)));
typedef float f32x4 __attribute__((ext_vector_type(4)));
typedef unsigned u32x4 __attribute__((ext_vector_type(4)));
constexpr int BM = 256, BK = 64, HALF = 128, HTB = HALF * BK * 2  , STAGE_BYTES = 8 * HTB, NXCD = 8, WGM = 8;

__host__ __device__ __forceinline__ int lds_byte(int r, int c) { const int st = (r >> 4) * 2 + (c >> 5), rr = r & 15, cc = c & 31, ob = rr * 64 + cc * 2; return st * 1024 + (ob ^ (((ob >> 9) & 1) << 5)); }
__host__ __device__ __forceinline__ void stage_rc(int b, int& R, int& C) { const int st = b / 1024, sb = b % 1024, swz = sb ^ (((sb >> 9) & 1) << 5); R = (st >> 1) * 16 + swz / 64; C = (st & 1) * 32 + (swz % 64) / 2; }
__host__ __device__ __forceinline__ int perm32(int rho) { const int n = rho >> 4, i = rho & 15; return 8 * (i >> 2) + 4 * n + (i & 3); }

struct Unit { int pm, pn; };
struct Gemm { const bf16_t* A; const bf16_t* Bt; int M, N, K; };

struct StaticOrder {
    int nM, nN, nwg, G, c;
    __host__ __device__ void init(int M, int N, int G_, int c_) { nM = M / BM; nN = N / BM; nwg = nM * nN; G = G_; c = c_; }
    __host__ __device__ bool next(int i, Unit& u) const {
        const long L = (long)i * G + c; if (L >= nwg) return false;
        int wgid = (int)L; { const int q = nwg / NXCD, r = nwg % NXCD, xcd = wgid % NXCD, off = wgid / NXCD; wgid = (xcd < r ? xcd * (q + 1) : r * (q + 1) + (xcd - r) * q) + off; }
        const int nig = WGM * nN, gid = wgid / nig, fm = gid * WGM, gsz = (nM - fm) < WGM ? (nM - fm) : WGM;
        u.pm = fm + ((wgid % nig) % gsz); u.pn = (wgid % nig) / gsz; return true;
    }
    __device__ __forceinline__ void a_ready(const Unit&) const {}
    __device__ __forceinline__ void done(const Unit&) const {}
    __device__ __forceinline__ const char* b_base(const Gemm& g, const Unit& u, size_t tstep) const { return (const char*)g.Bt + (size_t)u.pn * tstep; }
    __device__ __forceinline__ const char* a_base(const Gemm& g, const Unit& u, size_t tstep) const { return (const char*)g.A + (size_t)u.pm * tstep; }
};
struct ProjOrder {
    StaticOrder a; int nA, nC, nB, ctxpm;
    __device__ __forceinline__ void init(int M, int G_, int c_, bool ctx_kv_only) {
        if (ctx_kv_only) { a.init(M - 8192, 1536, G_, c_); nA = a.nwg; ctxpm = (M - 8192) / BM; nC = 3 * 32; nB = 3 * ctxpm; }
        else { a.init(M, 1536, G_, c_); nA = a.nwg; ctxpm = 0; nC = 0; nB = 3 * (M / BM); } }
    __device__ __forceinline__ bool next(int i, Unit& u) const { const long L = (long)i * a.G + a.c; if (L < nA) return a.next(i, u);
        int l2 = (int)(L - nA);
        if (l2 < nC) { const int j = l2 % 3; u.pm = ctxpm + l2 / 3; u.pn = j == 0 ? 2 : 3 + j; return true; }
        l2 -= nC; if (l2 >= nB) return false; u.pm = l2 % 3; u.pn = 1024 + l2 / 3; return true; }
    __device__ __forceinline__ void a_ready(const Unit&) const {}
    __device__ __forceinline__ void done(const Unit&) const {}
    __device__ __forceinline__ const char* a_base(const Gemm& g, const Unit& u, size_t tstep) const { return u.pn < 1024 ? (const char*)g.A + (size_t)u.pm * tstep : (const char*)g.Bt + (size_t)(6 + u.pm) * tstep; }
    __device__ __forceinline__ const char* b_base(const Gemm& g, const Unit& u, size_t tstep) const { return u.pn < 1024 ? (const char*)g.Bt + (size_t)u.pn * tstep : (const char*)g.A + (size_t)(u.pn - 1024) * tstep; }
};
struct MoeOrder : StaticOrder {
    int ts[9]; size_t estride; const unsigned* goff;
    __device__ __forceinline__ const char* b_base(const Gemm& g, const Unit& u, size_t tstep) const { int e = 0;
#pragma unroll
        for (int j = 1; j < 8; ++j) e += (u.pm >= ts[j]) ? 1 : 0;
        return (const char*)g.Bt + (size_t)e * estride + (size_t)u.pn * tstep; }
};


__device__ __forceinline__ unsigned cvt_pk_bf16(float lo, float hi) { unsigned r; asm volatile("v_cvt_pk_bf16_f32 %0, %1, %2" : "=v"(r) : "v"(lo), "v"(hi)); return r; }
__device__ __forceinline__ float silu_f(float v) { return v * __builtin_amdgcn_rcpf(1.0f + __expf(-v)); }

struct EpiStore {
    static constexpr bool PERM = true, AFTER_DRAIN = false;
    bf16_t* O; int ldc;
    __device__ __forceinline__ void operator()(const f32x4 (&acc)[2][2][4][2], const Unit& u, int wr, int wc, int fr, int fq) const {
        const int row0 = u.pm * BM + wr * 64 + fr; const int col0 = u.pn * BM + wc * 32 + 8 * fq;
#pragma unroll
        for (int ai = 0; ai < 2; ++ai)
#pragma unroll
            for (int m = 0; m < 4; ++m) { bf16_t* rowp = O + (size_t)(row0 + ai * HALF + m * 16) * ldc + col0;
#pragma unroll
                for (int bj = 0; bj < 2; ++bj) { const f32x4 v0 = acc[ai][bj][m][0], v1 = acc[ai][bj][m][1];
                    u32x4 w; w.x = cvt_pk_bf16(v0[0], v0[1]); w.y = cvt_pk_bf16(v0[2], v0[3]); w.z = cvt_pk_bf16(v1[0], v1[1]); w.w = cvt_pk_bf16(v1[2], v1[3]);
                    *(u32x4*)(rowp + bj * HALF) = w; } }
    }
};
struct EpiSwiglu {
    static constexpr bool PERM = true, AFTER_DRAIN = false;
    bf16_t* H; int ldh;
    __device__ __forceinline__ void operator()(const f32x4 (&acc)[2][2][4][2], const Unit& u, int wr, int wc, int fr, int fq) const {
        const int row0 = u.pm * BM + wr * 64 + fr; const int hid0 = u.pn * 128 + wc * 32 + 8 * fq;
#pragma unroll
        for (int ai = 0; ai < 2; ++ai)
#pragma unroll
            for (int m = 0; m < 4; ++m) { bf16_t* rowp = H + (size_t)(row0 + ai * HALF + m * 16) * ldh + hid0;
                float h[8];
#pragma unroll
                for (int bj = 0; bj < 2; ++bj)
#pragma unroll
                    for (int e = 0; e < 4; ++e) h[4 * bj + e] = silu_f(acc[ai][bj][m][0][e]) * acc[ai][bj][m][1][e];
                u32x4 w; w.x = cvt_pk_bf16(h[0], h[1]); w.y = cvt_pk_bf16(h[2], h[3]); w.z = cvt_pk_bf16(h[4], h[5]); w.w = cvt_pk_bf16(h[6], h[7]);
                *(u32x4*)rowp = w; }
    }
};
struct EpiResid {
    static constexpr bool PERM = true, AFTER_DRAIN = false;
    const void* slat; const void* sctx; void* dlat; void* dctx; int sf32, df32;
    const float* gate; const int* rowtok;
    const float* cw; int cw_stride;
    int dry;
    typedef unsigned u32x4_t __attribute__((ext_vector_type(4)));
    __device__ __forceinline__ void operator()(const f32x4 (&acc)[2][2][4][2], const Unit& u, int wr, int wc, int fr, int fq) const {
        const int row0 = u.pm * BM + wr * 64 + fr, col0 = u.pn * BM + wc * 32 + 8 * fq;
        unsigned long long sl = (unsigned long long)slat, sx = (unsigned long long)sctx, dl = (unsigned long long)dlat, dx = (unsigned long long)dctx;
        asm volatile("" : "+s"(sl), "+s"(sx), "+s"(dl), "+s"(dx));
        int tok[2][4]; float sc[2][4];
#pragma unroll
        for (int ai = 0; ai < 2; ++ai)
#pragma unroll
            for (int m = 0; m < 4; ++m) { const int row = row0 + ai * HALF + m * 16; tok[ai][m] = rowtok ? rowtok[row] : row; sc[ai][m] = cw ? cw[(size_t)row * cw_stride] : 1.0f; }
        f32x4 gu[2][2];
        if (!rowtok) { const int t0 = u.pm * BM; const float* g = gate + (size_t)(t0 < 65536 ? (t0 >> 11) : 32) * 6144 + col0;
#pragma unroll
            for (int bj = 0; bj < 2; ++bj)
#pragma unroll
                for (int n = 0; n < 2; ++n) gu[bj][n] = *(const f32x4*)(g + bj * HALF + 4 * n); }
#pragma unroll
        for (int ai = 0; ai < 2; ++ai)
#pragma unroll
          for (int mh = 0; mh < 2; ++mh) {
            f32x4 xv[2][2][2]; size_t ro[2]; int mr[2]; unsigned long long sb[2], db[2];
#pragma unroll
            for (int mm = 0; mm < 2; ++mm) { const int m = 2 * mh + mm; const int t = tok[ai][m] < 0 ? 0 : tok[ai][m];
                const bool lt = t < 65536; ro[mm] = (size_t)(lt ? t : t - 65536) * 1024 + col0; mr[mm] = lt ? (t >> 11) : 32; sb[mm] = lt ? sl : sx; db[mm] = lt ? dl : dx;
                if (sf32) { const __attribute__((address_space(1))) float* p = (const __attribute__((address_space(1))) float*)sb[mm] + ro[mm];
#pragma unroll
                    for (int bj = 0; bj < 2; ++bj)
#pragma unroll
                        for (int n = 0; n < 2; ++n) xv[mm][bj][n] = *(const __attribute__((address_space(1))) f32x4*)(p + bj * HALF + 4 * n);
                } else { const __attribute__((address_space(1))) bf16_t* p = (const __attribute__((address_space(1))) bf16_t*)sb[mm] + ro[mm];
#pragma unroll
                    for (int bj = 0; bj < 2; ++bj) { const u32x4_t w = *(const __attribute__((address_space(1))) u32x4_t*)(p + bj * HALF);
                        xv[mm][bj][0] = (f32x4){__builtin_bit_cast(float, w.x << 16), __builtin_bit_cast(float, w.x & 0xffff0000u), __builtin_bit_cast(float, w.y << 16), __builtin_bit_cast(float, w.y & 0xffff0000u)};
                        xv[mm][bj][1] = (f32x4){__builtin_bit_cast(float, w.z << 16), __builtin_bit_cast(float, w.z & 0xffff0000u), __builtin_bit_cast(float, w.w << 16), __builtin_bit_cast(float, w.w & 0xffff0000u)}; } } }
#pragma unroll
            for (int mm = 0; mm < 2; ++mm) { const int m = 2 * mh + mm; const float* g = gate + (size_t)mr[mm] * 6144 + col0; const float s = sc[ai][m];
                if (tok[ai][m] >= 0 && (s != 0.0f || sb[mm] != db[mm])) {
#pragma unroll
                    for (int bj = 0; bj < 2; ++bj) { f32x4 r[2];
#pragma unroll
                        for (int n = 0; n < 2; ++n) { const f32x4 gv = rowtok ? *(const f32x4*)(g + bj * HALF + 4 * n) : gu[bj][n];
                            r[n] = dry ? xv[mm][bj][n] : xv[mm][bj][n] + gv * s * acc[ai][bj][m][n]; }
                        if (df32) { __attribute__((address_space(1))) float* q = (__attribute__((address_space(1))) float*)db[mm] + ro[mm] + bj * HALF;
                            *((__attribute__((address_space(1))) f32x4*)q) = r[0]; *((__attribute__((address_space(1))) f32x4*)(q + 4)) = r[1]; }
                        else { u32x4_t w; w.x = cvt_pk_bf16(r[0].x, r[0].y); w.y = cvt_pk_bf16(r[0].z, r[0].w); w.z = cvt_pk_bf16(r[1].x, r[1].y); w.w = cvt_pk_bf16(r[1].z, r[1].w);
                            *((__attribute__((address_space(1))) u32x4_t*)((__attribute__((address_space(1))) bf16_t*)db[mm] + ro[mm] + bj * HALF)) = w; } } } }
          }
    }
};
struct EpiProj {
    static constexpr bool PERM = true, AFTER_DRAIN = false;
    bf16_t* P; bf16_t* HYT; int ldh; const float* qn; const float* kn; const float* ropeR; const float* ropeC;
    __device__ __forceinline__ void operator()(const f32x4 (&acc)[2][2][4][2], const Unit& u, int wr, int wc, int fr, int fq) const {
        if (u.pn >= 3) {
            bf16_t* O; int ldc, pn;
            if (u.pn >= 1024) { O = HYT; ldc = ldh; pn = u.pn - 1024; } else { O = P; ldc = 1536; pn = u.pn; }
            const int row0 = u.pm * BM + wr * 64 + fr; const int col0 = pn * BM + wc * 32 + 8 * fq;
#pragma unroll
            for (int ai = 0; ai < 2; ++ai)
#pragma unroll
                for (int m = 0; m < 4; ++m) { bf16_t* rowp = O + (size_t)(row0 + ai * HALF + m * 16) * ldc + col0;
#pragma unroll
                    for (int bj = 0; bj < 2; ++bj) { const f32x4 v0 = acc[ai][bj][m][0], v1 = acc[ai][bj][m][1];
                        u32x4 w; w.x = cvt_pk_bf16(v0[0], v0[1]); w.y = cvt_pk_bf16(v0[2], v0[3]); w.z = cvt_pk_bf16(v1[0], v1[1]); w.w = cvt_pk_bf16(v1[2], v1[3]);
                        *(u32x4*)(rowp + bj * HALF) = w; } }
            return;
        }
        const bool isq = u.pn < 2, isk = (u.pn == 2) && (wc < 2);
        const int colbase = u.pn * BM + wc * 64 + 16 * fq;
        const float* gsrc = isq ? qn : kn;
        f32x4 g[2][2];
#pragma unroll
        for (int bj = 0; bj < 2; ++bj)
#pragma unroll
            for (int n = 0; n < 2; ++n) g[bj][n] = *(const f32x4*)(gsrc + 32 * bj + 16 * n + 4 * fq);
        const float scl = isq ? 0.125f * 1.4426950408889634f : 1.0f;
#pragma unroll
        for (int ai = 0; ai < 2; ++ai)
#pragma unroll
            for (int m = 0; m < 4; ++m) { const int row = u.pm * BM + ai * HALF + wr * 64 + m * 16 + fr;
                f32x4 v[2][2];
#pragma unroll
                for (int bj = 0; bj < 2; ++bj)
#pragma unroll
                    for (int n = 0; n < 2; ++n) v[bj][n] = acc[ai][bj][m][n];
                if (isq || isk) {
                    float ss = 0.f;
#pragma unroll
                    for (int bj = 0; bj < 2; ++bj)
#pragma unroll
                        for (int n = 0; n < 2; ++n) ss += (v[bj][n][0] * v[bj][n][0] + v[bj][n][1] * v[bj][n][1]) + (v[bj][n][2] * v[bj][n][2] + v[bj][n][3] * v[bj][n][3]);
                    { const int ln_ = ::lane_now(); ss += ::shx(ss, 16, ln_); ss += ::shx(ss, 32, ln_); }
                    const float rstd = __builtin_amdgcn_rsqf(ss * (1.0f / 64.0f) + 1e-6f);
#pragma unroll
                    for (int bj = 0; bj < 2; ++bj)
#pragma unroll
                        for (int n = 0; n < 2; ++n) v[bj][n] = v[bj][n] * rstd * g[bj][n];
                    if (row < 65536) { const int t = row & 2047;
#pragma unroll
                        for (int bj = 0; bj < 2; ++bj) { const float* tb = (bj == 0 ? ropeR + (t >> 6) * 32 : ropeC + (t & 63) * 32) + 4 * fq;
                            const f32x4 cs = *(const f32x4*)tb, sn = *(const f32x4*)(tb + 16);
                            const f32x4 x1 = v[bj][0], x2 = v[bj][1]; v[bj][0] = x1 * cs - x2 * sn; v[bj][1] = x1 * sn + x2 * cs; } }
#pragma unroll
                    for (int bj = 0; bj < 2; ++bj)
#pragma unroll
                        for (int n = 0; n < 2; ++n) v[bj][n] = v[bj][n] * scl;
                }
                bf16_t* rowp = P + (size_t)row * 1536 + colbase;
#pragma unroll
                for (int bj = 0; bj < 2; ++bj) { u32x4 w; w.x = cvt_pk_bf16(v[bj][0][0], v[bj][0][1]); w.y = cvt_pk_bf16(v[bj][0][2], v[bj][0][3]); w.z = cvt_pk_bf16(v[bj][1][0], v[bj][1][1]); w.w = cvt_pk_bf16(v[bj][1][2], v[bj][1][3]);
                    *(u32x4*)(rowp + 8 * bj) = w; } }
    }
};
template <class Epi, class Sched, bool ALIGN_EPI = false, bool SP2 = false, bool GATHER = false>
__device__ __forceinline__ void gemm_phase(PG8_LAS unsigned char* lds, const Gemm g, const Sched& S, const Epi& E, const int tid) {
    const int wid = __builtin_amdgcn_readfirstlane(tid >> 6), lane = tid & 63, wr = wid >> 2, wc = wid & 3, fr = lane & 15, fq = lane >> 4;
    const int K = g.K, nt = K / BK;
    unsigned voffA[2], voffB[2];
#pragma unroll
    for (int i = 0; i < 2; ++i) { int R, C; stage_rc(tid * 16 + i * 8192, R, C); const int Rb = Epi::PERM ? ((R & ~31) + perm32(R & 31)) : R;
        voffA[i] = (unsigned)(R * K + C) * 2u; voffB[i] = (unsigned)(Rb * K + C) * 2u; }
    const size_t kstep = (size_t)(BK * 2);
    const size_t hstep = (size_t)HALF * K * 2;
    const size_t tstep = 2 * hstep;
    const unsigned ldsw = (unsigned)wid * 1024u;
    const int aoff = lds_byte(wr * 64 + fr, fq * 8), boff = lds_byte(wc * 32 + fr, fq * 8);
#define PG8_SA(b, h) (((b) * 2 + (h)) * HTB)
#define PG8_SB(b, h) ((4 + (b) * 2 + (h)) * HTB)
#define PG8_STAGE(bufoff, gbase, voff) do { _Pragma("unroll") for (int _i = 0; _i < 2; ++_i) \
        __builtin_amdgcn_global_load_lds((const unsigned*)((const char*)(gbase) + (voff)[_i]), (PG8_LAS unsigned*)(lds + (bufoff) + ldsw + _i * 8192), 16, 0, 0); } while (0)
#define PG8_STAGE_A(bufoff, base, h) do { if constexpr (GATHER) { PG8_STAGE(bufoff, base, gcur[h]); } else { PG8_STAGE(bufoff, (base) + ((h) ? hstep : 0), voffA); } } while (0)
#define PG8_GROWS(dst, unit) do { int _R, _C; stage_rc(tid * 16, _R, _C); u32x4 _o; \
        if (S.goff) _o = *(const u32x4*)(S.goff + (size_t)(unit).pm * BM + 4 * _R); else { const unsigned _b = (unsigned)((unit).pm * BM + _R) * (unsigned)(K * 2); const unsigned _s = 64u * (unsigned)(K * 2); _o = (u32x4){_b, _b + _s, _b + 2 * _s, _b + 3 * _s}; } \
        dst[0][0] = _o[0] + (unsigned)_C * 2u; dst[0][1] = _o[1] + (unsigned)_C * 2u; dst[1][0] = _o[2] + (unsigned)_C * 2u; dst[1][1] = _o[3] + (unsigned)_C * 2u; } while (0)
#define PG8_LDA(dst, b, h) do { _Pragma("unroll") for (int m = 0; m < 4; ++m) _Pragma("unroll") for (int k = 0; k < 2; ++k) dst[m][k] = *(const PG8_LAS bf16x8*)(lds + PG8_SA(b, h) + aoff + m * 2048 + k * 1024); } while (0)
#define PG8_LDB(dst, b, h) do { _Pragma("unroll") for (int n = 0; n < 2; ++n) _Pragma("unroll") for (int k = 0; k < 2; ++k) dst[n][k] = *(const PG8_LAS bf16x8*)(lds + PG8_SB(b, h) + boff + n * 2048 + k * 1024); } while (0)
#define PG8_MMA(ai, bj, At, Bt) do { __builtin_amdgcn_s_setprio(1); _Pragma("unroll") for (int m = 0; m < 4; ++m) _Pragma("unroll") for (int n = 0; n < 2; ++n) _Pragma("unroll") for (int k = 0; k < 2; ++k) \
        acc[ai][bj][m][n] = __builtin_amdgcn_mfma_f32_16x16x32_bf16(Bt[n][k], At[m][k], acc[ai][bj][m][n], 0, 0, 0); __builtin_amdgcn_s_setprio(0); } while (0)
#define PG8_WAIT_V(n) asm volatile("s_waitcnt vmcnt(" #n ")" ::: "memory")
#define PG8_WAIT_L(n) asm volatile("s_waitcnt lgkmcnt(" #n ")" ::: "memory")
#define PG8_BAR __builtin_amdgcn_s_barrier()
#define PG8_SCHED __builtin_amdgcn_sched_barrier(0)
    Unit cur, nxt; int ui = 0;
    if (!S.next(0, cur)) return;
    f32x4 acc[2][2][4][2];
#pragma unroll
    for (int a = 0; a < 2; ++a)
#pragma unroll
        for (int b = 0; b < 2; ++b)
#pragma unroll
            for (int m = 0; m < 4; ++m)
#pragma unroll
                for (int n = 0; n < 2; ++n) acc[a][b][m][n] = (f32x4){0.f, 0.f, 0.f, 0.f};
    bf16x8 At[4][2], B0[2][2], B1[2][2];
    const char* cA = GATHER ? (const char*)g.A : S.a_base(g, cur, tstep); const char* cB = S.b_base(g, cur, tstep);
    unsigned gcur[2][2];
    if constexpr (GATHER) { PG8_GROWS(gcur, cur); }
    S.a_ready(cur);
    if constexpr (SP2) {
        PG8_STAGE(PG8_SB(0, 0), cB, voffB); PG8_STAGE(PG8_SB(0, 1), cB + hstep, voffB); PG8_STAGE_A(PG8_SA(0, 0), cA, 0); PG8_STAGE_A(PG8_SA(0, 1), cA, 1);
        if (wr == 1) PG8_BAR;
        PG8_WAIT_V(2); PG8_BAR;
        PG8_STAGE(PG8_SB(1, 0), cB + kstep, voffB); PG8_STAGE_A(PG8_SA(1, 0), cA + kstep, 0); PG8_STAGE(PG8_SB(1, 1), cB + hstep + kstep, voffB);
        PG8_WAIT_V(6); PG8_BAR;
    } else {
        PG8_STAGE(PG8_SB(0, 0), cB, voffB); PG8_STAGE(PG8_SA(0, 0), cA, voffA); PG8_STAGE(PG8_SB(0, 1), cB + hstep, voffB); PG8_STAGE(PG8_SA(0, 1), cA + hstep, voffA);
        if (wr == 1) PG8_BAR;
        PG8_WAIT_V(4); PG8_BAR;
        PG8_STAGE(PG8_SB(1, 0), cB + kstep, voffB); PG8_STAGE(PG8_SA(1, 0), cA + kstep, voffA); PG8_STAGE(PG8_SB(1, 1), cB + hstep + kstep, voffB);
        PG8_WAIT_V(6); PG8_BAR;
    }
    for (;;) {
        const bool has_next = S.next(ui + 1, nxt);
        const char* nA = GATHER ? (const char*)g.A : (has_next ? S.a_base(g, nxt, tstep) : cA); const char* nB = has_next ? S.b_base(g, nxt, tstep) : cB;
        for (int t = 0; t < nt; t += 2) {
            const bool last = (t == nt - 2);
            const char* a1 = cA + (size_t)(t + 1) * kstep;
            const char* a2 = last ? nA : cA + (size_t)(t + 2) * kstep; const char* b2 = last ? nB : cB + (size_t)(t + 2) * kstep;
            const char* a3 = a2 + kstep; const char* b3 = b2 + kstep;
            if (last && has_next) S.a_ready(nxt);
            if constexpr (SP2) {
            PG8_LDB(B0, 0, 0); PG8_LDB(B1, 0, 1); PG8_SCHED; PG8_LDA(At, 0, 0); PG8_STAGE_A(PG8_SA(1, 1), a1, 1);
            if constexpr (GATHER) { if (last && has_next) PG8_GROWS(gcur, nxt); }
            PG8_WAIT_V(8); PG8_WAIT_L(0); PG8_BAR; PG8_MMA(0, 0, At, B0); PG8_MMA(0, 1, At, B1); PG8_BAR; PG8_SCHED;
            PG8_LDA(At, 0, 1); PG8_STAGE(PG8_SB(0, 0), b2, voffB); PG8_STAGE(PG8_SB(0, 1), b2 + hstep, voffB); PG8_STAGE_A(PG8_SA(0, 0), a2, 0);
            PG8_WAIT_V(8); PG8_WAIT_L(0); PG8_BAR; PG8_MMA(1, 0, At, B0); PG8_MMA(1, 1, At, B1); PG8_BAR; PG8_SCHED;
            PG8_LDB(B0, 1, 0); PG8_LDB(B1, 1, 1); PG8_SCHED; PG8_LDA(At, 1, 0); PG8_STAGE_A(PG8_SA(0, 1), a2, 1);
            PG8_WAIT_V(8); PG8_WAIT_L(0); PG8_BAR; PG8_MMA(0, 0, At, B0); PG8_MMA(0, 1, At, B1); PG8_BAR; PG8_SCHED;
            PG8_LDA(At, 1, 1); PG8_STAGE(PG8_SB(1, 0), b3, voffB); PG8_STAGE(PG8_SB(1, 1), b3 + hstep, voffB); PG8_STAGE_A(PG8_SA(1, 0), a3, 0);
            PG8_WAIT_V(8); PG8_WAIT_L(0); PG8_BAR; PG8_MMA(1, 0, At, B0); PG8_MMA(1, 1, At, B1); PG8_BAR; PG8_SCHED;
            } else {
            PG8_LDB(B0, 0, 0); PG8_SCHED; PG8_LDA(At, 0, 0); PG8_STAGE(PG8_SA(1, 1), a1 + hstep, voffA);
            PG8_WAIT_L(8); PG8_BAR; PG8_WAIT_L(0); PG8_MMA(0, 0, At, B0); PG8_BAR; PG8_SCHED;
            PG8_LDB(B1, 0, 1); PG8_STAGE(PG8_SB(0, 0), b2, voffB);
            PG8_BAR; PG8_WAIT_L(0); PG8_MMA(0, 1, At, B1); PG8_BAR;
            PG8_LDA(At, 0, 1); PG8_STAGE(PG8_SA(0, 0), a2, voffA);
            PG8_BAR; PG8_WAIT_L(0); PG8_MMA(1, 0, At, B0); PG8_BAR; PG8_SCHED;
            PG8_STAGE(PG8_SB(0, 1), b2 + hstep, voffB);
            PG8_WAIT_V(6); PG8_BAR; PG8_MMA(1, 1, At, B1); PG8_BAR;
            PG8_LDB(B0, 1, 0); PG8_SCHED; PG8_LDA(At, 1, 0); PG8_STAGE(PG8_SA(0, 1), a2 + hstep, voffA);
            PG8_WAIT_L(8); PG8_BAR; PG8_WAIT_L(0); PG8_MMA(0, 0, At, B0); PG8_BAR; PG8_SCHED;
            PG8_LDB(B1, 1, 1); PG8_STAGE(PG8_SB(1, 0), b3, voffB);
            PG8_BAR; PG8_WAIT_L(0); PG8_MMA(0, 1, At, B1); PG8_BAR;
            PG8_LDA(At, 1, 1); PG8_STAGE(PG8_SA(1, 0), a3, voffA);
            PG8_BAR; PG8_WAIT_L(0); PG8_MMA(1, 0, At, B0); PG8_BAR; PG8_SCHED;
            PG8_STAGE(PG8_SB(1, 1), b3 + hstep, voffB);
            PG8_WAIT_V(6); PG8_BAR; PG8_MMA(1, 1, At, B1); PG8_BAR;
            }
        }
        if constexpr (ALIGN_EPI) { if (wr == 0) PG8_BAR; }
        if constexpr (!Epi::AFTER_DRAIN) { E(acc, cur, wr, wc, fr, fq); S.done(cur); }
        if (!has_next) break;
#pragma unroll
        for (int a = 0; a < 2; ++a)
#pragma unroll
            for (int b = 0; b < 2; ++b)
#pragma unroll
                for (int m = 0; m < 4; ++m)
#pragma unroll
                    for (int n = 0; n < 2; ++n) acc[a][b][m][n] = (f32x4){0.f, 0.f, 0.f, 0.f};
        cur = nxt; cA = nA; cB = nB; ++ui;
        if constexpr (ALIGN_EPI) { if (wr == 1) PG8_BAR; }
    }
    PG8_WAIT_V(0);
    if constexpr (!ALIGN_EPI) { if (wr == 0) PG8_BAR; }
    PG8_BAR;
    if constexpr (Epi::AFTER_DRAIN) { E.fused(acc, cur, wr, wc, fr, fq, lds, wid, lane); S.done(cur); }
#undef PG8_SA
#undef PG8_SB
#undef PG8_STAGE
#undef PG8_STAGE_A
#undef PG8_GROWS
#undef PG8_LDA
#undef PG8_LDB
#undef PG8_MMA
#undef PG8_WAIT_V
#undef PG8_WAIT_L
#undef PG8_BAR
#undef PG8_SCHED
}
}

#ifndef PG8_SP2
#define PG8_SP2 true
#endif
#ifndef PG8_ALIGN
#define PG8_ALIGN true
#endif

constexpr int D = 1024, NB = 32, SEQ = 2048, CTXL = 256, DEPTH = 4;
constexpr int TLAT = NB * SEQ, TCTX = NB * CTXL, TT = TLAT + TCTX;
constexpr int PROJ_W = 2312, PW = 1536, WROWS = 2304;
constexpr int FF = 2816, NEXP = 8;
constexpr float EPS = 1e-6f;
constexpr int PC_Q = 0, PC_K = 512, PC_V = 640, PC_Z = 768, PC_XBC = 1024;

constexpr size_t MiB = 1u << 20;
constexpr size_t WS_CTL = 0, CTL_ZERO_BYTES = 1 * MiB;
constexpr size_t WS_SILUC = 1 * MiB;
constexpr size_t WS_MOD = 2 * MiB;
constexpr size_t WS_DT = 6 * MiB;
constexpr size_t WS_COMB = 9 * MiB;
constexpr size_t WS_FILT = 12 * MiB;
constexpr size_t WS_FILTC = 20 * MiB;
constexpr size_t WS_ROPE = 22 * MiB - 64 * 1024;
constexpr size_t WS_ROWTOK = 21 * MiB;
constexpr size_t WS_ROWW = 21 * MiB + 512 * 1024;
constexpr size_t WS_ROWTOK1 = 12 * MiB, WS_ROWW1 = 12 * MiB + 512 * 1024;
constexpr size_t WS_GOFF = 13 * MiB, WS_GOFF1 = 13 * MiB + 512 * 1024;
constexpr size_t WS_WIN = 22 * MiB;
constexpr size_t WS_WOUT = 27 * MiB;
constexpr size_t WS_F1 = 29 * MiB;
constexpr size_t WS_F2 = 117 * MiB;
constexpr size_t WS_XC = 161 * MiB;
constexpr size_t WS_XR = 805 * MiB;
constexpr size_t WS_A = 193 * MiB;
constexpr size_t WS_PROJ = 337 * MiB;
constexpr size_t WS_HID = 337 * MiB;
constexpr size_t WS_ATT = 661 * MiB;
constexpr size_t WS_SSDY = 733 * MiB;
constexpr size_t WS_HYOT = 805 * MiB;
constexpr size_t WS_HYT = 841 * MiB;
constexpr size_t WS_FILTB = 953 * MiB;
constexpr size_t WS_FILTCB = 969 * MiB;
constexpr size_t WS_AS = 805 * MiB;
constexpr size_t WS_END = 985 * MiB;
constexpr int MROWS = TT + 2048;
static_assert(WS_HID + (size_t)MROWS * FF * 2 <= WS_HYOT && WS_AS + (size_t)MROWS * D * 2 <= WS_FILTB && WS_HYT + (size_t)768 * TT * 2 <= WS_FILTB, "hidden / sorted overlays");
constexpr int CW_BAR = 4096;
constexpr int CW_GCNT = 4096 + 3 * 3456;
constexpr int CW_WQ = 4096 + 3 * 3456 + 256;
constexpr int CW_BB = 16384;

constexpr int NWAVES = 8, NTHR = 512;
constexpr int LDS_BYTES = 155648;
constexpr int MISC_OFF = 151 * 1024;

#define GAS __attribute__((address_space(1)))
#define LAS __attribute__((address_space(3)))
#define CAS __attribute__((address_space(4)))
typedef unsigned short bf16;
typedef unsigned v4u __attribute__((ext_vector_type(4)));
typedef unsigned v2u __attribute__((ext_vector_type(2)));
typedef float f32x4 __attribute__((ext_vector_type(4)));
typedef short bf16x8 __attribute__((ext_vector_type(8)));
typedef float f32x16 __attribute__((ext_vector_type(16)));
#define HY_MFMA(a, b, c) __builtin_amdgcn_mfma_f32_32x32x16_bf16((a), (b), (c), 0, 0, 0)
#define LDS_WAIT() asm volatile("s_waitcnt lgkmcnt(0)" ::: "memory")
__device__ __forceinline__ unsigned f2bf(float f) { unsigned u = __builtin_bit_cast(unsigned, f); return (u + 0x7fffu + ((u >> 16) & 1u)) >> 16; }
__device__ __forceinline__ unsigned pk2(float lo, float hi) { unsigned r; asm("v_cvt_pk_bf16_f32 %0, %1, %2" : "=v"(r) : "v"(lo), "v"(hi)); return r; }
__device__ __forceinline__ float bf2f(unsigned short b) { return __builtin_bit_cast(float, ((unsigned)b) << 16); }
__device__ __forceinline__ float bflo(unsigned w) { return __builtin_bit_cast(float, w << 16); }
__device__ __forceinline__ float bfhi(unsigned w) { return __builtin_bit_cast(float, w & 0xffff0000u); }
#define DPP_ADD(v, ctrl) ((v) + __builtin_bit_cast(float, __builtin_amdgcn_mov_dpp(__builtin_bit_cast(int, (v)), (ctrl), 0xF, 0xF, true)))
__device__ __forceinline__ float row16_sum(float v) {
    v = DPP_ADD(v, 0xB1);
    v = DPP_ADD(v, 0x4E);
    v = DPP_ADD(v, 0x141);
    v = DPP_ADD(v, 0x140);
    return v;
}
__device__ __forceinline__ float wave_sum(float v) {
    v = row16_sum(v);
    { const auto rr = __builtin_amdgcn_permlane16_swap(__float_as_uint(v), __float_as_uint(v), false, false); v = __uint_as_float(rr[0]) + __uint_as_float(rr[1]); }
    { const auto rr = __builtin_amdgcn_permlane32_swap(__float_as_uint(v), __float_as_uint(v), false, false); v = __uint_as_float(rr[0]) + __uint_as_float(rr[1]); }
    return v;
}
__device__ __forceinline__ float silu(float v) { return v / (1.0f + __expf(-v)); }
__device__ __forceinline__ float silu_fast(float v) { return v * __builtin_amdgcn_rcpf(1.0f + __builtin_amdgcn_exp2f(-1.4426950408889634f * v)); }

#define XB_TMO      128
#define XB_XCNT(j)  (256  + 64 * (j))
#define XB_XSUB(j)  (1280 + 64 * (j))
#define XB_XGEN(j)  (2304 + 64 * (j))
#define XB_TOP      3328
#define XB_TOPGEN   3392
#define XCD_BAR_WORDS 3456
#define XB_SPIN_CAP (1u << 20)
__device__ __forceinline__ unsigned xb_ld(unsigned* p)              { return __hip_atomic_load(p, __ATOMIC_RELAXED, __HIP_MEMORY_SCOPE_AGENT); }
__device__ __forceinline__ unsigned xb_add(unsigned* p, unsigned v) { return __hip_atomic_fetch_add(p, v, __ATOMIC_RELAXED, __HIP_MEMORY_SCOPE_AGENT); }
__device__ __forceinline__ unsigned xb_xcc_id() { return (unsigned)__builtin_amdgcn_s_getreg((3 << 11) | 20) & 0xFu; }
#define XB_SPIN(cond, bar) do { unsigned _sp = 0; while (cond) { __builtin_amdgcn_s_sleep(1); \
    if ((++_sp & 255u) == 0u) { if (xb_ld(&(bar)[XB_TMO])) break; if (_sp > XB_SPIN_CAP) { atomicAdd(&(bar)[XB_TMO], 1u); break; } } } } while (0)
struct XcdBarrier { unsigned* bar; unsigned x; volatile LAS unsigned* st; int wv; };
__device__ __forceinline__ XcdBarrier xcd_barrier_post(unsigned* bar, volatile LAS unsigned* st) {
    XcdBarrier b; b.bar = bar; b.x = xb_xcc_id(); b.st = st;
    if (threadIdx.x == 0) (void)xb_add(&bar[XB_XCNT(b.x)], 1u);
    return b;
}
__device__ __forceinline__ void xcd_barrier_complete(unsigned* bar, unsigned x, unsigned& nloc, unsigned& nx) {
    const unsigned G = gridDim.x * gridDim.y * gridDim.z;
    unsigned sum, cnt, mine, sp = 0u;
    for (;;) {
        sum = 0u; cnt = 0u; mine = 0u;
#pragma unroll
        for (unsigned j = 0; j < 16; ++j) { const unsigned c = xb_ld(&bar[XB_XCNT(j)]); sum += c; cnt += (c > 0u) ? 1u : 0u; mine = (j == x) ? c : mine; }
        if (sum == G) break;
        __builtin_amdgcn_s_sleep(1);
        if ((++sp & 255u) == 0u) { if (xb_ld(&bar[XB_TMO])) break; if (sp > XB_SPIN_CAP) { atomicAdd(&bar[XB_TMO], 1u); break; } }
    }
    nloc = mine > 0u ? mine : 1u; nx = cnt > 0u ? cnt : 1u;
}
__device__ __forceinline__ void xcd_barrier(const XcdBarrier& b) {
    asm volatile("s_waitcnt vmcnt(0)" ::: "memory");
    __syncthreads();
    int l0_; asm volatile("v_mbcnt_lo_u32_b32 %0, -1, 0\n\tv_mbcnt_hi_u32_b32 %0, -1, %0" : "=v"(l0_));
    if (b.wv == 0 && l0_ == 0) {
        unsigned* bar = b.bar;
        __builtin_amdgcn_s_waitcnt(0);
        unsigned nloc = b.st[0], nx = b.st[1];
        if (nloc == 0u) { xcd_barrier_complete(bar, b.x, nloc, nx); b.st[0] = nloc; b.st[1] = nx; }
        const unsigned old = xb_add(&bar[XB_XSUB(b.x)], 1u);
        const unsigned gen = old / nloc;
        if (old + 1u == (gen + 1u) * nloc) {
            __builtin_amdgcn_fence(__ATOMIC_RELEASE, "agent");
            asm volatile("s_waitcnt vmcnt(0)" ::: "memory");
            const unsigned og = xb_add(&bar[XB_TOP], 1u);
            const unsigned tg = og / nx;
            if (og + 1u == (tg + 1u) * nx) xb_add(&bar[XB_TOPGEN], 1u);
            else XB_SPIN(xb_ld(&bar[XB_TOPGEN]) == tg, bar);
            __builtin_amdgcn_fence(__ATOMIC_ACQUIRE, "agent");
            xb_add(&bar[XB_XGEN(b.x)], 1u);
            asm volatile("s_waitcnt vmcnt(0)" ::: "memory");
        } else {
            XB_SPIN(xb_ld(&bar[XB_XGEN(b.x)]) == gen, bar);
            __builtin_amdgcn_fence(__ATOMIC_ACQUIRE, "agent");
            asm volatile("s_waitcnt vmcnt(0)" ::: "memory");
        }
    }
    __syncthreads();
}

struct Args { const float* in[38]; float* out; unsigned char* ws; int ph_lo, ph_hi, pad0, pad1; };
enum { I_X = 0, I_C, I_CTX, I_CCTX, I_WADA, I_BADA, I_NORM1, I_NORM2, I_WIN, I_WOUT, I_QNORM, I_KNORM, I_SINKS, I_ATTON, I_SCW, I_SCB, I_SDTB, I_SALOG, I_SD, I_SNORM,
       I_HCW, I_HCB, I_HW1, I_HB1, I_HF1, I_HW2, I_HB2, I_HF2, I_HW3, I_HBIAS, I_HON, I_FG, I_FU, I_FD, I_MR, I_MG, I_MU, I_MD };

struct Ctx {
    const float* const CAS* in; float* out; unsigned char* ws; LAS unsigned char* lds;
    int tid, lane, wave, bid, G, dry;
};
#define WSP(type, off) ((type*)(C.ws + (off)))

__device__ __forceinline__ void phase_siluc(const Ctx& C) {
    float* sc = WSP(float, WS_SILUC);
    for (int i = C.bid * NTHR + C.tid; i < 33 * 1024; i += C.G * NTHR) {
        const int r = i >> 10, k = i & 1023; const float v = (r < 32) ? C.in[I_C][r * 1024 + k] : C.in[I_CCTX][k];
        sc[i] = silu(v);
    }
    float* rp = WSP(float, WS_ROPE);
    for (int i = C.bid * NTHR + C.tid; i < 96 * 16; i += C.G * NTHR) { const int pos = i >> 4, f = i & 15;
        const float inv = powf(10000.0f, -(float)(2 * f) / 32.0f); const float ang = (float)(pos < 32 ? pos : pos - 32) * inv;
        rp[pos * 32 + f] = cosf(ang); rp[pos * 32 + 16 + f] = sinf(ang); }
}

template <class SRC>
__device__ __forceinline__ void conv_item(const SRC& S, int K, int ld, bf16* WT, LAS float* scr, int item, int nblk, int lane) {
    const int kb = item / nblk, nb = item % nblk, k0 = 64 * kb;
    const float* sp; int col; const int myrow = S.row(nb, lane); S(myrow, sp, col);
    float tmp[64];
#pragma unroll
    for (int i = 0; i < 64; ++i) tmp[i] = sp[(size_t)(k0 + i) * ld + col];
#pragma unroll
    for (int i = 0; i < 64; ++i) scr[i * 65 + lane] = tmp[i];
    LDS_WAIT(); asm volatile("" ::: "memory");
    const int c = lane & 7;
#pragma unroll
    for (int j = 0; j < 8; ++j) { const int n = (lane >> 3) + 8 * j; const LAS float* s = scr + (8 * c) * 65 + n;
        v4u o; o.x = pk2(s[0 * 65], s[1 * 65]); o.y = pk2(s[2 * 65], s[3 * 65]); o.z = pk2(s[4 * 65], s[5 * 65]); o.w = pk2(s[6 * 65], s[7 * 65]);
        *(v4u*)(WT + (size_t)S.row(nb, n) * K + k0 + 8 * c) = o; }
    LDS_WAIT(); asm volatile("" ::: "memory");
}
struct SrcWin { const float* w; __device__ __forceinline__ int row(int nb, int l) const { return 64 * nb + l; }
    __device__ __forceinline__ void operator()(int rho, const float*& p, int& col) const { p = w;
    if (rho >= 1536) col = rho + 8; else if (rho >= 768) col = rho; else {
        const int pn = rho >> 8, r = rho & 255, bj = r >> 7, wc = (r >> 5) & 3, fq = (r >> 3) & 3, n = (r >> 2) & 1, e = r & 3;
        col = pn * 256 + wc * 64 + ((pn == 2 && wc >= 2) ? (16 * fq + 8 * bj + 4 * n + e) : (32 * bj + 16 * n + 4 * fq + e)); } } };
struct SrcPlain { const float* w; __device__ __forceinline__ int row(int nb, int l) const { return 64 * nb + l; }
    __device__ __forceinline__ void operator()(int rho, const float*& p, int& col) const { p = w; col = rho; } };
struct SrcGU { const float* g; const float* u;
    __device__ __forceinline__ int row(int nb, int l) const { return 256 * (nb >> 2) + 128 * (l >> 5) + 32 * (nb & 3) + (l & 31); }
    __device__ __forceinline__ void operator()(int rho, const float*& p, int& col) const {
    const int pn = rho >> 8, r = rho & 255, bj = r >> 7, wc = (r >> 5) & 3, fq = (r >> 3) & 3, n = (r >> 2) & 1, e = r & 3;
    p = (const float*)((const char*)g + (long)n * ((const char*)u - (const char*)g)); col = 128 * pn + 32 * wc + 8 * fq + 4 * bj + e; } };

__device__ __forceinline__ void hy_filter_item(const Ctx& C, int layer, int item) {
    const bool lat = item < 64; const int L = lat ? 2048 : 256; const int pos0 = 32 * (lat ? item : item - 64);
    LAS float* z = (LAS float*)C.lds;
    LAS float* h1 = z + 32 * 33;
    LAS float* h2 = h1 + 32 * 64;
    const float* w1 = C.in[I_HW1] + (size_t)layer * 33 * 64; const float* b1 = C.in[I_HB1] + layer * 64; const float* f1 = C.in[I_HF1] + layer * 64;
    const float* w2 = C.in[I_HW2] + (size_t)layer * 64 * 64; const float* b2 = C.in[I_HB2] + layer * 64; const float* f2 = C.in[I_HF2] + layer * 64;
    const float* w3 = C.in[I_HW3] + (size_t)layer * 64 * 1024; const float* hb = C.in[I_HBIAS] + (size_t)layer * 512;
    __syncthreads();
    for (int t = C.tid; t < 32 * 33; t += NTHR) { const int p = t / 33, j = t % 33; const int i = pos0 + p;
        const float tt = (float)i / (float)(L - 1); const float wv = (6.283185307179586f / (float)L) * (float)i;
        float v;
        if (j == 0) v = tt;
        else { const int jj = (j - 1) & 15; const float fr = 1e-4f + (float)jj * ((15.0f - 1e-4f) / 15.0f); const float a = fr * wv; v = (j <= 16) ? cosf(a) : -sinf(a); }
        z[p * 33 + j] = v; }
    __syncthreads();
    {
        const int k = C.tid & 63, p0 = C.tid >> 6;
        { float wc[33];
#pragma unroll
          for (int j = 0; j < 33; ++j) wc[j] = w1[j * 64 + k];
          const float bb = b1[k], ff = f1[k];
#pragma unroll 1
          for (int i = 0; i < 4; ++i) { const int p = p0 + 8 * i; float s = bb;
#pragma unroll
              for (int j = 0; j < 33; ++j) s += z[p * 33 + j] * wc[j];
              h1[p * 64 + k] = sinf(ff * s); } }
        __syncthreads();
        { float wd[64];
#pragma unroll
          for (int j = 0; j < 64; ++j) wd[j] = w2[j * 64 + k];
          const float bb = b2[k], ff = f2[k];
#pragma unroll 1
          for (int i = 0; i < 4; ++i) { const int p = p0 + 8 * i; float s = bb;
#pragma unroll
              for (int j = 0; j < 64; ++j) s += h1[p * 64 + j] * wd[j];
              h2[p * 64 + k] = sinf(ff * s); } }
    }
    __syncthreads();
    const float dmin = -3.0701134573253946f, dmax = -15.350567286626973f;
    bf16* FL = lat ? WSP(bf16, WS_FILTB) + (size_t)layer * 512 * 4096 : WSP(bf16, WS_FILTCB) + (size_t)layer * 512 * 512; const int FS = lat ? 4096 : 512;
    {
        const int o = C.tid;
        float a0[32], a1[32];
#pragma unroll
        for (int p = 0; p < 32; ++p) { a0[p] = 0.f; a1[p] = 0.f; }
#pragma unroll 2
        for (int j0 = 0; j0 < 64; j0 += 4) {
            const float wa = w3[j0 * 1024 + o], wb = w3[(j0 + 1) * 1024 + o], wc_ = w3[(j0 + 2) * 1024 + o], wd_ = w3[(j0 + 3) * 1024 + o];
            const float xa = w3[j0 * 1024 + o + 512], xb = w3[(j0 + 1) * 1024 + o + 512], xc_ = w3[(j0 + 2) * 1024 + o + 512], xd_ = w3[(j0 + 3) * 1024 + o + 512];
#pragma unroll
            for (int p = 0; p < 32; ++p) { const f32x4 hv = *(const LAS f32x4*)(h2 + p * 64 + j0);
                a0[p] += (hv.x * wa + hv.y * wb) + (hv.z * wc_ + hv.w * wd_); a1[p] += (hv.x * xa + hv.y * xb) + (hv.z * xc_ + hv.w * xd_); } }
        const int order = (o >> 8) & 1, c = o & 255;
        const float delta = fabsf(dmin + (float)c * ((dmax - dmin) / 255.0f));
        bf16* fo = FL + ((size_t)order * 256 + c) * FS;
#pragma unroll
        for (int p = 0; p < 32; ++p) { const float dec = expf(-((float)(pos0 + p) / (float)(L - 1)) * delta); a0[p] *= dec; a1[p] *= dec; }
        if (pos0 == 0) a0[0] += hb[order * 256 + c];
        { v4u* d = (v4u*)(fo + (L - 32 - pos0));
#pragma unroll
          for (int q = 0; q < 4; ++q) { v4u w; w.x = pk2(a0[31 - 8 * q], a0[30 - 8 * q]); w.y = pk2(a0[29 - 8 * q], a0[28 - 8 * q]); w.z = pk2(a0[27 - 8 * q], a0[26 - 8 * q]); w.w = pk2(a0[25 - 8 * q], a0[24 - 8 * q]); d[q] = w; } }
        { bf16* b = fo + (L - 1) + pos0;
          if (pos0 > 0) b[0] = (bf16)f2bf(a1[0]);
#pragma unroll
          for (int q = 0; q < 15; ++q) *(unsigned*)(b + 1 + 2 * q) = pk2(a1[1 + 2 * q], a1[2 + 2 * q]);
          b[31] = (bf16)f2bf(a1[31]); }
    }
    __syncthreads();
}

__device__ __forceinline__ void conv_block_load(f32x4 (&v)[16], const float* W, int ld, int k0, int c0, int tid) {
#pragma unroll
    for (int j = 0; j < 16; ++j) { const int kr = (tid >> 6) + 8 * j; v[j] = *(const f32x4*)(W + (size_t)(k0 + kr) * ld + c0 + 4 * (tid & 63)); }
}
constexpr int CB_PITCH = 520;
__device__ __forceinline__ void conv_block_tile(const Ctx& C, const f32x4 (&v)[16]) {
    const int tid = C.tid;
#pragma unroll
    for (int j = 0; j < 16; ++j) { const int kr = (tid >> 6) + 8 * j; v2u o; o.x = pk2(v[j].x, v[j].y); o.y = pk2(v[j].z, v[j].w); *(LAS v2u*)(C.lds + kr * CB_PITCH + 8 * (tid & 63)) = o; }
    __syncthreads();
}
template <class DST>
__device__ __forceinline__ void conv_block_out(const Ctx& C, int K, int k0, int c0, bf16* WT, const DST& dst) {
    const int tid = C.tid, n = tid & 255, half = tid >> 8;
    bf16* orow = WT + (size_t)dst(c0 + n) * K + k0 + 64 * half;
#pragma unroll
    for (int c = 0; c < 8; ++c) { unsigned short e[8];
#pragma unroll
        for (int i = 0; i < 8; ++i) e[i] = *(const LAS unsigned short*)(C.lds + (64 * half + 8 * c + i) * CB_PITCH + 2 * n);
        v4u o; o.x = e[0] | ((unsigned)e[1] << 16); o.y = e[2] | ((unsigned)e[3] << 16); o.z = e[4] | ((unsigned)e[5] << 16); o.w = e[6] | ((unsigned)e[7] << 16);
        *(v4u*)(orow + 8 * c) = o; }
    __syncthreads();
}
struct DstPlain { __device__ __forceinline__ int operator()(int c) const { return c; } };
struct DstGU { int n; __device__ __forceinline__ int operator()(int hid) const { const int pn = hid >> 7, r = hid & 127, wc = r >> 5, fq = (r >> 3) & 3, bj = (r >> 2) & 1, e = r & 3;
    return 256 * pn + 128 * bj + 32 * wc + 8 * fq + 4 * n + e; } };
__device__ __forceinline__ void phase_pre(const Ctx& C, int layer) {
    LAS float* scr = (LAS float*)(C.lds + C.wave * 16640);
    const bool moe = layer & 1; const int j2 = layer >> 1;
    const int ne = moe ? NEXP : 1;
    unsigned* heads = (unsigned*)(C.ws + WS_CTL) + CW_WQ + 8 * C.dry;
    volatile LAS int* bcast = (volatile LAS int*)(C.lds + MISC_OFF + 64);
    __syncthreads();
    {
        const int nit = ne * 264;
        f32x4 v[16];
        int it, itn;
#define CB_DECODE(IT, W_, LD_, K_, K0_, C0_, WT_, NSEL_, ISGU_) do { const int _e = (IT) / 264; int _r = (IT) % 264; const float *wg, *wu, *wd; \
            if (moe) { const size_t o = ((size_t)j2 * NEXP + _e) * (size_t)D * FF; wg = C.in[I_MG] + o; wu = C.in[I_MU] + o; wd = C.in[I_MD] + o; } \
            else { const size_t o = (size_t)j2 * D * FF; wg = C.in[I_FG] + o; wu = C.in[I_FU] + o; wd = C.in[I_FD] + o; } \
            if (_r < 176) { NSEL_ = _r / 88; _r %= 88; ISGU_ = true; W_ = NSEL_ ? wu : wg; LD_ = FF; K_ = D; K0_ = 128 * (_r / 11); C0_ = 256 * (_r % 11); WT_ = WSP(bf16, WS_F1) + (size_t)_e * 2 * FF * D; } \
            else { _r -= 176; NSEL_ = 0; ISGU_ = false; W_ = wd; LD_ = D; K_ = FF; K0_ = 128 * (_r / 4); C0_ = 256 * (_r % 4); WT_ = WSP(bf16, WS_F2) + (size_t)_e * D * FF; } } while (0)
#define CB_POP(DSTV) do { if (C.tid == 0) bcast[0] = (int)__hip_atomic_fetch_add(heads + 4 + layer, 1u, __ATOMIC_RELAXED, __HIP_MEMORY_SCOPE_AGENT); __syncthreads(); DSTV = bcast[0]; __syncthreads(); } while (0)
        CB_POP(it);
        const float* W = nullptr; int ld = 0, K = 0, k0 = 0, c0 = 0, nsel = 0; bool isgu = false; bf16* WT = nullptr;
        if (it < nit) { CB_DECODE(it, W, ld, K, k0, c0, WT, nsel, isgu); conv_block_load(v, W, ld, k0, c0, C.tid); }
        while (it < nit) {
            conv_block_tile(C, v);
            CB_POP(itn);
            const float* Wn = nullptr; int ldn = 0, Kn = 0, k0n = 0, c0n = 0, nseln = 0; bool isgun = false; bf16* WTn = nullptr;
            if (itn < nit) { CB_DECODE(itn, Wn, ldn, Kn, k0n, c0n, WTn, nseln, isgun); conv_block_load(v, Wn, ldn, k0n, c0n, C.tid); }
            if (isgu) { const DstGU d{nsel}; conv_block_out(C, K, k0, c0, WT, d); } else { const DstPlain d{}; conv_block_out(C, K, k0, c0, WT, d); }
            it = itn; W = Wn; ld = ldn; K = Kn; k0 = k0n; c0 = c0n; WT = WTn; nsel = nseln; isgu = isgun;
        }
#undef CB_DECODE
#undef CB_POP
    }
    {
        const SrcWin s_in{C.in[I_WIN] + (size_t)layer * D * PROJ_W};
        const SrcPlain s_out{C.in[I_WOUT] + (size_t)layer * D * D};
        constexpr int I_IN = 16 * (WROWS / 64), I_OUT = 16 * 16;
        for (;;) {
            int it = 0; if (C.lane == 0) it = (int)__hip_atomic_fetch_add(heads + layer, 1u, __ATOMIC_RELAXED, __HIP_MEMORY_SCOPE_AGENT);
            it = __builtin_amdgcn_readfirstlane(it);
            if (it >= I_IN + I_OUT) break;
            if (it < I_IN) conv_item(s_in, D, PROJ_W, WSP(bf16, WS_WIN), scr, it, WROWS / 64, C.lane);
            else conv_item(s_out, D, D, WSP(bf16, WS_WOUT), scr, it - I_IN, 16, C.lane);
        }
    }
    __syncthreads();
}
__device__ __forceinline__ void mod_task(const Ctx& C, int layer, int grp) {
    const float* sc = WSP(float, WS_SILUC); const float* wa = C.in[I_WADA] + (size_t)layer * D * 6144; const float* ba = C.in[I_BADA] + (size_t)layer * 6144;
    float* mod = WSP(float, WS_MOD) + (size_t)layer * 33 * 6144;
    LAS float* part = (LAS float*)C.lds;
    LAS float* SL = (LAS float*)C.lds + C.wave * (33 * 128);
    const int n = grp * 128 + C.lane; float acc[2][33];
    const int k0 = C.wave * 128;
    __syncthreads();
    for (int i = C.lane; i < 33 * 32; i += 64) { const int r = i >> 5, c4 = i & 31; *(LAS f32x4*)(SL + r * 128 + 4 * c4) = *(const f32x4*)(sc + r * 1024 + k0 + 4 * c4); }
#pragma unroll
    for (int r = 0; r < 33; ++r) { acc[0][r] = 0.f; acc[1][r] = 0.f; }
    asm volatile("s_waitcnt vmcnt(0) lgkmcnt(0)" ::: "memory");
    for (int kk = 0; kk < 128; kk += 8) { float w[2][8];
#pragma unroll
        for (int u = 0; u < 8; ++u) { w[0][u] = wa[(size_t)(k0 + kk + u) * 6144 + n]; w[1][u] = wa[(size_t)(k0 + kk + u) * 6144 + n + 64]; }
#pragma unroll
        for (int r = 0; r < 33; ++r) { const f32x4 s0 = *(const LAS f32x4*)(SL + r * 128 + kk), s1 = *(const LAS f32x4*)(SL + r * 128 + kk + 4);
#pragma unroll
            for (int c = 0; c < 2; ++c)
                acc[c][r] += (s0.x * w[c][0] + s0.y * w[c][1]) + (s0.z * w[c][2] + s0.w * w[c][3]) + (s1.x * w[c][4] + s1.y * w[c][5]) + (s1.z * w[c][6] + s1.w * w[c][7]); } }
    __syncthreads();
#pragma unroll
    for (int r = 0; r < 33; ++r) { part[(C.wave * 33 + r) * 128 + C.lane] = acc[0][r]; part[(C.wave * 33 + r) * 128 + 64 + C.lane] = acc[1][r]; }
    __syncthreads();
    for (int o = C.tid; o < 33 * 128; o += NTHR) { const int r = o >> 7, l = o & 127; float s = ba[grp * 128 + l];
#pragma unroll
        for (int w = 0; w < 8; ++w) s += part[(w * 33 + r) * 128 + l];
        mod[(size_t)r * 6144 + grp * 128 + l] = s; }
    __syncthreads();
}
__device__ __forceinline__ void phase_setup(const Ctx& C) {
    for (int t = C.bid; t < 4 * 120; t += C.G) { const int layer = t / 120, r = t % 120;
#if defined(PROBE_SETUP_ONLY)
        if (C.dry && ((PROBE_SETUP_ONLY == 0) != (r < 48))) continue;
#endif
        if (r < 48) mod_task(C, layer, r); else hy_filter_item(C, layer, r - 48); }
    __syncthreads();
}

__device__ __forceinline__ const float* norm_row_ptr_f32(const Ctx& C, int m) { return m < TLAT ? C.in[I_X] + (size_t)m * D : C.in[I_CTX] + (size_t)(m - TLAT) * D; }
__device__ __forceinline__ const bf16* norm_row_ptr_bf(const Ctx& C, int m) { return m < TLAT ? (const bf16*)C.out + (size_t)m * D : WSP(bf16, WS_XC) + (size_t)(m - TLAT) * D; }
__device__ __forceinline__ void phase_norm(const Ctx& C, int layer, int which) {
    LAS int* lcnt = (LAS int*)(C.lds + 32768);
    if (C.tid < 16) lcnt[C.tid] = 0;
    const bool moe = layer & 1; const bool need_extra = (which == 0) || moe;
    __syncthreads();
    const int lane = C.lane;
    f32x4 wlo[4][4], whi[4][4];
#pragma unroll
    for (int j = 0; j < 4; ++j)
#pragma unroll
        for (int e = 0; e < 4; ++e) { const int k = 8 * lane + 512 * (j >> 1) + 4 * (j & 1) + e;
            if (need_extra) {
                if (which == 0) { const float* wp = C.in[I_WIN] + (size_t)layer * D * PROJ_W + (size_t)k * PROJ_W + 1536; wlo[j][e] = *(const f32x4*)wp; whi[j][e] = *(const f32x4*)(wp + 4); }
                else { const float* wp = C.in[I_MR] + (size_t)(layer >> 1) * D * 8 + (size_t)k * 8; wlo[j][e] = *(const f32x4*)wp; whi[j][e] = *(const f32x4*)(wp + 4); }
            } else { wlo[j][e] = (f32x4){0.f, 0.f, 0.f, 0.f}; whi[j][e] = wlo[j][e]; } }
    const float* gn = (which == 0 ? C.in[I_NORM1] : C.in[I_NORM2]) + layer * D;
    const float* mod = WSP(float, WS_MOD) + (size_t)layer * 33 * 6144;
    const int i_sh = which == 0 ? 0 : 3, i_sc = which == 0 ? 1 : 4;
    bf16* O = WSP(bf16, WS_A);
    const int gw = C.bid * NWAVES + C.wave, NGW = C.G * NWAVES;
    const int nrows = (which == 1 && layer == DEPTH - 1) ? TLAT : TT;
    const int rpw = (nrows + NGW - 1) / NGW;
    int m0 = gw * rpw; asm volatile("" : "+s"(m0));
    const int m1 = (m0 + rpw < nrows) ? m0 + rpw : nrows;
    const bool first = which == 0 && layer == 0;
    f32x4 gA[4], gB[4]; int cur_mr = -1;
    f32x4 v[4]; v4u rw[2];
    if (m0 < m1) {
        if (first) { const f32x4* xr = (const f32x4*)norm_row_ptr_f32(C, m0) + 2 * lane;
#pragma unroll
            for (int j = 0; j < 4; ++j) v[j] = xr[128 * (j >> 1) + (j & 1)]; }
        else { const v4u* xr = (const v4u*)norm_row_ptr_bf(C, m0) + lane;
#pragma unroll
            for (int j = 0; j < 2; ++j) rw[j] = xr[64 * j]; } }
    for (int m = m0; m < m1; ++m) {
        const bool lat = m < TLAT; const int mr = lat ? (m >> 11) : 32;
        if (mr != cur_mr) { cur_mr = mr; const float* msh = mod + (size_t)mr * 6144 + i_sh * 1024; const float* msc = mod + (size_t)mr * 6144 + i_sc * 1024;
#pragma unroll
            for (int j = 0; j < 4; ++j) { const int k = 8 * lane + 512 * (j >> 1) + 4 * (j & 1); gA[j] = *(const f32x4*)(gn + k) * (1.0f + *(const f32x4*)(msc + k)); gB[j] = *(const f32x4*)(msh + k); } }
        f32x4 cv[4];
#pragma unroll
        for (int j = 0; j < 4; ++j) { const unsigned a = (j & 1) ? rw[j >> 1].z : rw[j >> 1].x, b = (j & 1) ? rw[j >> 1].w : rw[j >> 1].y; cv[j] = first ? v[j] : (f32x4){bflo(a), bfhi(a), bflo(b), bfhi(b)}; }
        if (m + 1 < m1) {
            if (first) { const f32x4* xr = (const f32x4*)norm_row_ptr_f32(C, m + 1) + 2 * lane;
#pragma unroll
                for (int j = 0; j < 4; ++j) v[j] = xr[128 * (j >> 1) + (j & 1)]; }
            else { const v4u* xr = (const v4u*)norm_row_ptr_bf(C, m + 1) + lane;
#pragma unroll
                for (int j = 0; j < 2; ++j) rw[j] = xr[64 * j]; } }
        float ss = 0.f;
#pragma unroll
        for (int j = 0; j < 4; ++j) ss += (cv[j].x * cv[j].x + cv[j].y * cv[j].y) + (cv[j].z * cv[j].z + cv[j].w * cv[j].w);
        const float rstd = rsqrtf(wave_sum(ss) * (1.0f / D) + EPS);
        f32x4 elo = (f32x4){0.f, 0.f, 0.f, 0.f}, ehi = elo;
        v4u* o16 = (v4u*)(O + (size_t)m * D) + lane; unsigned pw[8];
#pragma unroll
        for (int j = 0; j < 4; ++j) {
            const f32x4 h = cv[j] * rstd * gA[j] + gB[j];
            pw[2 * j] = pk2(h.x, h.y); pw[2 * j + 1] = pk2(h.z, h.w);
            if (j & 1) o16[64 * (j >> 1)] = (v4u){pw[2 * j - 2], pw[2 * j - 1], pw[2 * j], pw[2 * j + 1]};
            if (need_extra) {
#pragma unroll
                for (int e = 0; e < 4; ++e) { elo = elo + h[e] * wlo[j][e]; ehi = ehi + h[e] * whi[j][e]; } }
        }
        if (need_extra) {
            const bool b0 = lane & 1, b1 = lane & 2, b2 = lane & 4;
            float k4[4], k2[2];
#pragma unroll
            for (int j = 0; j < 4; ++j) { const float send = b0 ? elo[j] : ehi[j], keep = b0 ? ehi[j] : elo[j]; k4[j] = keep + shx(send, 1, lane); }
#pragma unroll
            for (int j = 0; j < 2; ++j) { const float send = b1 ? k4[j] : k4[2 + j], keep = b1 ? k4[2 + j] : k4[j]; k2[j] = keep + shx(send, 2, lane); }
            float k1; { const float send = b2 ? k2[0] : k2[1], keep = b2 ? k2[1] : k2[0]; k1 = keep + shx(send, 4, lane); }
            k1 += shx(k1, 8, lane); k1 += shx(k1, 16, lane); k1 += shx(k1, 32, lane);
            if (which == 0) { if (lane < 8) WSP(float, WS_DT)[(size_t)m * 8 + 4 * (lane & 1) + (lane & 2) + ((lane >> 2) & 1)] = k1; }
            else {
                float ex[8]; const int ki = __builtin_bit_cast(int, k1);
                ex[0] = __builtin_bit_cast(float, __builtin_amdgcn_readlane(ki, 0)); ex[1] = __builtin_bit_cast(float, __builtin_amdgcn_readlane(ki, 4));
                ex[2] = __builtin_bit_cast(float, __builtin_amdgcn_readlane(ki, 2)); ex[3] = __builtin_bit_cast(float, __builtin_amdgcn_readlane(ki, 6));
                ex[4] = __builtin_bit_cast(float, __builtin_amdgcn_readlane(ki, 1)); ex[5] = __builtin_bit_cast(float, __builtin_amdgcn_readlane(ki, 5));
                ex[6] = __builtin_bit_cast(float, __builtin_amdgcn_readlane(ki, 3)); ex[7] = __builtin_bit_cast(float, __builtin_amdgcn_readlane(ki, 7));
                int i0 = 0; float v0 = ex[0];
#pragma unroll
                for (int j = 1; j < 8; ++j) if (ex[j] > v0) { v0 = ex[j]; i0 = j; }
                int i1 = -1; float v1 = -3.0e38f;
#pragma unroll
                for (int j = 0; j < 8; ++j) if (j != i0 && ex[j] > v1) { v1 = ex[j]; i1 = j; }
                if (lane == 0) {
                    const float e1 = __expf(v1 - v0); const float w0 = 1.0f / (1.0f + e1), w1 = e1 / (1.0f + e1);
                    const int lp0 = __hip_atomic_fetch_add(lcnt + i0, 1, __ATOMIC_RELAXED, __HIP_MEMORY_SCOPE_WORKGROUP), lp1 = __hip_atomic_fetch_add(lcnt + 8 + i1, 1, __ATOMIC_RELAXED, __HIP_MEMORY_SCOPE_WORKGROUP);
                    int* d = (int*)(WSP(float, WS_COMB) + (size_t)m * 8);
                    *(v4u*)d = (v4u){(unsigned)i0, (unsigned)i1, (unsigned)lp0, (unsigned)lp1}; *(f32x4*)(d + 4) = (f32x4){w0, w1, 0.f, 0.f};
                }
            }
        }
    }
    __syncthreads();
    if (which == 1 && moe && C.tid < 16) {
        unsigned* ctl = (unsigned*)(C.ws + WS_CTL);
        const unsigned base = __hip_atomic_fetch_add(ctl + CW_GCNT + 64 * C.dry + layer * 16 + C.tid, (unsigned)lcnt[C.tid], __ATOMIC_RELAXED, __HIP_MEMORY_SCOPE_AGENT);
        ctl[CW_BB + 4096 * C.dry + C.bid * 16 + C.tid] = base;
    }
    __syncthreads();
}

__device__ __forceinline__ void moe_offsets(const Ctx& C, int layer, int slot, int (&off)[9]) {
    const unsigned* cnt = (const unsigned*)(C.ws + WS_CTL) + CW_GCNT + 64 * C.dry + layer * 16 + slot * 8;
    off[0] = 0;
#pragma unroll
    for (int e = 0; e < 8; ++e) { const int c = (int)__builtin_amdgcn_readfirstlane((int)__hip_atomic_load(cnt + e, __ATOMIC_RELAXED, __HIP_MEMORY_SCOPE_AGENT)); off[e + 1] = off[e] + ((c + 255) & ~255); }
}
__device__ __forceinline__ void phase_moe_maps(const Ctx& C, int layer) {
    const unsigned* ctl = (const unsigned*)(C.ws + WS_CTL);
    const int NGW = C.G * NWAVES;
    const int nrows = (layer == DEPTH - 1) ? TLAT : TT;
    const int rpw = (nrows + NGW - 1) / NGW;
#pragma unroll
    for (int slot = 0; slot < 2; ++slot) {
        int off[9]; moe_offsets(C, layer, slot, off);
        int* rowtok = slot ? WSP(int, WS_ROWTOK1) : WSP(int, WS_ROWTOK); float* roww = slot ? WSP(float, WS_ROWW1) : WSP(float, WS_ROWW);
        unsigned* goff = slot ? WSP(unsigned, WS_GOFF1) : WSP(unsigned, WS_GOFF);
        for (int m = C.bid * NTHR + C.tid; m < nrows; m += C.G * NTHR) {
            const int* rt = (const int*)(WSP(float, WS_COMB) + (size_t)m * 8);
            const int e = rt[slot], lp = rt[2 + slot]; const float w = ((const float*)rt)[4 + slot];
            const int blk = (m / rpw) >> 3;
            int oe = 0;
#pragma unroll
            for (int j = 0; j < 8; ++j) oe = (e == j) ? off[j] : oe;
            const int pos = oe + (int)ctl[CW_BB + 4096 * C.dry + blk * 16 + slot * 8 + e] + lp;
            rowtok[pos] = m; roww[pos] = w; goff[(pos & ~255) + 4 * (pos & 63) + ((pos >> 6) & 3)] = (unsigned)m * 2048u;
        }
        const unsigned* cnt = ctl + CW_GCNT + 64 * C.dry + layer * 16 + slot * 8;
        for (int i = C.bid * NTHR + C.tid; i < 8 * 256; i += C.G * NTHR) { const int e = i >> 8, j = i & 255;
            int oe = 0, on = 0;
#pragma unroll
            for (int k = 0; k < 8; ++k) { oe = (e == k) ? off[k] : oe; on = (e == k) ? off[k + 1] : on; }
            const int r = oe + (int)cnt[e] + j; if (r < on) { rowtok[r] = -1; goff[(r & ~255) + 4 * (r & 63) + ((r >> 6) & 3)] = 0u; } }
    }
}

constexpr int AT_KROW = 144, AT_VROW = 320, AT_KB = 64 * AT_KROW, AT_VB = 64 * AT_VROW, AT_BUF = AT_KB + AT_VB, AT_NBUF = 4;
static_assert(AT_NBUF * AT_BUF <= MISC_OFF, "attention LDS ring");
__device__ __forceinline__ v4u pk8s(float a0, float a1, float a2, float a3, float a4, float a5, float a6, float a7) {
    v4u w; asm("s_nop 0\n\tv_cvt_pk_bf16_f32 %0, %4, %5\n\tv_cvt_pk_bf16_f32 %1, %6, %7\n\tv_cvt_pk_bf16_f32 %2, %8, %9\n\tv_cvt_pk_bf16_f32 %3, %10, %11"
                   : "=&v"(w.x), "=&v"(w.y), "=&v"(w.z), "=&v"(w.w) : "v"(a0), "v"(a1), "v"(a2), "v"(a3), "v"(a4), "v"(a5), "v"(a6), "v"(a7)); return w; }
template <int KT> __device__ __forceinline__ void at_qk(f32x16 (&S)[2], const LAS unsigned char* kb, const bf16x8 (&Qf)[2][4], int r, int h) {
    const LAS unsigned char* kp = kb + (32 * KT + r) * AT_KROW + 16 * h;
    const f32x16 Z = {0.f, 0.f, 0.f, 0.f, 0.f, 0.f, 0.f, 0.f, 0.f, 0.f, 0.f, 0.f, 0.f, 0.f, 0.f, 0.f};
    { const bf16x8 Kf = *(const LAS bf16x8*)kp;
#pragma unroll
      for (int qt = 0; qt < 2; ++qt) S[qt] = HY_MFMA(Kf, Qf[qt][0], Z); }
#pragma unroll
    for (int kk = 1; kk < 4; ++kk) { const bf16x8 Kf = *(const LAS bf16x8*)(kp + 32 * kk);
#pragma unroll
        for (int qt = 0; qt < 2; ++qt) S[qt] = HY_MFMA(Kf, Qf[qt][kk], S[qt]); }
}
template <int KT> __device__ __forceinline__ void at_pv(f32x16 (&O)[2][2], const v4u (&Pp)[2][2], unsigned va) {
#pragma unroll
    for (int s2 = 0; s2 < 2; ++s2) {
        v2u t00, t01, t10, t11;
        asm volatile("ds_read_b64_tr_b16 %0, %1 offset:%2" : "=&v"(t00) : "v"(va), "i"((32 * KT + 16 * s2) * AT_VROW) : "memory");
        asm volatile("ds_read_b64_tr_b16 %0, %1 offset:%2" : "=&v"(t01) : "v"(va), "i"((32 * KT + 16 * s2 + 8) * AT_VROW) : "memory");
        asm volatile("ds_read_b64_tr_b16 %0, %1 offset:%2" : "=&v"(t10) : "v"(va), "i"((32 * KT + 16 * s2) * AT_VROW + 64) : "memory");
        asm volatile("ds_read_b64_tr_b16 %0, %1 offset:%2" : "=&v"(t11) : "v"(va), "i"((32 * KT + 16 * s2 + 8) * AT_VROW + 64) : "memory");
        asm volatile("s_waitcnt lgkmcnt(0)" ::: "memory"); __builtin_amdgcn_sched_barrier(0);
        { v4u w; w.x = t00.x; w.y = t00.y; w.z = t01.x; w.w = t01.y; const bf16x8 Vf = __builtin_bit_cast(bf16x8, w);
#pragma unroll
          for (int qt = 0; qt < 2; ++qt) O[0][qt] = HY_MFMA(Vf, __builtin_bit_cast(bf16x8, Pp[qt][s2]), O[0][qt]); }
        { v4u w; w.x = t10.x; w.y = t10.y; w.z = t11.x; w.w = t11.y; const bf16x8 Vf = __builtin_bit_cast(bf16x8, w);
#pragma unroll
          for (int qt = 0; qt < 2; ++qt) O[1][qt] = HY_MFMA(Vf, __builtin_bit_cast(bf16x8, Pp[qt][s2]), O[1][qt]); }
    }
}
__device__ __forceinline__ void at_sm(f32x16 (&S)[2], v4u (&Pp)[2][2], float (&mrun)[2], float (&lrun)[2], f32x16 (&O)[2][2], bool band, int dl0) {
#pragma unroll
    for (int qt = 0; qt < 2; ++qt) {
        float mx = -1.0e30f;
#pragma unroll
        for (int e = 0; e < 16; ++e) { float t = S[qt][e];
            if (band) { const int dl = dl0 - 32 * qt + (e & 3) + 8 * (e >> 2); if (dl < -128 || dl > 128) t = -1.0e30f; }
            S[qt][e] = t; mx = fmaxf(mx, t); }
        { const auto rr = __builtin_amdgcn_permlane32_swap(__float_as_uint(mx), __float_as_uint(mx), false, false); mx = fmaxf(__uint_as_float(rr[0]), __uint_as_float(rr[1])); }
        const bool up = mx > mrun[qt] + 8.0f;
        const float mnew = up ? mx : mrun[qt];
        float ls = 0.f;
#pragma unroll
        for (int e = 0; e < 16; ++e) { const float p = __builtin_amdgcn_exp2f(S[qt][e] - mnew); S[qt][e] = p; ls += p; }
        if (__builtin_amdgcn_ballot_w64(up) != 0ull) {
            const float alpha = __builtin_amdgcn_exp2f(mrun[qt] - mnew); mrun[qt] = mnew;
            lrun[qt] = lrun[qt] * alpha + ls;
#pragma unroll
            for (int dt = 0; dt < 2; ++dt)
#pragma unroll
                for (int e = 0; e < 16; ++e) O[dt][qt][e] *= alpha;
        } else lrun[qt] += ls;
#pragma unroll
        for (int s2 = 0; s2 < 2; ++s2) Pp[qt][s2] = pk8s(S[qt][8 * s2 + 0], S[qt][8 * s2 + 1], S[qt][8 * s2 + 2], S[qt][8 * s2 + 3], S[qt][8 * s2 + 4], S[qt][8 * s2 + 5], S[qt][8 * s2 + 6], S[qt][8 * s2 + 7]);
    }
}
__device__ __forceinline__ void at_sm_fix(f32x16 (&S)[2], v4u (&Pp)[2][2], float (&lrun)[2], bool band, int dl0) {
#pragma unroll
    for (int qt = 0; qt < 2; ++qt) {
        float ls = 0.f;
#pragma unroll
        for (int e = 0; e < 16; ++e) { float t = S[qt][e];
            if (band) { const int dl = dl0 - 32 * qt + (e & 3) + 8 * (e >> 2); if (dl < -128 || dl > 128) t = -1.0e30f; }
            const float p = __builtin_amdgcn_exp2f(t); S[qt][e] = p; ls += p; }
        if (__builtin_amdgcn_ballot_w64(ls < 0.f) != 0ull) lrun[qt] = 0.f; else lrun[qt] += ls;
#pragma unroll
        for (int s2 = 0; s2 < 2; ++s2) Pp[qt][s2] = pk8s(S[qt][8 * s2 + 0], S[qt][8 * s2 + 1], S[qt][8 * s2 + 2], S[qt][8 * s2 + 3], S[qt][8 * s2 + 4], S[qt][8 * s2 + 5], S[qt][8 * s2 + 6], S[qt][8 * s2 + 7]);
    }
}
template <bool FIX> __device__ __forceinline__ void att_unit(const Ctx& C, const bf16* P, bf16* AO, float sinkl2, int b, int kvh, int qrow0, int qpos0, bool lat) {
    LAS unsigned char* lds = C.lds;
    int lane; asm volatile("v_mbcnt_lo_u32_b32 %0, -1, 0\n\tv_mbcnt_hi_u32_b32 %0, -1, %0" : "=v"(lane));
    const int tid = C.wave * 64 + lane;
    const int r = lane & 31, h = lane >> 5, g = C.wave & 3, qh = C.wave >> 2, hd = kvh * 4 + g;
    bf16x8 Qf[2][4];
#pragma unroll
    for (int qt = 0; qt < 2; ++qt)
#pragma unroll
        for (int kk = 0; kk < 4; ++kk) Qf[qt][kk] = *(const bf16x8*)(P + (size_t)(qrow0 + 64 * qh + 32 * qt + r) * PW + PC_Q + 64 * hd + 16 * kk + 8 * h);
    f32x16 O[2][2];
#pragma unroll
    for (int dt = 0; dt < 2; ++dt)
#pragma unroll
        for (int qt = 0; qt < 2; ++qt)
#pragma unroll
            for (int e = 0; e < 16; ++e) O[dt][qt][e] = 0.f;
    float mrun[2] = {-1.0e30f, -1.0e30f}, lrun[2] = {0.f, 0.f};
    const int T0 = lat ? (qpos0 == 0 ? 2 : 0) : 2, T1 = lat ? (qpos0 == 2048 - 128 ? 8 : 10) : 6;
    const int w0 = lat ? (T0 > qh ? T0 : qh) : 2, w1 = lat ? (T1 - 1 < 8 + qh ? T1 - 1 : 8 + qh) : 5;
    const int lkey = tid >> 3, lch = tid & 7;
    const unsigned vtr = (unsigned)(unsigned long)(lds + AT_KB) + (unsigned)((4 * h + ((lane & 15) >> 2)) * AT_VROW + 2 * (16 * ((lane >> 4) & 1) + 4 * (lane & 3)));
    const bf16* kvbase = P + PC_K + 64 * kvh + 8 * lch;
    v4u kreg, vreg;
#define AT_TILE_ROW(ix) (((ix) >= 2 && (ix) < 6) ? (TLAT + b * 256 + 64 * ((ix) - 2)) : (b * 2048 + qpos0 - 128 + 64 * ((ix) < 2 ? (ix) : (ix) - 4)))
#define AT_KBUF(ix) (lds + ((ix) & 3) * AT_BUF)
#define AT_VBUF(ix) (vtr + (unsigned)(((ix) & 3) * AT_BUF))
    __syncthreads();
    {
        const bf16* s0 = kvbase + (size_t)(AT_TILE_ROW(T0) + lkey) * PW; const bf16* s1 = kvbase + (size_t)(AT_TILE_ROW(T0 + 1) + lkey) * PW;
        kreg = *(const v4u*)s0; vreg = *(const v4u*)(s0 + (PC_V - PC_K)); const v4u k2 = *(const v4u*)s1, v2 = *(const v4u*)(s1 + (PC_V - PC_K));
        LAS unsigned char* kb = AT_KBUF(T0); *(LAS v4u*)(kb + lkey * AT_KROW + lch * 16) = kreg; *(LAS v4u*)(kb + AT_KB + lkey * AT_VROW + lch * 16) = vreg;
        kb = AT_KBUF(T0 + 1); *(LAS v4u*)(kb + lkey * AT_KROW + lch * 16) = k2; *(LAS v4u*)(kb + AT_KB + lkey * AT_VROW + lch * 16) = v2;
    }
    asm volatile("s_waitcnt lgkmcnt(0)" ::: "memory");
    __syncthreads();
    f32x16 S0[2], S1[2]; v4u Pp[2][2];
    if (qh == 0) __builtin_amdgcn_s_setprio(2);
    at_qk<0>(S0, AT_KBUF(w0), Qf, r, h);
    for (int tx = T0; tx < T1; ++tx) {
#if defined(PROBE_ATT_SLEEP)
        if (qh == 1) __builtin_amdgcn_s_sleep(PROBE_ATT_SLEEP);
#endif
        const bool nok = tx + 2 < T1;
        if (nok) { const bf16* src = kvbase + (size_t)(AT_TILE_ROW(tx + 2) + lkey) * PW; kreg = *(const v4u*)src; vreg = *(const v4u*)(src + (PC_V - PC_K)); }
        if (tx >= w0 && tx <= w1) {
            const int bj = tx < 2 ? tx : tx - 4;
            const bool band = lat && (tx < 2 || tx >= 6) && (bj - qh == 0 || bj - qh == 4);
            const int dbase = (-128 + 64 * bj) - 64 * qh + 4 * h - r;
            at_qk<1>(S1, AT_KBUF(tx), Qf, r, h);
            if (tx > w0) at_pv<1>(O, Pp, AT_VBUF(tx - 1));
            if constexpr (FIX) at_sm_fix(S0, Pp, lrun, band, dbase); else at_sm(S0, Pp, mrun, lrun, O, band, dbase);
            if (tx < w1) at_qk<0>(S0, AT_KBUF(tx + 1), Qf, r, h);
            at_pv<0>(O, Pp, AT_VBUF(tx));
            if constexpr (FIX) at_sm_fix(S1, Pp, lrun, band, dbase + 32); else at_sm(S1, Pp, mrun, lrun, O, band, dbase + 32);
        }
        if (nok) {
            LAS unsigned char* kb = AT_KBUF(tx + 2); *(LAS v4u*)(kb + lkey * AT_KROW + lch * 16) = kreg;
            *(LAS v4u*)(kb + AT_KB + lkey * AT_VROW + lch * 16) = vreg;
        }
        asm volatile("s_waitcnt lgkmcnt(0)" ::: "memory");
        __syncthreads();
    }
    at_pv<1>(O, Pp, AT_VBUF(w1));
    __builtin_amdgcn_s_setprio(0);
#undef AT_TILE_ROW
#undef AT_KBUF
#undef AT_VBUF
#pragma unroll
    for (int qt = 0; qt < 2; ++qt) {
        float l = lrun[qt]; { const auto rr = __builtin_amdgcn_permlane32_swap(__float_as_uint(l), __float_as_uint(l), false, false); l = __uint_as_float(rr[0]) + __uint_as_float(rr[1]); } l += __builtin_amdgcn_exp2f(FIX ? sinkl2 : sinkl2 - mrun[qt]);
        const float il = 1.0f / l;
        bf16* orow = AO + (size_t)(qrow0 + 64 * qh + 32 * qt + r) * 512 + 64 * hd + 4 * h;
#pragma unroll
        for (int dt = 0; dt < 2; ++dt)
#pragma unroll
            for (int gq = 0; gq < 4; ++gq) { v2u w; w.x = pk2(O[dt][qt][4 * gq] * il, O[dt][qt][4 * gq + 1] * il); w.y = pk2(O[dt][qt][4 * gq + 2] * il, O[dt][qt][4 * gq + 3] * il);
                *(v2u*)(orow + 32 * dt + 8 * gq) = w; }
    }
}
__device__ __forceinline__ void phase_att_mfma(const Ctx& C, int layer) {
    const bf16* P = WSP(bf16, WS_PROJ); bf16* AO = WSP(bf16, WS_ATT);
    const bool last = layer == DEPTH - 1;
    const int nlat = NB * 2 * 16, nctx = last ? 0 : NB * 2 * 2;
    const int vcu = (C.G % 8 == 0) ? (C.bid % 8) * (C.G / 8) + C.bid / 8 : C.bid;
    int bl; asm volatile("v_mbcnt_lo_u32_b32 %0, -1, 0\n\tv_mbcnt_hi_u32_b32 %0, -1, %0" : "=v"(bl));
    float gq = fabsf(C.in[I_QNORM][layer * 64 + bl]), gk = fabsf(C.in[I_KNORM][layer * 64 + bl]);
#pragma unroll
    for (int o = 1; o < 64; o <<= 1) { gq = fmaxf(gq, shx(gq, o, bl)); gk = fmaxf(gk, shx(gk, o, bl)); }
    const float sbound = __uint_as_float(__builtin_amdgcn_readfirstlane(__float_as_uint(1.02f * 64.0f * gq * gk * 0.125f * 1.4426950408889634f + 1.0f)));
    const bool fix = sbound <= 40.0f;
    for (int u = vcu; u < nlat + nctx; u += C.G) {
        if (u < nlat) { const int b = u >> 5, kvh = (u >> 4) & 1, qb = u & 15;
            const float sk = C.in[I_SINKS][layer * 8 + kvh * 4 + (C.wave & 3)] * 1.4426950408889634f;
            if (fix) att_unit<true>(C, P, AO, sk, b, kvh, b * 2048 + qb * 128, qb * 128, true); else att_unit<false>(C, P, AO, sk, b, kvh, b * 2048 + qb * 128, qb * 128, true); }
        else { const int v = u - nlat; const int b = v >> 2, kvh = (v >> 1) & 1, qb = v & 1;
            const float sk = C.in[I_SINKS][layer * 8 + kvh * 4 + (C.wave & 3)] * 1.4426950408889634f;
            if (fix) att_unit<true>(C, P, AO, sk, b, kvh, TLAT + b * 256 + qb * 128, 0, false); else att_unit<false>(C, P, AO, sk, b, kvh, TLAT + b * 256 + qb * 128, 0, false); }
    }
    __syncthreads();
}

constexpr int SS_XT = 144, SS_BM = 144, SS_BT = 144, SS_CM = 144;
constexpr int SS_OFF_XT = 0, SS_OFF_BM = SS_OFF_XT + 128 * SS_XT, SS_OFF_BT = SS_OFF_BM + 128 * SS_BM, SS_OFF_CM = SS_OFF_BT + 128 * SS_BT, SS_OFF_LA = SS_OFF_CM + 128 * SS_CM,
              SS_OFF_DT = SS_OFF_LA + 512, SS_OFF_CF = SS_OFF_DT + 512, SS_OFF_CW = SS_OFF_CF + 512 + 16, SS_END = SS_OFF_CW + 192 * 16;
static_assert(SS_END <= MISC_OFF, "ssd LDS map");
__device__ __forceinline__ float wave_incl_scan(float v, int lane) {
#pragma unroll
    for (int o = 1; o < 64; o <<= 1) { const float t = shup(v, o, lane); if (lane >= o) v += t; }
    return v;
}
__device__ __forceinline__ bf16x8 ld2x64(const LAS unsigned char* p) { const v2u a = *(const LAS v2u*)p, c = *(const LAS v2u*)(p + 16); v4u w; w.x = a.x; w.y = a.y; w.z = c.x; w.w = c.y; return __builtin_bit_cast(bf16x8, w); }
__device__ __forceinline__ bf16x8 ld2x64c(const LAS unsigned char* p) { const v2u a = *(const LAS v2u*)p, c = *(const LAS v2u*)(p + 8); v4u w; w.x = a.x; w.y = a.y; w.z = c.x; w.w = c.y; return __builtin_bit_cast(bf16x8, w); }
__device__ __forceinline__ bf16x8 pack8(const f32x16& v, int o) { v4u w; w.x = pk2(v[o], v[o + 1]); w.y = pk2(v[o + 2], v[o + 3]); w.z = pk2(v[o + 4], v[o + 5]); w.w = pk2(v[o + 6], v[o + 7]); return __builtin_bit_cast(bf16x8, w); }
#define SS_TR2(a, b, addr, off0, off1) do { asm volatile("ds_read_b64_tr_b16 %0, %1 offset:%2" : "=&v"(a) : "v"(addr), "i"(off0) : "memory"); \
        asm volatile("ds_read_b64_tr_b16 %0, %1 offset:%2" : "=&v"(b) : "v"(addr), "i"(off1) : "memory"); } while (0)
#define SS_TRWAIT() do { asm volatile("s_waitcnt lgkmcnt(0)" ::: "memory"); __builtin_amdgcn_sched_barrier(0); } while (0)
__device__ __forceinline__ bf16x8 ss_frag(v2u a, v2u b) { v4u w; w.x = a.x; w.y = a.y; w.z = b.x; w.w = b.y; return __builtin_bit_cast(bf16x8, w); }
__device__ __forceinline__ void ssd_chunk_geo(int ci, int b, int dir, int& L, int& base, int& cs) {
    const bool sctx = ci < 2; L = sctx ? 256 : 2048; const int nch = sctx ? 2 : 16, cidx = sctx ? ci : ci - 2; base = sctx ? TLAT + b * 256 : b * 2048;
    cs = dir ? (nch - 1 - cidx) * 128 : cidx * 128;
}
constexpr int SS_STG = SS_END, SS_STG_ROW = 25 * 16, SS_STG_END = SS_STG + 7 * 512 * 16;
constexpr int SS_LA_ALL = SS_STG_END, SS_DT_ALL = SS_LA_ALL + 18 * 512, SS_LEND_ALL = SS_DT_ALL + 18 * 512, SS_ALL_END = SS_LEND_ALL + 128;
static_assert(SS_STG % 16 == 0 && SS_ALL_END <= MISC_OFF, "ssd staging");
__device__ __forceinline__ void ssd_stage(const bf16* P, LAS unsigned char* lds, int ci, int b, int hh, int g, int dir, int tid, int wave) {
    int L, base, cs; ssd_chunk_geo(ci, b, dir, L, base, cs);
#pragma unroll
    for (int j = 0; j < 7; ++j) { const int sl = j * 512 + tid; int rho = sl / 25, cg = sl - rho * 25; rho = rho > 129 ? 129 : rho; cg = cg > 23 ? 23 : cg;
        int t = cs - 1 + rho; t = t < 0 ? 0 : (t > L - 1 ? L - 1 : t);
        const int ch = cg < 8 ? 64 * hh + 8 * cg : (cg < 16 ? 256 + 64 * g + 8 * (cg - 8) : 384 + 64 * g + 8 * (cg - 16));
        __builtin_amdgcn_global_load_lds((const unsigned*)(P + (size_t)(base + t) * PW + PC_XBC + ch), (LAS unsigned*)(lds + SS_STG + (j * 512 + wave * 64) * 16), 16, 0, 0); }
}
__device__ __forceinline__ void ssd_unit(const Ctx& C, int layer, int b, int hh, int dir) {
    LAS unsigned char* lds = C.lds;
    int lane = C.lane; asm volatile("" : "+v"(lane));
    int tid = C.tid; asm volatile("" : "+v"(tid));
    const int r = lane & 31, h = lane >> 5, ph = C.wave >> 2, lt = ph ? 3 - (C.wave & 3) : (C.wave & 3), g = hh >> 1;
    const bf16* P = WSP(bf16, WS_PROJ); const float* DTR = WSP(float, WS_DT); bf16* Y = WSP(bf16, WS_SSDY) + (size_t)dir * TT * 256;
    const float a = -expf(C.in[I_SALOG][layer * 8 + dir * 4 + hh]); const float dtb = C.in[I_SDTB][layer * 8 + dir * 4 + hh]; const float dsk = dir == 0 ? C.in[I_SD][layer * 4 + hh] : 0.f;
    __syncthreads();
    if (tid < 192) { const int ch = tid < 64 ? 64 * hh + tid : (tid < 128 ? 256 + 64 * g + (tid - 64) : 384 + 64 * g + (tid - 128));
        const float* cw = C.in[I_SCW] + (size_t)layer * 3 * 512; const float* cb = C.in[I_SCB] + (size_t)layer * 512;
        *(LAS f32x4*)(lds + SS_OFF_CW + tid * 16) = (f32x4){cw[ch], cw[512 + ch], cw[1024 + ch], cb[ch]}; }
    f32x16 Hacc[2];
#pragma unroll
    for (int nt = 0; nt < 2; ++nt)
#pragma unroll
        for (int e = 0; e < 16; ++e) Hacc[nt][e] = 0.f;
    const int lp = tid & 127, cg0 = tid >> 7;
    const unsigned trlane = (unsigned)(((lane & 15) >> 2) * 144 + 2 * (16 * ((lane >> 4) & 1) + 4 * (lane & 3)));
    const unsigned trx4 = (unsigned)(unsigned long)(lds + SS_OFF_XT) + trlane + (unsigned)(4 * h * SS_XT + 64 * ph);
    const unsigned trx8 = (unsigned)(unsigned long)(lds + SS_OFF_XT) + trlane + (unsigned)(8 * h * SS_XT + 64 * ph);
    const unsigned trb8 = (unsigned)(unsigned long)(lds + SS_OFF_BT) + trlane + (unsigned)(8 * h * SS_BT);
    ssd_stage(P, lds, 0, b, hh, g, dir, tid, C.wave);
    for (int cj = C.wave; cj < 18; cj += 8) { int L, base, cs; ssd_chunk_geo(cj, b, dir, L, base, cs);
        const int t0 = dir ? cs + 127 - lane : cs + lane, t1 = dir ? cs + 63 - lane : cs + 64 + lane;
        const float r0 = DTR[(size_t)(base + t0) * 8 + dir * 4 + hh] + dtb, r1 = DTR[(size_t)(base + t1) * 8 + dir * 4 + hh] + dtb;
        const float d0 = r0 > 20.f ? r0 : log1pf(expf(r0)), d1 = r1 > 20.f ? r1 : log1pf(expf(r1));
        const float s0 = wave_incl_scan(d0 * a, lane); const float tot0 = __builtin_bit_cast(float, __builtin_amdgcn_readlane(__builtin_bit_cast(int, s0), 63)); const float s1 = wave_incl_scan(d1 * a, lane) + tot0;
        LAS float* LA = (LAS float*)(lds + SS_LA_ALL) + cj * 128; LAS float* DTs = (LAS float*)(lds + SS_DT_ALL) + cj * 128;
        LA[lane] = s0; LA[64 + lane] = s1; DTs[lane] = d0; DTs[64 + lane] = d1; if (lane == 63) ((LAS float*)(lds + SS_LEND_ALL))[cj] = s1; }
    for (int ci = 0; ci < 18; ++ci) {
        int L, base, cs; ssd_chunk_geo(ci, b, dir, L, base, cs); const bool sctx = ci < 2;
        asm volatile("s_waitcnt vmcnt(0)" ::: "memory");
        __syncthreads();
        {
            const float lend_c = ((const LAS float*)(lds + SS_LEND_ALL))[ci];
            const float coef = ((const LAS float*)(lds + SS_DT_ALL))[ci * 128 + lp] * __expf(lend_c - ((const LAS float*)(lds + SS_LA_ALL))[ci * 128 + lp]);
            const int tt = dir ? cs + 127 - lp : cs + lp; const int rho = tt - cs + 1;
#pragma unroll
            for (int j = 0; j < 6; ++j) { const int cg = cg0 + 4 * j;
                const LAS unsigned char* sp = lds + SS_STG + rho * SS_STG_ROW + cg * 16; const v4u zero = (v4u){0u, 0u, 0u, 0u};
                const v4u r0 = tt > 0 ? *(const LAS v4u*)(sp - SS_STG_ROW) : zero, r1 = *(const LAS v4u*)sp, r2 = tt < L - 1 ? *(const LAS v4u*)(sp + SS_STG_ROW) : zero;
                const unsigned w0[4] = {r0.x, r0.y, r0.z, r0.w}, w1[4] = {r1.x, r1.y, r1.z, r1.w}, w2[4] = {r2.x, r2.y, r2.z, r2.w};
                float v[8];
#pragma unroll
                for (int e = 0; e < 8; ++e) { const f32x4 cw = *(const LAS f32x4*)(lds + SS_OFF_CW + (8 * cg + e) * 16);
                    const float x0 = (e & 1) ? bfhi(w0[e >> 1]) : bflo(w0[e >> 1]), x1 = (e & 1) ? bfhi(w1[e >> 1]) : bflo(w1[e >> 1]), x2 = (e & 1) ? bfhi(w2[e >> 1]) : bflo(w2[e >> 1]);
                    v[e] = silu_fast(cw.x * x0 + cw.y * x1 + cw.z * x2 + cw.w); }
                if (cg < 8) {
                    v4u w; w.x = pk2(v[0], v[1]); w.y = pk2(v[2], v[3]); w.z = pk2(v[4], v[5]); w.w = pk2(v[6], v[7]); *(LAS v4u*)(lds + SS_OFF_XT + lp * SS_XT + 16 * cg) = w;
                } else if (cg < 16) { const int n0 = 8 * (cg - 8);
                    v4u w; w.x = pk2(v[0], v[1]); w.y = pk2(v[2], v[3]); w.z = pk2(v[4], v[5]); w.w = pk2(v[6], v[7]); *(LAS v4u*)(lds + SS_OFF_BM + lp * SS_BM + 2 * n0) = w;
                    v4u ws; ws.x = pk2(v[0] * coef, v[1] * coef); ws.y = pk2(v[2] * coef, v[3] * coef); ws.z = pk2(v[4] * coef, v[5] * coef); ws.w = pk2(v[6] * coef, v[7] * coef); *(LAS v4u*)(lds + SS_OFF_BT + lp * SS_BT + 2 * n0) = ws;
                } else { const int n0 = 8 * (cg - 16);
                    v4u w; w.x = pk2(v[0], v[1]); w.y = pk2(v[2], v[3]); w.z = pk2(v[4], v[5]); w.w = pk2(v[6], v[7]); *(LAS v4u*)(lds + SS_OFF_CM + lp * SS_CM + 2 * n0) = w; }
            }
        }
        asm volatile("s_waitcnt lgkmcnt(0)" ::: "memory");
        __syncthreads();
        if (ci + 1 < 18) ssd_stage(P, lds, ci + 1, b, hh, g, dir, tid, C.wave);
        {
            const LAS float* LA = (const LAS float*)(lds + SS_LA_ALL) + ci * 128; const LAS float* DTs = (const LAS float*)(lds + SS_DT_ALL) + ci * 128;
            const float la_l = LA[32 * lt + r]; const float lend = ((const LAS float*)(lds + SS_LEND_ALL))[ci];
            f32x16 Yo, Yd;
#pragma unroll
            for (int e = 0; e < 16; ++e) { Yo[e] = 0.f; Yd[e] = 0.f; }
#pragma unroll
            for (int nt = 0; nt < 2; ++nt)
#pragma unroll
                for (int s2 = 0; s2 < 2; ++s2) { const bf16x8 A = pack8(Hacc[nt], 8 * s2);
                    const bf16x8 Bf = ld2x64(lds + SS_OFF_CM + (32 * lt + r) * SS_CM + 2 * (32 * nt + 16 * s2 + 4 * h));
                    Yo = HY_MFMA(A, Bf, Yo); }
            for (int st = 0; st <= lt; ++st) {
                f32x16 S;
#pragma unroll
                for (int e = 0; e < 16; ++e) S[e] = 0.f;
#pragma unroll
                for (int kk = 0; kk < 4; ++kk) { const bf16x8 A = *(const LAS bf16x8*)(lds + SS_OFF_BM + (32 * st + r) * SS_BM + 32 * kk + 16 * h);
                    const bf16x8 Bf = *(const LAS bf16x8*)(lds + SS_OFF_CM + (32 * lt + r) * SS_CM + 32 * kk + 16 * h);
                    S = HY_MFMA(A, Bf, S); }
#pragma unroll
                for (int gq = 0; gq < 4; ++gq) { const int s0 = 32 * st + 8 * gq + 4 * h;
                    const f32x4 las = *(const LAS f32x4*)(LA + s0), dts = *(const LAS f32x4*)(DTs + s0);
#pragma unroll
                    for (int e = 0; e < 4; ++e) { float gv = S[4 * gq + e] * __expf(la_l - las[e]) * dts[e];
                        if (st == lt) { const int sl = 8 * gq + 4 * h + e; if (sl > r) gv = 0.f; if (sl == r) gv += dsk; }
                        S[4 * gq + e] = gv; } }
                {
                    const unsigned xa = trx4 + (unsigned)(st * 32 * SS_XT); v2u a0, a1, c0, c1;
                    SS_TR2(a0, a1, xa, 0, 8 * SS_XT); SS_TR2(c0, c1, xa, 16 * SS_XT, 24 * SS_XT); SS_TRWAIT();
                    Yd = HY_MFMA(ss_frag(a0, a1), pack8(S, 0), Yd); Yd = HY_MFMA(ss_frag(c0, c1), pack8(S, 8), Yd); }
            }
            { const int lq = 32 * lt + r; const int tq = dir ? cs + 127 - lq : cs + lq; const float el = __expf(la_l);
              bf16* orow = Y + (size_t)(base + tq) * 256 + 64 * hh + 32 * ph + 4 * h;
              if (!sctx || layer != DEPTH - 1) {
#pragma unroll
                for (int gq = 0; gq < 4; ++gq) { v2u w; w.x = pk2(Yd[4 * gq] + el * Yo[4 * gq], Yd[4 * gq + 1] + el * Yo[4 * gq + 1]); w.y = pk2(Yd[4 * gq + 2] + el * Yo[4 * gq + 2], Yd[4 * gq + 3] + el * Yo[4 * gq + 3]);
                    *(v2u*)(orow + 8 * gq) = w; } } }
            { const float ea = __expf(lend);
#pragma unroll
              for (int nt = 0; nt < 2; ++nt)
#pragma unroll
                for (int e = 0; e < 16; ++e) Hacc[nt][e] *= ea;
#pragma unroll
              for (int kh = 0; kh < 2; ++kh) {
                v2u ax[4][2], a0[4][2], a1[4][2];
#pragma unroll
                for (int kk = 0; kk < 4; ++kk) { const int k = 4 * kh + kk;
                    SS_TR2(ax[kk][0], ax[kk][1], trx8, 16 * k * SS_XT, (16 * k + 4) * SS_XT);
                    SS_TR2(a0[kk][0], a0[kk][1], trb8, 16 * k * SS_BT, (16 * k + 4) * SS_BT);
                    SS_TR2(a1[kk][0], a1[kk][1], trb8, 16 * k * SS_BT + 64, (16 * k + 4) * SS_BT + 64); }
                SS_TRWAIT();
#pragma unroll
                for (int kk = 0; kk < 4; ++kk) { const bf16x8 Bf = ss_frag(ax[kk][0], ax[kk][1]);
                    Hacc[0] = HY_MFMA(ss_frag(a0[kk][0], a0[kk][1]), Bf, Hacc[0]); Hacc[1] = HY_MFMA(ss_frag(a1[kk][0], a1[kk][1]), Bf, Hacc[1]); } } }
        }
    }
}
__device__ __forceinline__ void phase_ssd_mfma(const Ctx& C, int layer) {
    for (int u = C.bid; u < NB * 4 * 2; u += C.G) ssd_unit(C, layer, u >> 3, (u >> 1) & 3, u & 1);
    __syncthreads();
}

constexpr int HY_ROW = 4112, HY_ROWC = 528;
constexpr int HY_F0 = 32 * HY_ROW, HY_F1 = HY_F0 + 8192 + 64, HY_LDS_END = HY_F1 + 8192;
static_assert(HY_LDS_END <= MISC_OFF, "hyena LDS map");
__device__ __forceinline__ bf16x8 hy_ldA(LAS unsigned char* lds, unsigned addr) {
    const LAS unsigned* p = (const LAS unsigned*)(lds + addr); v4u w; w.x = p[0]; w.y = p[1]; w.z = p[2]; w.w = p[3]; return __builtin_bit_cast(bf16x8, w);
}
__device__ __forceinline__ void hy_load_filter(LAS unsigned char* lds, const bf16* R, int n, int tid) {
    asm volatile("" : "+v"(tid));
    for (int q = tid; q < n / 8; q += NTHR) { v4u v = *((const v4u*)R + q); const unsigned nxt = (q < n / 8 - 1) ? (unsigned)R[8 * q + 8] : 0u;
        if (q == n / 8 - 1) v.w &= 0xffffu;
        *(LAS v4u*)(lds + HY_F0 + 16 * q) = v;
        v4u s; s.x = (v.x >> 16) | (v.y << 16); s.y = (v.y >> 16) | (v.z << 16); s.z = (v.z >> 16) | (v.w << 16); s.w = (v.w >> 16) | (nxt << 16);
        *(LAS v4u*)(lds + HY_F1 + 16 * q) = s; }
}
template <int L, int ROW>
__device__ __forceinline__ void hy_load_rows(LAS unsigned char* lds, const bf16* src, float w0, float w1, float w2, float bias, int tid) {
    asm volatile("" : "+v"(tid));
    constexpr int CPR = L / 8, NCH = 32 * CPR, PER = NCH / NTHR, HP = PER > 8 ? 8 : PER;
#pragma unroll
    for (int j0 = 0; j0 < PER; j0 += HP) {
        v4u v[HP]; unsigned short pv[HP], nx[HP];
#pragma unroll
        for (int j = 0; j < HP; ++j) { const int q = tid + NTHR * (j0 + j), ch = q % CPR; v[j] = *((const v4u*)src + q);
            pv[j] = ch > 0 ? src[(size_t)q * 8 - 1] : (unsigned short)0; nx[j] = ch < CPR - 1 ? src[(size_t)q * 8 + 8] : (unsigned short)0; }
#pragma unroll
        for (int j = 0; j < HP; ++j) { const int q = tid + NTHR * (j0 + j), b = q / CPR, ch = q % CPR;
            float x[10]; x[0] = bf2f(pv[j]); x[9] = bf2f(nx[j]);
            x[1] = bflo(v[j].x); x[2] = bfhi(v[j].x); x[3] = bflo(v[j].y); x[4] = bfhi(v[j].y); x[5] = bflo(v[j].z); x[6] = bfhi(v[j].z); x[7] = bflo(v[j].w); x[8] = bfhi(v[j].w);
            float y[8];
#pragma unroll
            for (int e = 0; e < 8; ++e) y[e] = w0 * x[e] + w1 * x[e + 1] + w2 * x[e + 2] + bias;
            v4u o; o.x = pk2(y[0], y[1]); o.y = pk2(y[2], y[3]); o.z = pk2(y[4], y[5]); o.w = pk2(y[6], y[7]);
            *(LAS v4u*)(lds + b * ROW + ch * 16) = o; }
    }
}
template <int L, int ROW>
__device__ __forceinline__ void hy_store_rows(LAS unsigned char* lds, bf16* dst, int tid) {
    asm volatile("" : "+v"(tid));
    constexpr int CPR = L / 8, NCH = 32 * CPR, PER = NCH / NTHR;
#pragma unroll
    for (int j = 0; j < PER; ++j) { const int q = tid + NTHR * j, b = q / CPR, ch = q % CPR; *((v4u*)dst + q) = *(const LAS v4u*)(lds + b * ROW + ch * 16); }
}
template <int NTILE, int ROW>
__device__ __forceinline__ void hy_mul_inplace(LAS unsigned char* lds, const f32x16 (&acc)[NTILE], int wave, int lane) {
    asm volatile("" : "+v"(lane));
    const int r = lane & 31, h = lane >> 5;
#pragma unroll
    for (int i = 0; i < NTILE; ++i)
#pragma unroll
        for (int g = 0; g < 4; ++g) { const int t = 32 * NTILE * wave + 32 * i + 8 * g + 4 * h;
            LAS v2u* p = (LAS v2u*)(lds + r * ROW + 2 * t); const v2u x = *p;
            v2u o; o.x = pk2(bflo(x.x) * acc[i][4 * g + 0], bfhi(x.x) * acc[i][4 * g + 1]); o.y = pk2(bflo(x.y) * acc[i][4 * g + 2], bfhi(x.y) * acc[i][4 * g + 3]); *p = o; }
}
__device__ __forceinline__ void hy_conv_lat(LAS unsigned char* lds, f32x16 (&acc)[8], int wave, int lane_in) {
    int lane = lane_in; asm volatile("" : "+v"(lane));
    const int r = lane & 31, h = lane >> 5, odd = (r + 1) & 1;
    const unsigned LA7 = HY_F0 + odd * (HY_F1 - HY_F0) + 2 * (2047 - r + 8 * h - odd) - 512 * wave - 448;
    const unsigned LB = r * HY_ROW + 16 * h;
#pragma unroll
    for (int i = 0; i < 8; ++i)
#pragma unroll
        for (int e = 0; e < 16; ++e) acc[i][e] = 0.f;
    bf16x8 We[8], Wo[8];
#pragma unroll
    for (int i = 1; i < 8; ++i) { We[i] = hy_ldA(lds, LA7 + 64 * (7 - i)); Wo[i] = hy_ldA(lds, LA7 + 64 * (7 - i) + 32); }
    unsigned fa = LA7 + 448, fb = LB;
    bf16x8 An = hy_ldA(lds, fa), Bn = *(const LAS bf16x8*)(lds + fb);
#pragma unroll 1
    for (int kb = 0; kb < 8; ++kb) {
#pragma unroll
        for (int u = 0; u < 8; ++u) {
            {
                const bf16x8 Bc = Bn; We[0] = An;
                An = hy_ldA(lds, fa + 32 * (2 * u + 1)); Bn = *(const LAS bf16x8*)(lds + fb + 32 * (2 * u + 1));
#pragma unroll
                for (int i = 0; i < 8; ++i) acc[i] = HY_MFMA(We[i], Bc, acc[i]);
#pragma unroll
                for (int i = 7; i >= 1; --i) We[i] = We[i - 1];
            }
            {
                const bf16x8 Bc = Bn; Wo[0] = An;
                An = hy_ldA(lds, fa + 32 * (2 * u + 2)); Bn = *(const LAS bf16x8*)(lds + fb + 32 * (2 * u + 2));
#pragma unroll
                for (int i = 0; i < 8; ++i) acc[i] = HY_MFMA(Wo[i], Bc, acc[i]);
#pragma unroll
                for (int i = 7; i >= 1; --i) Wo[i] = Wo[i - 1];
            }
        }
        fa += 512; fb += 512;
    }
}
__device__ __forceinline__ void hy_conv_ctx(LAS unsigned char* lds, f32x16 (&acc)[1], int wave, int lane) {
    asm volatile("" : "+v"(lane));
    const int r = lane & 31, h = lane >> 5, odd = (r + 1) & 1;
    const unsigned LA = HY_F0 + odd * (HY_F1 - HY_F0) + 2 * (255 - r + 8 * h - odd) - 64 * wave;
    const unsigned LB = r * HY_ROWC + 16 * h;
#pragma unroll
    for (int e = 0; e < 16; ++e) acc[0][e] = 0.f;
#pragma unroll
    for (int k = 0; k < 16; ++k) { const bf16x8 A = hy_ldA(lds, LA + 32 * k); const bf16x8 B = *(const LAS bf16x8*)(lds + LB + 32 * k); acc[0] = HY_MFMA(A, B, acc[0]); }
}
__device__ __forceinline__ void phase_hy_mfma(const Ctx& C, int layer) {
    const bf16* HT = WSP(bf16, WS_HYT); bf16* HO = WSP(bf16, WS_HYOT);
    const bool last = layer == DEPTH - 1;
    LAS unsigned char* lds = C.lds;
    const float* cw = C.in[I_HCW] + (size_t)layer * 3 * 768; const float* cb = C.in[I_HCB] + (size_t)layer * 768;
    for (int c = C.bid; c < 256; c += C.G) {
        float w[3][4];
#pragma unroll
        for (int p = 0; p < 3; ++p) { w[p][0] = cw[256 * p + c]; w[p][1] = cw[768 + 256 * p + c]; w[p][2] = cw[1536 + 256 * p + c]; w[p][3] = cb[256 * p + c]; }
        __syncthreads();
        {
            f32x16 acc[8];
            hy_load_filter(lds, WSP(bf16, WS_FILTB) + ((size_t)layer * 512 + c) * 4096, 4096, C.tid);
            hy_load_rows<2048, HY_ROW>(lds, HT + (size_t)c * TT, w[0][0], w[0][1], w[0][2], w[0][3], C.tid);
            __syncthreads();
            hy_conv_lat(lds, acc, C.wave, C.lane);
            __syncthreads();
            hy_load_filter(lds, WSP(bf16, WS_FILTB) + ((size_t)layer * 512 + 256 + c) * 4096, 4096, C.tid);
            hy_load_rows<2048, HY_ROW>(lds, HT + (size_t)(256 + c) * TT, w[1][0], w[1][1], w[1][2], w[1][3], C.tid);
            __syncthreads();
            hy_mul_inplace<8, HY_ROW>(lds, acc, C.wave, C.lane);
            __syncthreads();
            hy_conv_lat(lds, acc, C.wave, C.lane);
            __syncthreads();
            hy_load_rows<2048, HY_ROW>(lds, HT + (size_t)(512 + c) * TT, w[2][0], w[2][1], w[2][2], w[2][3], C.tid);
            __syncthreads();
            hy_mul_inplace<8, HY_ROW>(lds, acc, C.wave, C.lane);
            __syncthreads();
            hy_store_rows<2048, HY_ROW>(lds, HO + (size_t)c * TT, C.tid);
        }
        if (!last) {
            __syncthreads();
            f32x16 acc[1];
            hy_load_filter(lds, WSP(bf16, WS_FILTCB) + ((size_t)layer * 512 + c) * 512, 512, C.tid);
            hy_load_rows<256, HY_ROWC>(lds, HT + (size_t)c * TT + TLAT, w[0][0], w[0][1], w[0][2], w[0][3], C.tid);
            __syncthreads();
            hy_conv_ctx(lds, acc, C.wave, C.lane);
            __syncthreads();
            hy_load_filter(lds, WSP(bf16, WS_FILTCB) + ((size_t)layer * 512 + 256 + c) * 512, 512, C.tid);
            hy_load_rows<256, HY_ROWC>(lds, HT + (size_t)(256 + c) * TT + TLAT, w[1][0], w[1][1], w[1][2], w[1][3], C.tid);
            __syncthreads();
            hy_mul_inplace<1, HY_ROWC>(lds, acc, C.wave, C.lane);
            __syncthreads();
            hy_conv_ctx(lds, acc, C.wave, C.lane);
            __syncthreads();
            hy_load_rows<256, HY_ROWC>(lds, HT + (size_t)(512 + c) * TT + TLAT, w[2][0], w[2][1], w[2][2], w[2][3], C.tid);
            __syncthreads();
            hy_mul_inplace<1, HY_ROWC>(lds, acc, C.wave, C.lane);
            __syncthreads();
            hy_store_rows<256, HY_ROWC>(lds, HO + (size_t)c * TT + TLAT, C.tid);
        }
    }
    __syncthreads();
}

__device__ __forceinline__ void phase_merge(const Ctx& C, int layer) {
    const bf16* AO = WSP(bf16, WS_ATT); const bf16* SY = WSP(bf16, WS_SSDY); const bf16* HO = WSP(bf16, WS_HYOT); const bf16* P = WSP(bf16, WS_PROJ);
    bf16* Y = WSP(bf16, WS_A);
    const float* g_att = C.in[I_ATTON] + layer * 512; const float* g_ssd = C.in[I_SNORM] + layer * 256; const float* g_hy = C.in[I_HON] + layer * 256;
    const int nrows = (layer == DEPTH - 1) ? TLAT : TT;
    constexpr int RS = 66;
    LAS unsigned char* lds = C.lds;
    const int lane = C.lane;
    float ga[8], gs[4], gh[4];
#pragma unroll
    for (int e = 0; e < 8; ++e) ga[e] = g_att[8 * lane + e];
#pragma unroll
    for (int e = 0; e < 4; ++e) { gs[e] = g_ssd[4 * lane + e]; gh[e] = g_hy[4 * lane + e]; }
    for (int tile = C.bid; tile < nrows / 32; tile += C.G) {
        const int tok0 = 32 * tile;
        __syncthreads();
        {
            v4u hv[2];
#pragma unroll
            for (int j = 0; j < 2; ++j) { const int q = C.tid + NTHR * j, c = q >> 2, ch = q & 3; hv[j] = *(const v4u*)(HO + (size_t)c * TT + tok0 + 8 * ch); }
#pragma unroll
            for (int j = 0; j < 2; ++j) { const int q = C.tid + NTHR * j, c = q >> 2, ch = q & 3; LAS unsigned* d = (LAS unsigned*)(lds + c * RS + 16 * ch + (c & 1) * 2);
                (void)d; LAS bf16* d2 = (LAS bf16*)(lds + c * RS + 16 * ch); const unsigned w[4] = {hv[j].x, hv[j].y, hv[j].z, hv[j].w};
#pragma unroll
                for (int e = 0; e < 8; ++e) d2[e] = (bf16)((e & 1) ? (w[e >> 1] >> 16) : (w[e >> 1] & 0xffffu)); }
        }
        __syncthreads();
#pragma unroll
        for (int i = 0; i < 4; ++i) { const int tl = 4 * C.wave + i; const int m = tok0 + tl;
            { const v4u w = *((const v4u*)(AO + (size_t)m * 512) + lane);
              float v[8] = {bflo(w.x), bfhi(w.x), bflo(w.y), bfhi(w.y), bflo(w.z), bfhi(w.z), bflo(w.w), bfhi(w.w)}; float ss = 0.f;
#pragma unroll
              for (int e = 0; e < 8; ++e) ss += v[e] * v[e];
              const float rstd = rsqrtf(wave_sum(ss) * (1.0f / 512.0f) + EPS);
              v4u o; o.x = pk2(v[0] * rstd * ga[0], v[1] * rstd * ga[1]); o.y = pk2(v[2] * rstd * ga[2], v[3] * rstd * ga[3]); o.z = pk2(v[4] * rstd * ga[4], v[5] * rstd * ga[5]); o.w = pk2(v[6] * rstd * ga[6], v[7] * rstd * ga[7]);
              *((v4u*)(Y + (size_t)m * D) + lane) = o; }
            { const v2u w0 = *((const v2u*)(SY + (size_t)m * 256) + lane), w1 = *((const v2u*)(SY + ((size_t)TT + m) * 256) + lane), wz = *((const v2u*)(P + (size_t)m * PW + PC_Z) + lane);
              float v[4] = {bflo(w0.x) + bflo(w1.x), bfhi(w0.x) + bfhi(w1.x), bflo(w0.y) + bflo(w1.y), bfhi(w0.y) + bfhi(w1.y)};
              const float z[4] = {bflo(wz.x), bfhi(wz.x), bflo(wz.y), bfhi(wz.y)}; float ss = 0.f;
#pragma unroll
              for (int e = 0; e < 4; ++e) { v[e] *= silu(z[e]); ss += v[e] * v[e]; }
              const float rstd = rsqrtf(wave_sum(ss) * (1.0f / 256.0f) + EPS);
              v2u o; o.x = pk2(v[0] * rstd * gs[0], v[1] * rstd * gs[1]); o.y = pk2(v[2] * rstd * gs[2], v[3] * rstd * gs[3]);
              *((v2u*)(Y + (size_t)m * D + 512) + lane) = o; }
            { float v[4]; float ss = 0.f;
#pragma unroll
              for (int e = 0; e < 4; ++e) { v[e] = bf2f(*(const LAS bf16*)(lds + (4 * lane + e) * RS + 2 * tl)); ss += v[e] * v[e]; }
              ss = row16_sum(ss);
              const float rstd = rsqrtf(ss * (1.0f / 64.0f) + EPS);
              v2u o; o.x = pk2(v[0] * rstd * gh[0], v[1] * rstd * gh[1]); o.y = pk2(v[2] * rstd * gh[2], v[3] * rstd * gh[3]);
              *((v2u*)(Y + (size_t)m * D + 768) + lane) = o; }
        }
    }
    __syncthreads();
}

constexpr int NPHASES = 1 << 20;
__global__ void __launch_bounds__(NTHR, 2) mega_fwd(Args args) {
    extern __shared__ __attribute__((aligned(16))) unsigned char lds_raw[];
    Ctx C0; C0.in = (const float* const CAS*)__builtin_amdgcn_kernarg_segment_ptr();     C0.out = args.out; C0.ws = args.ws; C0.lds = (LAS unsigned char*)lds_raw;
    C0.tid = threadIdx.x; C0.lane = C0.tid & 63; C0.wave = __builtin_amdgcn_readfirstlane(C0.tid >> 6); C0.bid = blockIdx.x; C0.G = gridDim.x; C0.dry = args.pad1;
    const Ctx& C = C0;
    volatile LAS unsigned* MISC = (volatile LAS unsigned*)(C.lds + MISC_OFF);
    if (C.tid < 64) MISC[C.tid] = 0u;
    __syncthreads();
    const int lo = args.ph_lo, hi = args.ph_hi;
    const bool multi = (hi - lo) > 1;
    XcdBarrier bar; bar.bar = (unsigned*)(C.ws + WS_CTL) + CW_BAR + args.pad0 * XCD_BAR_WORDS; bar.x = 0; bar.st = MISC + 8;
    if (multi) bar = xcd_barrier_post((unsigned*)(C.ws + WS_CTL) + CW_BAR + args.pad0 * XCD_BAR_WORDS, MISC + 8);
    bar.wv = C0.wave;
    int ph = 0;
#if defined(PROBE_SLEEP_US)
    if (lo == 0) { const unsigned long long t0 = __builtin_amdgcn_s_memrealtime(); while (__builtin_amdgcn_s_memrealtime() - t0 < 100ull * PROBE_SLEEP_US) __builtin_amdgcn_s_sleep(32); }
#endif
#ifndef PHMASK
#define PHMASK 0xffffffffu
#endif
#define PHM(i) ((PHMASK >> (i)) & 1u)
#ifndef REPMASK
#define REPMASK 0u
#endif
#define REP(i, call) do { call; if ((REPMASK >> (i)) & 1u) { __syncthreads(); call; } } while (0)
#define PH_BEGIN if (ph >= lo && ph < hi) { Ctx C = C0; { unsigned long long _b = (unsigned long long)C0.out, _c = (unsigned long long)C0.ws, _a = (unsigned long long)C0.in; int _t; \
        asm volatile("v_mbcnt_lo_u32_b32 %0, -1, 0\n\tv_mbcnt_hi_u32_b32 %0, -1, %0" : "=v"(_t)); asm volatile("" : "+s"(_b), "+s"(_c), "+s"(_a)); C.in = (const float* const CAS*)_a; \
        C.out = (float*)(GAS float*)_b; C.ws = (unsigned char*)(GAS unsigned char*)_c; C.lane = _t; C.tid = C0.wave * 64 + _t; C.wave = C0.wave; }
#define PH_END } if (ph >= lo && ph + 1 < hi) xcd_barrier(bar); ++ph;

    PH_BEGIN if (PHM(0)) phase_siluc(C); PH_END
    PH_BEGIN if (PHM(0)) { phase_setup(C);
#if defined(PROBE_SETUP_ONLY)
        if (!C.dry)
#endif
        phase_pre(C, 0); } PH_END
#if defined(PROBE_BARRIERS)
    for (int i = 0; i < PROBE_BARRIERS; ++i) xcd_barrier(bar);
#endif
    for (int layer = 0; layer < DEPTH; ++layer) {
        const bool last = layer == DEPTH - 1; const bool moe = layer & 1;
        PH_BEGIN if (PHM(2)) { phase_norm(C, layer, 0); if (layer > 0) phase_pre(C, layer); } PH_END
        PH_BEGIN if (PHM(3)) { pg8::Gemm g{WSP(bf16, WS_A), WSP(bf16, WS_WIN), TT, PW, D}; pg8::ProjOrder S; S.init(TT, C.G, C.bid, layer == DEPTH - 1);
                   pg8::EpiProj E{WSP(bf16, WS_PROJ), WSP(bf16, WS_HYT), TT, C.in[I_QNORM] + layer * 64, C.in[I_KNORM] + layer * 64, WSP(float, WS_ROPE), WSP(float, WS_ROPE) + 32 * 32};
                   pg8::gemm_phase<pg8::EpiProj, pg8::ProjOrder, PG8_ALIGN, PG8_SP2>(C.lds, g, S, E, C.tid); } PH_END
        PH_BEGIN {
#pragma unroll 1
            for (int k = 0; k < 3; ++k) { const int w = (C.bid & 1) ? 2 - k : k;
#if defined(PROBE_SUB)
                if (C.dry && w != PROBE_SUB) continue;
#endif
                if (w == 0) phase_att_mfma(C, layer); else if (w == 1) phase_ssd_mfma(C, layer); else phase_hy_mfma(C, layer); } } PH_END
        PH_BEGIN if (PHM(9)) REP(9, phase_merge(C, layer)); PH_END
        PH_BEGIN if (PHM(10)) { const int M = last ? TLAT : TT; pg8::Gemm g{WSP(bf16, WS_A), WSP(bf16, WS_WOUT), M, D, D}; pg8::StaticOrder S; S.init(M, D, C.G, C.bid);
                   pg8::EpiResid E{layer == 0 ? (const void*)C.in[I_X] : (const void*)C.out, layer == 0 ? (const void*)C.in[I_CTX] : (const void*)WSP(bf16, WS_XC), (void*)C.out, (void*)WSP(bf16, WS_XC), layer == 0 ? 1 : 0, 0,
                                      WSP(float, WS_MOD) + (size_t)layer * 33 * 6144 + 2 * 1024, nullptr, nullptr, 0, C.dry};
                   pg8::gemm_phase<pg8::EpiResid, pg8::StaticOrder, PG8_ALIGN, PG8_SP2>(C.lds, g, S, E, C.tid); } PH_END
        PH_BEGIN if (PHM(11)) phase_norm(C, layer, 1); PH_END
        const int nslot = moe ? 2 : 1;
        for (int slot = 0; slot < nslot; ++slot) {
            if (moe && slot == 0) { PH_BEGIN if (PHM(14)) phase_moe_maps(C, layer); PH_END }
            PH_BEGIN if (PHM(12)) for (int rep = 0; rep < 1 + (int)((REPMASK >> 12) & 1u); ++rep) { pg8::MoeOrder S; int off[9];
                   if (moe) moe_offsets(C, layer, slot, off); else { off[0] = 0;
#pragma unroll
                       for (int e = 1; e < 9; ++e) off[e] = last ? TLAT : TT; }
#pragma unroll
                   for (int e = 0; e < 9; ++e) S.ts[e] = off[e] >> 8;
                   S.estride = (size_t)2 * FF * D * 2; S.init(off[8], 2 * FF, C.G, C.bid); S.goff = moe ? (slot ? WSP(unsigned, WS_GOFF1) : WSP(unsigned, WS_GOFF)) : nullptr;
                   pg8::Gemm g{WSP(bf16, WS_A), WSP(bf16, WS_F1), off[8], 2 * FF, D};
                   pg8::EpiSwiglu E{WSP(bf16, WS_HID), FF};
                   pg8::gemm_phase<pg8::EpiSwiglu, pg8::MoeOrder, PG8_ALIGN, PG8_SP2, true>(C.lds, g, S, E, C.tid); } PH_END
            PH_BEGIN if (PHM(13)) { pg8::MoeOrder S; int off[9];
                   if (moe) moe_offsets(C, layer, slot, off); else { off[0] = 0;
#pragma unroll
                       for (int e = 1; e < 9; ++e) off[e] = last ? TLAT : TT; }
#pragma unroll
                   for (int e = 0; e < 9; ++e) S.ts[e] = off[e] >> 8;
                   S.estride = (size_t)D * FF * 2; S.init(off[8], D, C.G, C.bid); S.goff = nullptr;
                   pg8::Gemm g{WSP(bf16, WS_HID), WSP(bf16, WS_F2), off[8], D, FF};
                   const bool fin0 = last && slot == 0, fin1 = last && slot == 1;
                   pg8::EpiResid E{fin1 ? (const void*)WSP(bf16, WS_XR) : (const void*)C.out, (const void*)WSP(bf16, WS_XC), fin0 ? (void*)WSP(bf16, WS_XR) : (void*)C.out, (void*)WSP(bf16, WS_XC), 0, fin1 ? 1 : 0,
                                   WSP(float, WS_MOD) + (size_t)layer * 33 * 6144 + 5 * 1024, moe ? (slot ? WSP(int, WS_ROWTOK1) : WSP(int, WS_ROWTOK)) : nullptr, moe ? (slot ? WSP(float, WS_ROWW1) : WSP(float, WS_ROWW)) : nullptr, 1, C.dry};
                   pg8::gemm_phase<pg8::EpiResid, pg8::MoeOrder, PG8_ALIGN, PG8_SP2>(C.lds, g, S, E, C.tid);
                   } PH_END
        }
    }
#undef PH_BEGIN
#undef PH_END
}

#ifndef MK_ONE_LAUNCH
#define MK_ONE_LAUNCH 1
#endif
extern "C" void kernel_launch(void* const* d_in, const int* in_sizes, int n_in, void* d_out, int out_size, void* d_ws, size_t ws_size, hipStream_t stream) {
    static int grid = 0;
    if (grid == 0) {
        if (n_in != 38 || out_size != TLAT * D || ws_size < WS_END) { fprintf(stderr, "kernel_launch: unexpected shapes (n_in %d, out %d, ws %zu)\n", n_in, out_size, ws_size); grid = -1; return; }
        int dev = 0, cus = 0, per_cu = 0;
        if (hipGetDevice(&dev) != hipSuccess || hipDeviceGetAttribute(&cus, hipDeviceAttributeMultiprocessorCount, dev) != hipSuccess) { grid = -1; return; }
        if (hipFuncSetAttribute((const void*)mega_fwd, hipFuncAttributeMaxDynamicSharedMemorySize, LDS_BYTES) != hipSuccess) { fprintf(stderr, "kernel_launch: hipFuncSetAttribute failed\n"); grid = -1; return; }
        if (hipOccupancyMaxActiveBlocksPerMultiprocessor(&per_cu, (const void*)mega_fwd, NTHR, LDS_BYTES) != hipSuccess || per_cu < 1) { fprintf(stderr, "kernel_launch: occupancy query says %d\n", per_cu); (void)hipGetLastError(); grid = -1; return; }
        grid = cus;
    }
    if (grid < 0) return;
    (void)hipMemsetAsync((char*)d_ws + WS_CTL, 0, CTL_ZERO_BYTES, stream);
    Args a{};
    for (int i = 0; i < 38; ++i) a.in[i] = (const float*)d_in[i];
    a.out = (float*)d_out; a.ws = (unsigned char*)d_ws;
#if defined(PROBE_PHASE)
#ifndef PROBE_END
#define PROBE_END (PROBE_PHASE + 1)
#endif
    a.ph_lo = 0; a.ph_hi = PROBE_END; a.pad0 = 0; hipLaunchKernelGGL(mega_fwd, dim3(grid), dim3(NTHR), LDS_BYTES, stream, a);
#ifndef PROBE_REP
#define PROBE_REP 1
#endif
    for (int rep = 0; rep < PROBE_REP; ++rep) { a.ph_lo = PROBE_PHASE; a.ph_hi = PROBE_END; a.pad0 = 1; a.pad1 = 1; hipLaunchKernelGGL(mega_fwd, dim3(grid), dim3(NTHR), LDS_BYTES, stream, a); }
    a.ph_lo = PROBE_END; a.ph_hi = NPHASES; a.pad0 = 2; a.pad1 = 0; hipLaunchKernelGGL(mega_fwd, dim3(grid), dim3(NTHR), LDS_BYTES, stream, a);
#elif MK_ONE_LAUNCH
    a.ph_lo = 0; a.ph_hi = NPHASES;
    hipLaunchKernelGGL(mega_fwd, dim3(grid), dim3(NTHR), LDS_BYTES, stream, a);
#else
#error multi-launch build removed
#endif
}
```
